# Optimizing an MI355X kernel written in HIP

```python
import math
import jax, jax.numpy as jnp
from jax import lax
import numpy as np

D_MODEL = 1024
BATCH = 2
SEQ = 16384
DEPTH = 2

N_META = 16
RMS_EPS = 1e-6
D_FF = 2816
S5_WIDTH = D_MODEL // 2
S5_GROUP = 16
S5_GROUPS = S5_WIDTH // S5_GROUP
S5_STATE = 64
DT_MIN = 1e-3
DT_MAX = 1e-1
GLA_HEADS = 4
GLA_DK = D_MODEL // 4
GLA_DV = D_MODEL // 2
GLA_HEAD_DK = GLA_DK // GLA_HEADS
GLA_HEAD_DV = GLA_DV // GLA_HEADS
GLA_RANK = 16
GLA_GATE_NORM = 16.0
GLA_CHUNK = 64
N_BRANCH = 2
IN_SPLITS = (S5_WIDTH, GLA_DK, GLA_DK, GLA_DV, GLA_DV, GLA_RANK, GLA_RANK, N_BRANCH * D_MODEL)
D_IN = S5_WIDTH + 2 * GLA_DK + 2 * GLA_DV + 2 * GLA_RANK + N_BRANCH * D_MODEL

kernel_name = "bidir_s5_gla_macaron_hybrid"

F32 = jnp.float32


def rmsnorm(x, g):
    x32 = x.astype(F32)
    y = x32 * lax.rsqrt(jnp.mean(x32 * x32, axis=-1, keepdims=True) + RMS_EPS)
    return (y * g.astype(F32)).astype(x.dtype)


def swiglu(x, wg, wu, wd):
    return (jax.nn.silu(x @ wg) * (x @ wu)) @ wd


def _cmul(ar, ai, br, bi):
    return ar * br - ai * bi, ar * bi + ai * br


def _s5_discretise(a_re, a_im, log_dt, b_re, b_im):
    dt = jnp.exp(log_dt.astype(F32))[:, None]
    ar, ai = a_re.astype(F32), a_im.astype(F32)
    mag = jnp.exp(ar * dt)
    lb_re, lb_im = mag * jnp.cos(ai * dt), mag * jnp.sin(ai * dt)
    den = ar * ar + ai * ai
    f_re, f_im = _cmul(lb_re - 1.0, lb_im, ar / den, -ai / den)
    bb_re, bb_im = _cmul(f_re[..., None], f_im[..., None], b_re.astype(F32), b_im.astype(F32))
    return lb_re, lb_im, bb_re, bb_im


def _diag_combine(earlier, later):
    a1r, a1i, b1r, b1i = earlier
    a2r, a2i, b2r, b2i = later
    ar, ai = _cmul(a2r, a2i, a1r, a1i)
    br, bi = _cmul(a2r, a2i, b1r, b1i)
    return ar, ai, br + b2r, bi + b2i


def _s5_direction(u_t, a_re, a_im, log_dt, b_re, b_im, c_re, c_im, reverse):
    lb_re, lb_im, bb_re, bb_im = _s5_discretise(a_re, a_im, log_dt, b_re, b_im)
    bu_re = jnp.einsum('lbgh,gph->lbgp', u_t, bb_re)
    bu_im = jnp.einsum('lbgh,gph->lbgp', u_t, bb_im)
    shape = (u_t.shape[0], 1) + lb_re.shape
    a_re_t = jnp.broadcast_to(lb_re, shape)
    a_im_t = jnp.broadcast_to(lb_im, shape)
    _, _, h_re, h_im = lax.associative_scan(
        _diag_combine, (a_re_t, a_im_t, bu_re, bu_im), reverse=reverse, axis=0)
    c_re, c_im = c_re.astype(F32), c_im.astype(F32)
    return jnp.einsum('lbgp,ghp->lbgh', h_re, c_re) - jnp.einsum('lbgp,ghp->lbgh', h_im, c_im)


def s5_branch(u, a_re_f, a_im_f, log_dt_f, a_re_b, a_im_b, log_dt_b,
              b_re, b_im, c_re, c_im, d, w_glu):
    bsz, L, _ = u.shape
    u_t = u.astype(F32).reshape(bsz, L, S5_GROUPS, S5_GROUP).transpose(1, 0, 2, 3)
    y = (_s5_direction(u_t, a_re_f, a_im_f, log_dt_f, b_re, b_im, c_re, c_im, False)
         + _s5_direction(u_t, a_re_b, a_im_b, log_dt_b, b_re, b_im, c_re, c_im, True)
         + d.astype(F32).reshape(S5_GROUPS, S5_GROUP) * u_t)
    y = y.transpose(1, 0, 2, 3).reshape(bsz, L, S5_WIDTH)
    ab = jax.nn.gelu(y).astype(u.dtype) @ w_glu
    a, b = jnp.split(ab, 2, axis=-1)
    return a * jax.nn.sigmoid(b)


def _gla_direction(q, k, v, g, strict):
    C = q.shape[3]
    b = jnp.cumsum(g, axis=3)
    b_last = b[:, :, :, -1:]
    q_d = q * jnp.exp(b)
    k_d = k * jnp.exp(-b)
    scores = jnp.einsum('bhnid,bhnjd->bhnij', q_d, k_d)
    mask = jnp.tril(jnp.ones((C, C), dtype=bool), k=-1 if strict else 0)
    intra = jnp.einsum('bhnij,bhnjv->bhniv', jnp.where(mask, scores, 0.0), v)
    k_s = k * jnp.exp(b_last - b)
    chunk_state = jnp.einsum('bhncd,bhncv->bhndv', k_s, v)
    decay = jnp.exp(b_last[:, :, :, 0])

    def step(h, inp):
        s_n, a_n = inp
        return a_n[..., None] * h + s_n, h

    h0 = jnp.zeros(q.shape[:2] + (q.shape[-1], v.shape[-1]), q.dtype)
    _, h_in = lax.scan(step, h0, (jnp.moveaxis(chunk_state, 2, 0), jnp.moveaxis(decay, 2, 0)))
    h_in = jnp.moveaxis(h_in, 0, 2)
    inter = jnp.einsum('bhncd,bhndv->bhncv', q_d, h_in)
    return intra + inter


def _to_chunks(t):
    bsz, lp, nh, dd = t.shape
    return t.reshape(bsz, lp // GLA_CHUNK, GLA_CHUNK, nh, dd).transpose(0, 3, 1, 2, 4)


def _from_chunks(t):
    bsz, nh, n, c, dd = t.shape
    return t.transpose(0, 2, 3, 1, 4).reshape(bsz, n * c, nh, dd)


def gla_branch(q, k, v, r, z_f, z_b, w2_f, bias_f, w2_b, bias_b, norm_g, w_o):
    bsz, L, _ = q.shape
    pad = GLA_CHUNK - N_META
    g_f = jax.nn.log_sigmoid(z_f.astype(F32) @ w2_f.astype(F32) + bias_f.astype(F32)) / GLA_GATE_NORM
    g_b = jax.nn.log_sigmoid(z_b.astype(F32) @ w2_b.astype(F32) + bias_b.astype(F32)) / GLA_GATE_NORM
    scale = GLA_HEAD_DK ** -0.5

    def heads(t, dd):
        t = jnp.pad(t.astype(F32), ((0, 0), (pad, 0), (0, 0)))
        return t.reshape(bsz, L + pad, GLA_HEADS, dd)

    qh, kh = heads(q * scale, GLA_HEAD_DK), heads(k, GLA_HEAD_DK)
    vh = heads(v, GLA_HEAD_DV)
    gfh, gbh = heads(g_f, GLA_HEAD_DK), heads(g_b, GLA_HEAD_DK)

    o_f = _from_chunks(_gla_direction(_to_chunks(qh), _to_chunks(kh), _to_chunks(vh),
                                      _to_chunks(gfh), strict=False))
    flip = lambda t: jnp.flip(t, axis=1)
    o_b = flip(_from_chunks(_gla_direction(_to_chunks(flip(qh)), _to_chunks(flip(kh)),
                                           _to_chunks(flip(vh)), _to_chunks(flip(gbh)),
                                           strict=True)))
    o = (o_f + o_b)[:, pad:]
    o = o * lax.rsqrt(jnp.mean(o * o, axis=-1, keepdims=True) + RMS_EPS)
    o = o.reshape(bsz, L, GLA_DV) * norm_g.astype(F32)
    o = o * jax.nn.silu(r.astype(F32))
    return o.astype(q.dtype) @ w_o


def hybrid_mixer(hn, w_in, s5_a_re_f, s5_a_im_f, s5_log_dt_f, s5_a_re_b, s5_a_im_b, s5_log_dt_b,
                 s5_b_re, s5_b_im, s5_c_re, s5_c_im, s5_d, s5_w_glu,
                 gla_w2_f, gla_b_f, gla_w2_b, gla_b_b, gla_norm, gla_w_o, w_out):
    bsz, L, _ = hn.shape
    points = []
    acc = 0
    for w in IN_SPLITS[:-1]:
        acc += w
        points.append(acc)
    proj = hn @ w_in
    u, q, k, v, r, z_f, z_b, gate_logits = jnp.split(proj, points, axis=-1)
    o_s5 = s5_branch(u, s5_a_re_f, s5_a_im_f, s5_log_dt_f, s5_a_re_b, s5_a_im_b, s5_log_dt_b,
                     s5_b_re, s5_b_im, s5_c_re, s5_c_im, s5_d, s5_w_glu)
    o_gla = gla_branch(q, k, v, r, z_f, z_b, gla_w2_f, gla_b_f, gla_w2_b, gla_b_b, gla_norm, gla_w_o)
    gates = jax.nn.sigmoid(gate_logits.astype(F32)).reshape(bsz, L, N_BRANCH, D_MODEL)
    merged = gates[:, :, 0] * o_s5.astype(F32) + gates[:, :, 1] * o_gla.astype(F32)
    return merged.astype(hn.dtype) @ w_out


def setup_inputs(seed: int = 0) -> dict:
    key = jax.random.key(seed)
    keys = iter(jax.random.split(key, 64))
    nrm = lambda shape, s: jax.random.normal(next(keys), shape, F32) * s
    gain = lambda shape: 1.0 + 0.01 * jax.random.normal(next(keys), shape, F32)
    L_ = DEPTH
    a_im0 = jnp.pi * jnp.arange(S5_STATE, dtype=F32)
    log_lo, log_hi = math.log(DT_MIN), math.log(DT_MAX)
    return {
        "x": nrm((BATCH, SEQ, D_MODEL), 1.0),
        "meta": nrm((N_META, D_MODEL), 1.0),
        "ffn1_norm": gain((L_, D_MODEL)),
        "ffn1_wg": nrm((L_, D_MODEL, D_FF), D_MODEL ** -0.5),
        "ffn1_wu": nrm((L_, D_MODEL, D_FF), D_MODEL ** -0.5),
        "ffn1_wd": nrm((L_, D_FF, D_MODEL), D_FF ** -0.5),
        "mix_norm": gain((L_, D_MODEL)),
        "w_in": nrm((L_, D_MODEL, D_IN), D_MODEL ** -0.5),
        "s5_a_re_f": -0.5 + nrm((L_, S5_GROUPS, S5_STATE), 0.01),
        "s5_a_im_f": a_im0 + nrm((L_, S5_GROUPS, S5_STATE), 0.01),
        "s5_log_dt_f": jax.random.uniform(next(keys), (L_, S5_GROUPS), F32, log_lo, log_hi),
        "s5_a_re_b": -0.5 + nrm((L_, S5_GROUPS, S5_STATE), 0.01),
        "s5_a_im_b": a_im0 + nrm((L_, S5_GROUPS, S5_STATE), 0.01),
        "s5_log_dt_b": jax.random.uniform(next(keys), (L_, S5_GROUPS), F32, log_lo, log_hi),
        "s5_b_re": nrm((L_, S5_GROUPS, S5_STATE, S5_GROUP), (2 * S5_GROUP) ** -0.5),
        "s5_b_im": nrm((L_, S5_GROUPS, S5_STATE, S5_GROUP), (2 * S5_GROUP) ** -0.5),
        "s5_c_re": nrm((L_, S5_GROUPS, S5_GROUP, S5_STATE), S5_STATE ** -0.5),
        "s5_c_im": nrm((L_, S5_GROUPS, S5_GROUP, S5_STATE), S5_STATE ** -0.5),
        "s5_d": nrm((L_, S5_WIDTH), 0.5),
        "s5_w_glu": nrm((L_, S5_WIDTH, 2 * D_MODEL), S5_WIDTH ** -0.5),
        "gla_w2_f": nrm((L_, GLA_RANK, GLA_DK), GLA_RANK ** -0.5),
        "gla_b_f": nrm((L_, GLA_DK), 0.1),
        "gla_w2_b": nrm((L_, GLA_RANK, GLA_DK), GLA_RANK ** -0.5),
        "gla_b_b": nrm((L_, GLA_DK), 0.1),
        "gla_norm": gain((L_, GLA_DV)),
        "gla_w_o": nrm((L_, GLA_DV, D_MODEL), GLA_DV ** -0.5),
        "w_out": nrm((L_, D_MODEL, D_MODEL), D_MODEL ** -0.5),
        "ffn2_norm": gain((L_, D_MODEL)),
        "ffn2_wg": nrm((L_, D_MODEL, D_FF), D_MODEL ** -0.5),
        "ffn2_wu": nrm((L_, D_MODEL, D_FF), D_MODEL ** -0.5),
        "ffn2_wd": nrm((L_, D_FF, D_MODEL), D_FF ** -0.5),
        "final_norm": gain((D_MODEL,)),
    }


def reference(x, meta, ffn1_norm, ffn1_wg, ffn1_wu, ffn1_wd, mix_norm, w_in,
              s5_a_re_f, s5_a_im_f, s5_log_dt_f, s5_a_re_b, s5_a_im_b, s5_log_dt_b,
              s5_b_re, s5_b_im, s5_c_re, s5_c_im, s5_d, s5_w_glu,
              gla_w2_f, gla_b_f, gla_w2_b, gla_b_b, gla_norm, gla_w_o, w_out,
              ffn2_norm, ffn2_wg, ffn2_wu, ffn2_wd, final_norm):
    bsz = x.shape[0]
    meta_b = jnp.broadcast_to(meta.astype(x.dtype)[None], (bsz,) + meta.shape)
    h = jnp.concatenate([meta_b, x], axis=1)
    for l in range(DEPTH):
        h = h + 0.5 * swiglu(rmsnorm(h, ffn1_norm[l]), ffn1_wg[l], ffn1_wu[l], ffn1_wd[l])
        h = h + hybrid_mixer(rmsnorm(h, mix_norm[l]), w_in[l],
                             s5_a_re_f[l], s5_a_im_f[l], s5_log_dt_f[l],
                             s5_a_re_b[l], s5_a_im_b[l], s5_log_dt_b[l],
                             s5_b_re[l], s5_b_im[l], s5_c_re[l], s5_c_im[l], s5_d[l], s5_w_glu[l],
                             gla_w2_f[l], gla_b_f[l], gla_w2_b[l], gla_b_b[l], gla_norm[l],
                             gla_w_o[l], w_out[l])
        h = h + 0.5 * swiglu(rmsnorm(h, ffn2_norm[l]), ffn2_wg[l], ffn2_wu[l], ffn2_wd[l])
    h = rmsnorm(h, final_norm)
    return h[:, N_META:]
```

```cpp
#include <hip/hip_runtime.h>
#include <hip/hip_cooperative_groups.h>
#include <cstdio>
namespace cg = cooperative_groups;

#define LAS __attribute__((address_space(3)))
typedef unsigned short bf16_t;
typedef short bf16x8 __attribute__((ext_vector_type(8)));
typedef float f32x4 __attribute__((ext_vector_type(4)));
typedef float f32x2 __attribute__((ext_vector_type(2)));
typedef unsigned u32x4 __attribute__((ext_vector_type(4)));
typedef unsigned u32x2 __attribute__((ext_vector_type(2)));

constexpr int T = 32800, TR = 32768, DM = 1024, DFF = 2816, DIN = 4128;
constexpr int NCH = 1025, MCH = 2050;
constexpr int GCH = 257;
constexpr int NTHR = 512;
constexpr int LDS_BYTES = 131072;

constexpr size_t AL(size_t x) { return (x + 255) & ~size_t(255); }
constexpr size_t SLACK = size_t(2) << 20;
constexpr size_t OFF_HB = 0;
constexpr size_t OFF_METAH = OFF_HB + AL((size_t)T * 1024 * 2) + SLACK;
constexpr size_t OFF_ROWPART = OFF_METAH + 32 * 1024 * 4;
constexpr size_t OFF_LAM = OFF_ROWPART + AL((size_t)T * 16 * 4);
constexpr size_t OFF_W = OFF_LAM + 32 * 2 * 64 * 2 * 4;
constexpr size_t W_UP1 = 0, W_DN1 = W_UP1 + (size_t)5632 * 1024, W_INP = W_DN1 + (size_t)1024 * 2816, W_ING = W_INP + (size_t)2304 * 1024,
                 W_GLU = W_ING + (size_t)2048 * 1024, W_O = W_GLU + (size_t)2048 * 512, W_OUT = W_O + (size_t)1024 * 512,
                 W_UP2 = W_OUT + (size_t)1024 * 1024, W_DN2 = W_UP2 + (size_t)5632 * 1024, W_S1 = W_DN2 + (size_t)1024 * 2816,
                 W_S2 = W_S1 + (size_t)32 * 256 * 256, W_END = W_S2 + (size_t)32 * 256 * 512;
constexpr size_t OFF_R1 = OFF_W + AL(W_END * 2);
constexpr size_t R1_SIZE = AL((size_t)T * 2816 * 2) + SLACK;
constexpr size_t OFF_HID = OFF_R1;
constexpr size_t OFF_UBUF = OFF_R1;
constexpr size_t OFF_Q = OFF_UBUF + AL((size_t)32 * MCH * 512 * 2) + SLACK;
constexpr size_t OFF_K = OFF_Q + AL((size_t)T * 256 * 2);
constexpr size_t OFF_V = OFF_K + AL((size_t)T * 256 * 2);
constexpr size_t OFF_R = OFF_V + AL((size_t)T * 512 * 2);
constexpr size_t OFF_Z = OFF_R + AL((size_t)T * 512 * 2);
constexpr size_t OFF_ZEND = OFF_Z + AL((size_t)T * 32 * 4);
static_assert(OFF_ZEND <= OFF_R1 + R1_SIZE, "R1 overflow");
constexpr size_t OFF_SB = OFF_R1;
constexpr size_t OFF_GB = OFF_SB + AL((size_t)T * 1024 * 2) + SLACK;
static_assert(OFF_GB + AL((size_t)T * 1024 * 2) + SLACK <= OFF_R1 + R1_SIZE, "R1 overflow 2");
constexpr size_t OFF_R2 = OFF_R1 + R1_SIZE;
constexpr size_t OFF_S5S = OFF_R2;
constexpr size_t OFF_Y = OFF_R2;
constexpr size_t OFF_O = OFF_Y + AL((size_t)T * 512 * 2) + SLACK;
constexpr size_t R2A_A = AL((size_t)32 * MCH * 256 * 4), R2A_B = 2 * (AL((size_t)T * 512 * 2) + SLACK);
constexpr size_t R2A_SIZE = R2A_A > R2A_B ? R2A_A : R2A_B;
constexpr size_t OFF_GS = OFF_R2 + R2A_SIZE;
constexpr size_t OFF_DEC = OFF_GS + AL((size_t)4112 * 8192 * 2);
constexpr size_t OFF_BAR = OFF_DEC + AL((size_t)4112 * 64 * 4);
constexpr size_t WS_END = OFF_BAR + 256;

#ifndef PHMASK
#if defined(DBG_NO_GLA)
#define PHMASK 0xFFFD5F
#elif defined(DBG_NO_INTER)
#define PHMASK 0xFFFF1F
#elif defined(DBG_NO_S5)
#define PHMASK 0xFFFFBF
#else
#define PHMASK 0xFFFFFF
#endif
#endif
#define PH(n) if constexpr (((PHMASK) >> (n)) & 1)
struct Params { const float* in[32]; float* out; unsigned char* ws; };

__device__ __forceinline__ float bf2f(bf16_t b) { return __uint_as_float(((unsigned)b) << 16); }
typedef __bf16 bf16x2_t __attribute__((ext_vector_type(2)));
__device__ __forceinline__ unsigned pk2(float lo, float hi) { bf16x2_t v; v.x = (__bf16)lo; v.y = (__bf16)hi; return __builtin_bit_cast(unsigned, v); }
__device__ __forceinline__ bf16_t f2bf(float f) { return (bf16_t)(pk2(f, 0.f) & 0xffffu); }
__device__ __forceinline__ float sigm(float x) { return __builtin_amdgcn_rcpf(1.f + __expf(-x)); }
__device__ __forceinline__ float siluf_(float x) { return x * sigm(x); }
__device__ __forceinline__ float gelu_tanh(float x) { const float u = 0.7978845608028654f * (x + 0.044715f * x * x * x); return x * sigm(2.f * u); }
__device__ __forceinline__ float logsig(float x) { return fminf(x, 0.f) - log1pf(__expf(-fabsf(x))); }
__device__ __forceinline__ float lo16(unsigned w) { return __uint_as_float(w << 16); }
__device__ __forceinline__ float hi16(unsigned w) { return __uint_as_float(w & 0xffff0000u); }
__device__ __forceinline__ float row_rstd(const float* rowpart, int rowc, int fq) {
    const f32x4 p = *(const f32x4*)(rowpart + (size_t)rowc * 16 + 4 * fq);
    float s = (p[0] + p[1]) + (p[2] + p[3]);
    s += __shfl_xor(s, 16); s += __shfl_xor(s, 32);
    return rsqrtf(s * (1.f / 1024.f) + 1e-6f);
}
__device__ __forceinline__ int opaque_tid() { int t = threadIdx.x; asm volatile("" : "+v"(t)); return t; }
__device__ __forceinline__ void row_to_mt(int row, int& m, int& t) {
    if (row < TR) { const int b = row >> 14, s = row & 16383, p = s + 16; m = b * NCH + (p >> 4); t = p & 15; }
    else { const int rr = row - TR; m = (rr >> 4) * NCH; t = rr & 15; }
}

namespace pg8 {
constexpr int BM = 256, BK = 64, HALF = 128, HTB = HALF * BK * 2, NXCD = 8, WGM = 8;
__device__ __forceinline__ int lds_byte(int r, int c) { const int st = (r >> 4) * 2 + (c >> 5), rr = r & 15, cc = c & 31, ob = rr * 64 + cc * 2; return st * 1024 + (ob ^ (((ob >> 9) & 1) << 5)); }
__device__ __forceinline__ void stage_rc(int b, int& R, int& C) { const int st = b / 1024, sb = b % 1024, swz = sb ^ (((sb >> 9) & 1) << 5); R = (st >> 1) * 16 + swz / 64; C = (st & 1) * 32 + (swz % 64) / 2; }
struct Unit { int pm, pn, pg; };
struct Gemm { const bf16_t* A; const bf16_t* Bt; int lda, K, nM, nN, nG; size_t gsA, gsB; };

__device__ __forceinline__ int next_unit(const Gemm& g, int i, int G, int c) {
    const int nwg = g.nM * g.nN, tot = nwg * g.nG;
    const int L = i * G + c; if (L >= tot) return -1;
    int pm, pn, pg;
    if (g.nG > 1) { pg = L / nwg; const int r = L - pg * nwg; pm = r / g.nN; pn = r - pm * g.nN; }
    else {
        int wgid = L; { const int q = nwg / NXCD, r = nwg % NXCD, xcd = wgid % NXCD, off = wgid / NXCD; wgid = (xcd < r ? xcd * (q + 1) : r * (q + 1) + (xcd - r) * q) + off; }
        const int nig = WGM * g.nN, gid = wgid / nig, fm = gid * WGM, gsz = (g.nM - fm) < WGM ? (g.nM - fm) : WGM;
        const int rem = wgid - gid * nig; pn = rem / gsz; pm = fm + (rem - pn * gsz); pg = 0;
    }
    return pm | (pn << 10) | (pg << 20);
}
__device__ __forceinline__ Unit unpack_unit(int v) { Unit u; u.pm = v & 1023; u.pn = (v >> 10) & 1023; u.pg = v >> 20; return u; }

template <class Epi>
__device__ __forceinline__ void gemm_phase(LAS unsigned char* lds, const Gemm g, const Epi& E, const int G, const int c) {
    const int tid = opaque_tid(), wid = __builtin_amdgcn_readfirstlane(tid >> 6), lane = tid & 63, wr = wid >> 2, wc = wid & 3, fr = lane & 15, fq = lane >> 4;
    const int K = g.K, nt = K / BK;
    unsigned voffA[2], voffB[2];
#pragma unroll
    for (int i = 0; i < 2; ++i) { int R, C; stage_rc(tid * 16 + i * 8192, R, C); voffA[i] = (unsigned)(R * g.lda + C) * 2u; voffB[i] = (unsigned)(R * K + C) * 2u; }
    const size_t kstep = (size_t)(BK * 2);
    const size_t hstepA = (size_t)HALF * g.lda * 2, hstepB = (size_t)HALF * K * 2;
    const size_t tstepA = 2 * hstepA, tstepB = 2 * hstepB;
    const unsigned ldsw = (unsigned)wid * 1024u;
    const int aoff = lds_byte(wr * 64 + fr, fq * 8), boff = lds_byte(wc * 32 + fr, fq * 8);
#define PG8_SA(b, h) (((b) * 2 + (h)) * HTB)
#define PG8_SB(b, h) ((4 + (b) * 2 + (h)) * HTB)
#define PG8_STAGE(bufoff, gbase, voff) do { _Pragma("unroll") for (int _i = 0; _i < 2; ++_i) \
        __builtin_amdgcn_global_load_lds((const unsigned*)((const char*)(gbase) + (voff)[_i]), (LAS unsigned*)(lds + (bufoff) + ldsw + _i * 8192), 16, 0, 0); } while (0)
#define PG8_LDA(dst, b, h) do { _Pragma("unroll") for (int m = 0; m < 4; ++m) _Pragma("unroll") for (int k = 0; k < 2; ++k) dst[m][k] = *(const LAS bf16x8*)(lds + PG8_SA(b, h) + aoff + m * 2048 + k * 1024); } while (0)
#define PG8_LDB(dst, b, h) do { _Pragma("unroll") for (int n = 0; n < 2; ++n) _Pragma("unroll") for (int k = 0; k < 2; ++k) dst[n][k] = *(const LAS bf16x8*)(lds + PG8_SB(b, h) + boff + n * 2048 + k * 1024); } while (0)
#define PG8_MMA(ai, bj, At, Bt) do { __builtin_amdgcn_s_setprio(1); _Pragma("unroll") for (int m = 0; m < 4; ++m) _Pragma("unroll") for (int n = 0; n < 2; ++n) _Pragma("unroll") for (int k = 0; k < 2; ++k) \
        acc[ai][bj][m][n] = __builtin_amdgcn_mfma_f32_16x16x32_bf16(Bt[n][k], At[m][k], acc[ai][bj][m][n], 0, 0, 0); __builtin_amdgcn_s_setprio(0); } while (0)
#define PG8_WAIT_V(n) asm volatile("s_waitcnt vmcnt(" #n ")" ::: "memory")
#define PG8_WAIT_L(n) asm volatile("s_waitcnt lgkmcnt(" #n ")" ::: "memory")
#define PG8_BAR __builtin_amdgcn_s_barrier()
#define PG8_SCHED __builtin_amdgcn_sched_barrier(0)
    int ui = 0;
    int curp = next_unit(g, 0, G, c); if (curp < 0) return;
    Unit cur = unpack_unit(curp);
    f32x4 acc[2][2][4][2];
#pragma unroll
    for (int a = 0; a < 2; ++a)
#pragma unroll
        for (int b = 0; b < 2; ++b)
#pragma unroll
            for (int m = 0; m < 4; ++m)
#pragma unroll
                for (int n = 0; n < 2; ++n) acc[a][b][m][n] = (f32x4){0.f, 0.f, 0.f, 0.f};
    bf16x8 At[4][2], B0[2][2], B1[2][2];
    const char* cA = (const char*)(g.A + (size_t)cur.pg * g.gsA) + (size_t)cur.pm * tstepA;
    const char* cB = (const char*)(g.Bt + (size_t)cur.pg * g.gsB) + (size_t)cur.pn * tstepB;
    PG8_STAGE(PG8_SB(0, 0), cB, voffB); PG8_STAGE(PG8_SA(0, 0), cA, voffA); PG8_STAGE(PG8_SB(0, 1), cB + hstepB, voffB); PG8_STAGE(PG8_SA(0, 1), cA + hstepA, voffA);
    if (wr == 1) PG8_BAR;
    PG8_WAIT_V(4); PG8_BAR;
    PG8_STAGE(PG8_SB(1, 0), cB + kstep, voffB); PG8_STAGE(PG8_SA(1, 0), cA + kstep, voffA); PG8_STAGE(PG8_SB(1, 1), cB + hstepB + kstep, voffB);
    PG8_WAIT_V(6); PG8_BAR;
    for (;;) {
        const int nxtp = next_unit(g, ui + 1, G, c); const bool has_next = nxtp >= 0; const Unit nxt = unpack_unit(has_next ? nxtp : curp);
        const char* nA = has_next ? (const char*)(g.A + (size_t)nxt.pg * g.gsA) + (size_t)nxt.pm * tstepA : cA;
        const char* nB = has_next ? (const char*)(g.Bt + (size_t)nxt.pg * g.gsB) + (size_t)nxt.pn * tstepB : cB;
        for (int t = 0; t < nt; t += 2) {
            const bool last = (t == nt - 2);
            const char* a1 = cA + (size_t)(t + 1) * kstep;
            const char* a2 = last ? nA : cA + (size_t)(t + 2) * kstep; const char* b2 = last ? nB : cB + (size_t)(t + 2) * kstep;
            const char* a3 = a2 + kstep; const char* b3 = b2 + kstep;
            PG8_LDB(B0, 0, 0); PG8_SCHED; PG8_LDA(At, 0, 0); PG8_STAGE(PG8_SA(1, 1), a1 + hstepA, voffA);
            PG8_WAIT_L(8); PG8_BAR; PG8_WAIT_L(0); PG8_MMA(0, 0, At, B0); PG8_BAR; PG8_SCHED;
            PG8_LDB(B1, 0, 1); PG8_STAGE(PG8_SB(0, 0), b2, voffB);
            PG8_BAR; PG8_WAIT_L(0); PG8_MMA(0, 1, At, B1); PG8_BAR;
            PG8_LDA(At, 0, 1); PG8_STAGE(PG8_SA(0, 0), a2, voffA);
            PG8_BAR; PG8_WAIT_L(0); PG8_MMA(1, 0, At, B0); PG8_BAR; PG8_SCHED;
            PG8_STAGE(PG8_SB(0, 1), b2 + hstepB, voffB);
            PG8_WAIT_V(6); PG8_BAR; PG8_MMA(1, 1, At, B1); PG8_BAR;
            PG8_LDB(B0, 1, 0); PG8_SCHED; PG8_LDA(At, 1, 0); PG8_STAGE(PG8_SA(0, 1), a2 + hstepA, voffA);
            PG8_WAIT_L(8); PG8_BAR; PG8_WAIT_L(0); PG8_MMA(0, 0, At, B0); PG8_BAR; PG8_SCHED;
            PG8_LDB(B1, 1, 1); PG8_STAGE(PG8_SB(1, 0), b3, voffB);
            PG8_BAR; PG8_WAIT_L(0); PG8_MMA(0, 1, At, B1); PG8_BAR;
            PG8_LDA(At, 1, 1); PG8_STAGE(PG8_SA(1, 0), a3, voffA);
            PG8_BAR; PG8_WAIT_L(0); PG8_MMA(1, 0, At, B0); PG8_BAR; PG8_SCHED;
            PG8_STAGE(PG8_SB(1, 1), b3 + hstepB, voffB);
            PG8_WAIT_V(6); PG8_BAR; PG8_MMA(1, 1, At, B1); PG8_BAR;
        }
        { int efr = fr, efq = fq; asm volatile("" : "+v"(efr), "+v"(efq)); E(acc, cur, wr, wc, efr, efq); }
        if (!has_next) break;
#pragma unroll
        for (int a = 0; a < 2; ++a)
#pragma unroll
            for (int b = 0; b < 2; ++b)
#pragma unroll
                for (int m = 0; m < 4; ++m)
#pragma unroll
                    for (int n = 0; n < 2; ++n) acc[a][b][m][n] = (f32x4){0.f, 0.f, 0.f, 0.f};
        cur = nxt; curp = nxtp; cA = nA; cB = nB; ++ui;
    }
    PG8_WAIT_V(0);
    if (wr == 0) PG8_BAR;
    PG8_BAR;
#undef PG8_SA
#undef PG8_SB
#undef PG8_STAGE
#undef PG8_LDA
#undef PG8_LDB
#undef PG8_MMA
#undef PG8_WAIT_V
#undef PG8_WAIT_L
#undef PG8_BAR
#undef PG8_SCHED
}
}
using pg8::Unit;
typedef f32x4 Acc[2][2][4][2];

struct EpiUp {
    const float* rowpart; bf16_t* hid; int Mv;
    __device__ __forceinline__ void operator()(const Acc& acc, const Unit& u, int wr, int wc, int fr, int fq) const {
#pragma unroll
        for (int ai = 0; ai < 2; ++ai)
#pragma unroll
            for (int m = 0; m < 4; ++m) {
                const int row = u.pm * 256 + ai * 128 + wr * 64 + m * 16 + fr; const int rc = row < Mv ? row : Mv - 1;
                const float rs = row_rstd(rowpart, rc, fq);
#pragma unroll
                for (int bj = 0; bj < 2; ++bj) {
                    const f32x4 gv = acc[ai][bj][m][0] * rs, uv = acc[ai][bj][m][1] * rs;
                    u32x2 w; w.x = pk2(siluf_(gv[0]) * uv[0], siluf_(gv[1]) * uv[1]); w.y = pk2(siluf_(gv[2]) * uv[2], siluf_(gv[3]) * uv[3]);
                    const int col = 128 * u.pn + 64 * bj + 16 * wc + 4 * fq;
                    if (row < Mv) *(u32x2*)(hid + (size_t)row * DFF + col) = w;
                }
            }
    }
};
struct EpiRes {
    float* out; float* metah; bf16_t* hb; float* rowpart; float scale; int Mv;
    __device__ __forceinline__ void operator()(const Acc& acc, const Unit& u, int wr, int wc, int fr, int fq) const {
#pragma unroll
        for (int ai = 0; ai < 2; ++ai)
#pragma unroll
            for (int m = 0; m < 4; ++m) {
                const int row = u.pm * 256 + ai * 128 + wr * 64 + m * 16 + fr; const bool valid = row < Mv; const int rc = valid ? row : Mv - 1;
                float* hp = rc < TR ? out + (size_t)rc * DM : metah + (size_t)(rc - TR) * DM;
                float ss = 0.f;
#pragma unroll
                for (int bj = 0; bj < 2; ++bj)
#pragma unroll
                    for (int n = 0; n < 2; ++n) {
                        const int col = 256 * u.pn + 128 * bj + 32 * wc + 16 * n + 4 * fq;
                        const f32x4 old = *(const f32x4*)(hp + col);
                        const f32x4 nv = old + acc[ai][bj][m][n] * scale;
                        ss += (nv[0] * nv[0] + nv[1] * nv[1]) + (nv[2] * nv[2] + nv[3] * nv[3]);
                        if (valid) { *(f32x4*)(hp + col) = nv; u32x2 w; w.x = pk2(nv[0], nv[1]); w.y = pk2(nv[2], nv[3]); *(u32x2*)(hb + (size_t)row * DM + col) = w; }
                    }
                ss += __shfl_xor(ss, 16); ss += __shfl_xor(ss, 32);
                if (valid && fq == 0) rowpart[(size_t)row * 16 + u.pn * 4 + wc] = ss;
                asm volatile("" ::: "memory");
            }
    }
};
struct EpiProj {
    const float* rowpart; bf16_t* ubuf; bf16_t* q; bf16_t* k; bf16_t* v; bf16_t* r; float* z; int Mv;
    __device__ __forceinline__ void operator()(const Acc& acc, const Unit& u, int wr, int wc, int fr, int fq) const {
        const int pn = u.pn;
#pragma unroll
        for (int ai = 0; ai < 2; ++ai)
#pragma unroll
            for (int m = 0; m < 4; ++m) {
                const int row = u.pm * 256 + ai * 128 + wr * 64 + m * 16 + fr; const bool valid = row < Mv; const int rc = valid ? row : Mv - 1;
                const float rs = row_rstd(rowpart, rc, fq);
                int mm, tt; row_to_mt(rc, mm, tt);
#pragma unroll
                for (int bj = 0; bj < 2; ++bj)
#pragma unroll
                    for (int n = 0; n < 2; ++n) {
                        const f32x4 val = acc[ai][bj][m][n] * rs;
                        const int cl = 128 * bj + 32 * wc + 16 * n + 4 * fq;
                        u32x2 w; w.x = pk2(val[0], val[1]); w.y = pk2(val[2], val[3]);
                        if (!valid) continue;
                        if (pn < 2) { const int cc = 256 * pn + cl; const int gg = cc >> 4, j = cc & 15; *(u32x2*)(ubuf + ((size_t)gg * MCH + mm) * 512 + tt * 16 + j) = w; }
                        else if (pn == 2) *(u32x2*)(q + (size_t)row * 256 + cl) = w;
                        else if (pn == 3) *(u32x2*)(k + (size_t)row * 256 + cl) = w;
                        else if (pn < 6) *(u32x2*)(v + (size_t)row * 512 + (pn - 4) * 256 + cl) = w;
                        else if (pn < 8) *(u32x2*)(r + (size_t)row * 512 + (pn - 6) * 256 + cl) = w;
                        else if (cl < 32) *(f32x4*)(z + (size_t)row * 32 + cl) = val;
                    }
            }
    }
};
struct EpiS5S {
    float* S;
    __device__ __forceinline__ void operator()(const Acc& acc, const Unit& u, int wr, int wc, int fr, int fq) const {
#pragma unroll
        for (int ai = 0; ai < 2; ++ai)
#pragma unroll
            for (int m = 0; m < 4; ++m) {
                const int row = u.pm * 256 + ai * 128 + wr * 64 + m * 16 + fr;
                if (row < MCH) {
#pragma unroll
                    for (int bj = 0; bj < 2; ++bj)
#pragma unroll
                        for (int n = 0; n < 2; ++n) *(f32x4*)(S + ((size_t)u.pg * MCH + row) * 256 + 128 * bj + 32 * wc + 16 * n + 4 * fq) = acc[ai][bj][m][n];
                }
            }
    }
};
struct EpiS5Y {
    bf16_t* y;
    __device__ __forceinline__ void operator()(const Acc& acc, const Unit& u, int wr, int wc, int fr, int fq) const {
#pragma unroll
        for (int ai = 0; ai < 2; ++ai)
#pragma unroll
            for (int m = 0; m < 4; ++m) {
                const int mrow = u.pm * 256 + ai * 128 + wr * 64 + m * 16 + fr;
                if (mrow < MCH) {
                    const int b = mrow >= NCH ? 1 : 0, cch = mrow - b * NCH;
                    const int rbase = cch == 0 ? TR + 16 * b : b * 16384 + 16 * (cch - 1);
#pragma unroll
                    for (int bj = 0; bj < 2; ++bj)
#pragma unroll
                        for (int n = 0; n < 2; ++n) {
                            const int tt = 8 * bj + 2 * wc + n; const f32x4 a = acc[ai][bj][m][n];
                            u32x2 w; w.x = pk2(gelu_tanh(a[0]), gelu_tanh(a[1])); w.y = pk2(gelu_tanh(a[2]), gelu_tanh(a[3]));
                            *(u32x2*)(y + (size_t)(rbase + tt) * 512 + u.pg * 16 + 4 * fq) = w;
                        }
                }
            }
    }
};
struct EpiGlu {
    bf16_t* S; int Mv;
    __device__ __forceinline__ void operator()(const Acc& acc, const Unit& u, int wr, int wc, int fr, int fq) const {
#pragma unroll
        for (int ai = 0; ai < 2; ++ai)
#pragma unroll
            for (int m = 0; m < 4; ++m) {
                const int row = u.pm * 256 + ai * 128 + wr * 64 + m * 16 + fr;
#pragma unroll
                for (int bj = 0; bj < 2; ++bj) {
                    const f32x4 a = acc[ai][bj][m][0], b = acc[ai][bj][m][1];
                    u32x2 w; w.x = pk2(a[0] * sigm(b[0]), a[1] * sigm(b[1])); w.y = pk2(a[2] * sigm(b[2]), a[3] * sigm(b[3]));
                    const int col = 128 * u.pn + 64 * bj + 16 * wc + 4 * fq;
                    if (row < Mv) *(u32x2*)(S + (size_t)row * DM + col) = w;
                }
            }
    }
};
struct EpiBf {
    bf16_t* O; int Mv;
    __device__ __forceinline__ void operator()(const Acc& acc, const Unit& u, int wr, int wc, int fr, int fq) const {
#pragma unroll
        for (int ai = 0; ai < 2; ++ai)
#pragma unroll
            for (int m = 0; m < 4; ++m) {
                const int row = u.pm * 256 + ai * 128 + wr * 64 + m * 16 + fr;
#pragma unroll
                for (int bj = 0; bj < 2; ++bj)
#pragma unroll
                    for (int n = 0; n < 2; ++n) {
                        const f32x4 a = acc[ai][bj][m][n]; u32x2 w; w.x = pk2(a[0], a[1]); w.y = pk2(a[2], a[3]);
                        const int col = 256 * u.pn + 128 * bj + 32 * wc + 16 * n + 4 * fq;
                        if (row < Mv) *(u32x2*)(O + (size_t)row * DM + col) = w;
                    }
            }
    }
};
struct EpiGate {
    const float* rowpart; bf16_t* S; const bf16_t* Gm; int Mv;
    __device__ __forceinline__ void operator()(const Acc& acc, const Unit& u, int wr, int wc, int fr, int fq) const {
#pragma unroll
        for (int ai = 0; ai < 2; ++ai)
#pragma unroll
            for (int m = 0; m < 4; ++m) {
                const int row = u.pm * 256 + ai * 128 + wr * 64 + m * 16 + fr; const bool valid = row < Mv; const int rc = valid ? row : Mv - 1;
                const float rs = row_rstd(rowpart, rc, fq);
#pragma unroll
                for (int bj = 0; bj < 2; ++bj) {
                    const int col = 128 * u.pn + 64 * bj + 16 * wc + 4 * fq;
                    const u32x2 sv = *(const u32x2*)(S + (size_t)rc * DM + col), gv = *(const u32x2*)(Gm + (size_t)rc * DM + col);
                    const f32x4 g0 = acc[ai][bj][m][0] * rs, g1 = acc[ai][bj][m][1] * rs;
#ifdef DBG_NO_GLA
                    const float GW = 0.f; const float SW = 1.f;
#elif defined(DBG_NO_S5)
                    const float GW = 1.f; const float SW = 0.f;
#else
                    const float GW = 1.f; const float SW = 1.f;
#endif
                    const float o0 = SW * sigm(g0[0]) * lo16(sv.x) + GW * sigm(g1[0]) * lo16(gv.x), o1 = SW * sigm(g0[1]) * hi16(sv.x) + GW * sigm(g1[1]) * hi16(gv.x);
                    const float o2 = SW * sigm(g0[2]) * lo16(sv.y) + GW * sigm(g1[2]) * lo16(gv.y), o3 = SW * sigm(g0[3]) * hi16(sv.y) + GW * sigm(g1[3]) * hi16(gv.y);
                    u32x2 w; w.x = pk2(o0, o1); w.y = pk2(o2, o3);
                    if (valid) *(u32x2*)(S + (size_t)row * DM + col) = w;
                }
            }
    }
};

struct CvtJob { const float* s0; const float* s1; const float* scale; bf16_t* dst; int K, N, ld, pair, nvalid, q0, q1; };
__device__ __forceinline__ const float* cvt_map(const CvtJob& j, int c, float& mul) {
    mul = 1.f;
    if (j.pair) { const int col = (c >> 5) * 16 + (c & 15); return ((c >> 4) & 1) ? j.s1 + col : j.s0 + col; }
    if (c >= j.q0 && c < j.q1) mul = 0.125f;
    return c < j.nvalid ? j.s0 + c : nullptr;
}
__device__ __forceinline__ void convert_wt(LAS unsigned char* lds, const CvtJob& j, int G, int c, int& rot) {
    LAS float* tile = (LAS float*)lds;
    const int tid = opaque_tid();
    const int K = j.K, ld = j.ld;
    const int nkt = K / 64, nct = j.N / 64, ntile = nkt * nct;
    for (int ti = (c + G - (rot % G)) % G; ti < ntile; ti += G) {
        const int k0 = (ti % nkt) * 64, c0 = (ti / nkt) * 64;
        {
            const int cq = (tid & 15) * 4; float mul; const float* sp = cvt_map(j, c0 + cq, mul);
#pragma unroll
            for (int ps = 0; ps < 2; ++ps) {
                const int kk = (tid >> 4) + 32 * ps;
                f32x4 v = (f32x4){0.f, 0.f, 0.f, 0.f};
                if (sp) { v = *(const f32x4*)(sp + (size_t)(k0 + kk) * ld); const float sc = (j.scale ? j.scale[k0 + kk] : 1.f) * mul; v = v * sc; }
                tile[kk * 65 + cq + 0] = v[0]; tile[kk * 65 + cq + 1] = v[1]; tile[kk * 65 + cq + 2] = v[2]; tile[kk * 65 + cq + 3] = v[3];
            }
        }
        __syncthreads();
        {
            const int cc = tid >> 3, kq = (tid & 7) * 8;
            u32x4 w;
            w.x = pk2(tile[(kq + 0) * 65 + cc], tile[(kq + 1) * 65 + cc]); w.y = pk2(tile[(kq + 2) * 65 + cc], tile[(kq + 3) * 65 + cc]);
            w.z = pk2(tile[(kq + 4) * 65 + cc], tile[(kq + 5) * 65 + cc]); w.w = pk2(tile[(kq + 6) * 65 + cc], tile[(kq + 7) * 65 + cc]);
            *(u32x4*)(j.dst + (size_t)(c0 + cc) * K + k0 + kq) = w;
        }
        __syncthreads();
    }
    rot += ntile;
}
__device__ __forceinline__ CvtJob make_job(const Params& p, int l, int job) {
    bf16_t* W = (bf16_t*)(p.ws + OFF_W);
    const float* win = p.in[7] + (size_t)l * DM * DIN; const float* wglu = p.in[19] + (size_t)l * 512 * 2048;
    const float* n1 = p.in[2] + (size_t)l * DM; const float* nm = p.in[6] + (size_t)l * DM; const float* n2 = p.in[27] + (size_t)l * DM;
    switch (job) {
    case 0: return CvtJob{p.in[3] + (size_t)l * DM * DFF, p.in[4] + (size_t)l * DM * DFF, n1, W + W_UP1, 1024, 5632, DFF, 1, 0, 0, 0};
    case 1: return CvtJob{p.in[5] + (size_t)l * DFF * DM, nullptr, nullptr, W + W_DN1, 2816, 1024, DM, 0, 1024, 0, 0};
    case 2: return CvtJob{win, nullptr, nm, W + W_INP, 1024, 2304, DIN, 0, 2080, 512, 768};
    case 3: return CvtJob{win + 2080, win + 2080 + 1024, nm, W + W_ING, 1024, 2048, DIN, 1, 0, 0, 0};
    case 4: return CvtJob{wglu, wglu + 1024, nullptr, W + W_GLU, 512, 2048, 2048, 1, 0, 0, 0};
    case 5: return CvtJob{p.in[25] + (size_t)l * 512 * DM, nullptr, nullptr, W + W_O, 512, 1024, DM, 0, 1024, 0, 0};
    case 6: return CvtJob{p.in[26] + (size_t)l * DM * DM, nullptr, nullptr, W + W_OUT, 1024, 1024, DM, 0, 1024, 0, 0};
    case 7: return CvtJob{p.in[28] + (size_t)l * DM * DFF, p.in[29] + (size_t)l * DM * DFF, n2, W + W_UP2, 1024, 5632, DFF, 1, 0, 0, 0};
    default: return CvtJob{p.in[30] + (size_t)l * DFF * DM, nullptr, nullptr, W + W_DN2, 2816, 1024, DM, 0, 1024, 0, 0};
    }
}

__device__ void s5_gen(LAS unsigned char* lds, const Params& p, int l, int g, bf16_t* B1, bf16_t* B2, float* lamtab) {
    const int tid = opaque_tid();
    LAS f32x2* P = (LAS f32x2*)lds;
    LAS f32x2* BB = P + 2 * 17 * 64;
    LAS f32x2* CC = BB + 2 * 64 * 16;
    LAS f32x2* F = CC + 16 * 64;
    LAS float* KT = (LAS float*)(F + 128);
    const float* a_re0 = p.in[8] + (size_t)(l * 32 + g) * 64; const float* a_re1 = p.in[11] + (size_t)(l * 32 + g) * 64;
    const float* a_im0 = p.in[9] + (size_t)(l * 32 + g) * 64; const float* a_im1 = p.in[12] + (size_t)(l * 32 + g) * 64;
    const float ldt0 = p.in[10][l * 32 + g], ldt1 = p.in[13][l * 32 + g];
    const float* b_re = p.in[14] + (size_t)(l * 32 + g) * 1024; const float* b_im = p.in[15] + (size_t)(l * 32 + g) * 1024;
    const float* c_re = p.in[16] + (size_t)(l * 32 + g) * 1024; const float* c_im = p.in[17] + (size_t)(l * 32 + g) * 1024;
    const float* dd = p.in[18] + (size_t)l * 512 + g * 16;
    __syncthreads();
    for (int e = tid; e < 2 * 17 * 64; e += NTHR) {
        const int dir = e / (17 * 64), n = (e / 64) % 17, pp = e & 63;
        const float dt = expf(dir ? ldt1 : ldt0); const float ar = (dir ? a_re1 : a_re0)[pp], ai = (dir ? a_im1 : a_im0)[pp];
        const float mag = expf(ar * dt * (float)n), ang = ai * dt * (float)n;
        P[e] = (f32x2){mag * cosf(ang), mag * sinf(ang)};
    }
    if (tid < 128) {
        const int dir = tid >> 6, pp = tid & 63;
        const float dt = expf(dir ? ldt1 : ldt0); const float ar = (dir ? a_re1 : a_re0)[pp], ai = (dir ? a_im1 : a_im0)[pp];
        const float mag = expf(ar * dt); const float lr = mag * cosf(ai * dt), li = mag * sinf(ai * dt);
        const float den = ar * ar + ai * ai; const float ir = ar / den, ii = -ai / den;
        const float xr = lr - 1.f, xi = li;
        F[tid] = (f32x2){xr * ir - xi * ii, xr * ii + xi * ir};
        const float m16 = expf(ar * dt * 16.f), a16 = ai * dt * 16.f;
        *(f32x2*)(lamtab + ((size_t)(g * 2 + dir) * 64 + pp) * 2) = (f32x2){m16 * cosf(a16), m16 * sinf(a16)};
    }
    for (int e = tid; e < 1024; e += NTHR) { const int i = e >> 6, pp = e & 63; CC[e] = (f32x2){c_re[i * 64 + pp], c_im[i * 64 + pp]}; }
    __syncthreads();
    for (int e = tid; e < 2048; e += NTHR) {
        const int dir = e >> 10, pj = e & 1023, pp = pj >> 4; const f32x2 f = F[dir * 64 + pp]; const float br = b_re[pj], bi = b_im[pj];
        BB[e] = (f32x2){f.x * br - f.y * bi, f.x * bi + f.y * br};
    }
    __syncthreads();
    for (int e = tid; e < 2 * 16 * 256; e += NTHR) {
        const int dir = e >> 12, n = (e >> 8) & 15, i = (e >> 4) & 15, j = e & 15; float s = 0.f;
        for (int pp = 0; pp < 64; ++pp) {
            const f32x2 cv = CC[i * 64 + pp], pv = P[(dir * 17 + n) * 64 + pp], bv = BB[(dir * 64 + pp) * 16 + j];
            const float xr = cv.x * pv.x - cv.y * pv.y, xi = cv.x * pv.y + cv.y * pv.x;
            s += xr * bv.x - xi * bv.y;
        }
        KT[e] = s;
    }
    __syncthreads();
    for (int e = tid; e < 256 * 32; e += NTHR) {
        const int n = e >> 5, k0 = (e & 31) * 8; const int dir = n >> 7, reim = (n >> 6) & 1, pp = n & 63; const int s = k0 >> 4, j0 = k0 & 15;
        const f32x2 pv = P[(dir * 17 + (dir == 0 ? 15 - s : s)) * 64 + pp]; float o[8];
#pragma unroll
        for (int jj = 0; jj < 8; ++jj) { const f32x2 bv = BB[(dir * 64 + pp) * 16 + j0 + jj]; o[jj] = reim == 0 ? pv.x * bv.x - pv.y * bv.y : pv.x * bv.y + pv.y * bv.x; }
        u32x4 w; w.x = pk2(o[0], o[1]); w.y = pk2(o[2], o[3]); w.z = pk2(o[4], o[5]); w.w = pk2(o[6], o[7]);
        *(u32x4*)(B1 + (size_t)n * 256 + k0) = w;
    }
    for (int e = tid; e < 256 * 64; e += NTHR) {
        const int n = e >> 6, k0 = (e & 63) * 8; const int t = n >> 4, i = n & 15; float o[8];
        if (k0 < 256) {
            const int s = k0 >> 4, j0 = k0 & 15;
#pragma unroll
            for (int jj = 0; jj < 8; ++jj) {
                const int j = j0 + jj; float v = 0.f;
                if (t >= s) v += KT[((0 * 16) + (t - s)) * 256 + i * 16 + j];
                if (s >= t) v += KT[((1 * 16) + (s - t)) * 256 + i * 16 + j];
                if (s == t && i == j) v += dd[i];
                o[jj] = v;
            }
        } else {
            const int kk = k0 - 256; const int dir = kk >> 7, reim = (kk >> 6) & 1, p0 = kk & 63; const int pw = dir == 0 ? t + 1 : 16 - t;
#pragma unroll
            for (int jj = 0; jj < 8; ++jj) {
                const f32x2 cv = CC[i * 64 + p0 + jj], pv = P[(dir * 17 + pw) * 64 + p0 + jj];
                o[jj] = reim == 0 ? (cv.x * pv.x - cv.y * pv.y) : -(cv.x * pv.y + cv.y * pv.x);
            }
        }
        u32x4 w; w.x = pk2(o[0], o[1]); w.y = pk2(o[2], o[3]); w.z = pk2(o[4], o[5]); w.w = pk2(o[6], o[7]);
        *(u32x4*)(B2 + (size_t)n * 512 + k0) = w;
    }
    __syncthreads();
}

constexpr int GL_BF = 0, GL_BB = 16384, GL_X = 32768;
__device__ __forceinline__ int gla_row0(int b, int n) { return n == 0 ? TR + 16 * b : b * 16384 + 64 * (n - 1); }
__device__ __forceinline__ void gla_prep(LAS unsigned char* lds, const Params& p, int l, const float* zbuf, int hh, int row0, int ntok) {
    const int tid = opaque_tid();
    LAS float* BF = (LAS float*)(lds + GL_BF); LAS float* BBk = (LAS float*)(lds + GL_BB);
    LAS float* Z = (LAS float*)(lds + GL_X); LAS float* W2 = Z + 2048; LAS float* BI = W2 + 2048;
    {
        const int t = tid >> 3, c4 = (tid & 7) * 4; f32x4 v = (f32x4){0.f, 0.f, 0.f, 0.f};
        if (t < ntok) v = *(const f32x4*)(zbuf + (size_t)(row0 + t) * 32 + c4);
        *(LAS f32x4*)(Z + t * 32 + c4) = v;
    }
    for (int e = tid; e < 2048; e += NTHR) { const int dir = e >> 10, r = (e >> 6) & 15, d = e & 63; W2[e] = (dir ? p.in[22] : p.in[20])[(size_t)l * 16 * 256 + r * 256 + hh * 64 + d]; }
    if (tid < 128) { const int dir = tid >> 6, d = tid & 63; BI[tid] = (dir ? p.in[23] : p.in[21])[l * 256 + hh * 64 + d]; }
    __syncthreads();
    for (int e = tid; e < 8192; e += NTHR) {
        const int dir = e >> 12, t = (e >> 6) & 63, d = e & 63; float x = BI[dir * 64 + d];
#pragma unroll
        for (int r = 0; r < 16; ++r) x += Z[t * 32 + dir * 16 + r] * W2[(dir * 16 + r) * 64 + d];
        const float gg = t < ntok ? logsig(x) * (1.f / 16.f) : 0.f;
        (dir ? BBk : BF)[t * 64 + d] = gg;
    }
    __syncthreads();
    if (tid < 128) {
        const int dir = tid >> 6, d = tid & 63; float s = 0.f;
        if (dir == 0) { for (int t = 0; t < 64; ++t) { s += BF[t * 64 + d]; BF[t * 64 + d] = s; } }
        else { for (int t = 63; t >= 0; --t) { s += BBk[t * 64 + d]; BBk[t * 64 + d] = s; } }
    }
    __syncthreads();
}

__device__ void gla_g1(LAS unsigned char* lds, const Params& p, int l, const bf16_t* kbuf, const bf16_t* vbuf, const float* zbuf, bf16_t* gs, float* dec, int G, int c) {
    const int tid = opaque_tid(), wid = tid >> 6, lane = tid & 63, fr = lane & 15, fq = lane >> 4;
    LAS float* BF = (LAS float*)(lds + GL_BF); LAS float* BBk = (LAS float*)(lds + GL_BB);
    LAS bf16_t* KF = (LAS bf16_t*)(lds + GL_X); LAS bf16_t* KB = KF + 64 * 72; LAS bf16_t* VT = KB + 64 * 72;
    for (int task = c; task < 8 * GCH; task += G) {
        const int n = task % GCH, bh = task / GCH, b = bh >> 2, hh = bh & 3;
        const int row0 = gla_row0(b, n), ntok = n == 0 ? 16 : 64;
        gla_prep(lds, p, l, zbuf, hh, row0, ntok);
        {
            const int t = tid >> 3, d0 = (tid & 7) * 8; u32x4 kv = (u32x4){0u, 0u, 0u, 0u};
            if (t < ntok) kv = *(const u32x4*)(kbuf + (size_t)(row0 + t) * 256 + hh * 64 + d0);
            const unsigned kw[4] = {kv.x, kv.y, kv.z, kv.w};
#pragma unroll
            for (int i = 0; i < 8; ++i) {
                const int d = d0 + i; const float kk = (i & 1) ? hi16(kw[i >> 1]) : lo16(kw[i >> 1]);
                KF[d * 72 + t] = f2bf(kk * __expf(BF[63 * 64 + d] - BF[t * 64 + d]));
                KB[d * 72 + t] = f2bf(kk * __expf(BBk[0 * 64 + d] - BBk[t * 64 + d]));
            }
            const int v0 = (tid & 7) * 16;
#pragma unroll
            for (int hv = 0; hv < 2; ++hv) {
                u32x4 vv = (u32x4){0u, 0u, 0u, 0u};
                if (t < ntok) vv = *(const u32x4*)(vbuf + (size_t)(row0 + t) * 512 + hh * 128 + v0 + hv * 8);
                const unsigned vw[4] = {vv.x, vv.y, vv.z, vv.w};
#pragma unroll
                for (int i = 0; i < 8; ++i) VT[(v0 + hv * 8 + i) * 72 + t] = (bf16_t)((i & 1) ? (vw[i >> 1] >> 16) : (vw[i >> 1] & 0xffffu));
            }
        }
        if (tid < 128) { const int dir = tid >> 6, d = tid & 63; dec[((size_t)(bh * 2 + dir) * GCH + n) * 64 + d] = __expf(dir ? BBk[d] : BF[63 * 64 + d]); }
        __syncthreads();
        {
            const int dir = wid >> 2, dt = wid & 3; LAS bf16_t* KS = dir ? KB : KF;
            const bf16x8 a0 = *(const LAS bf16x8*)(KS + (dt * 16 + fr) * 72 + fq * 8), a1 = *(const LAS bf16x8*)(KS + (dt * 16 + fr) * 72 + 32 + fq * 8);
            bf16_t* dst = gs + ((size_t)(bh * 2 + dir) * GCH + n) * 8192;
#pragma unroll
            for (int vt = 0; vt < 8; ++vt) {
                const bf16x8 b0 = *(const LAS bf16x8*)(VT + (vt * 16 + fr) * 72 + fq * 8), b1 = *(const LAS bf16x8*)(VT + (vt * 16 + fr) * 72 + 32 + fq * 8);
                f32x4 a = (f32x4){0.f, 0.f, 0.f, 0.f};
                a = __builtin_amdgcn_mfma_f32_16x16x32_bf16(a0, b0, a, 0, 0, 0);
                a = __builtin_amdgcn_mfma_f32_16x16x32_bf16(a1, b1, a, 0, 0, 0);
#ifdef DBG_CLAMP
#pragma unroll
                for (int j = 0; j < 4; ++j) { float x = a[j]; x = (x == x) ? x : 0.f; x = fminf(fmaxf(x, -1000.f), 1000.f); a[j] = x; }
#endif
                u32x2 w; w.x = pk2(a[0], a[1]); w.y = pk2(a[2], a[3]);
                *(u32x2*)(dst + (size_t)(vt * 16 + fr) * 64 + dt * 16 + fq * 4) = w;
            }
        }
        __syncthreads();
    }
}

__device__ void gla_g2(bf16_t* gs, const float* dec, int G, int c) {
    const int tid = opaque_tid();
    for (int gid = c * NTHR + tid; gid < 16 * 8192; gid += G * NTHR) {
        const int seq = gid >> 13, e = gid & 8191, d = e & 63, dir = seq & 1;
        bf16_t* base = gs + (size_t)seq * GCH * 8192 + e; const float* db = dec + (size_t)seq * GCH * 64 + d;
        float st = 0.f;
        for (int n0 = 0; n0 < GCH; n0 += 8) {
            float sv[8], dv[8];
#pragma unroll
            for (int i = 0; i < 8; ++i) { const int n = n0 + i; const int nn = dir ? GCH - 1 - n : n; if (n < GCH) { sv[i] = bf2f(base[(size_t)nn * 8192]); dv[i] = db[nn * 64]; } else { sv[i] = 0.f; dv[i] = 0.f; } }
#pragma unroll
            for (int i = 0; i < 8; ++i) { const int n = n0 + i; const int nn = dir ? GCH - 1 - n : n; if (n < GCH) { base[(size_t)nn * 8192] = f2bf(st); st = dv[i] * st + sv[i]; } }
        }
    }
}

constexpr int GL_A1 = GL_X + 18432, GL_B1 = GL_A1 + 25600, GL_RS = GL_B1 + 51200;
static_assert(GL_RS + 512 <= LDS_BYTES, "G3 LDS");
__device__ void gla_g3(LAS unsigned char* lds, const Params& p, int l, const bf16_t* qbuf, const bf16_t* kbuf, const bf16_t* vbuf, const bf16_t* rbuf, const float* zbuf,
                       const bf16_t* gs, bf16_t* obuf, int G, int c) {
    const int tid = opaque_tid(), wid = tid >> 6, lane = tid & 63, fr = lane & 15, fq = lane >> 4;
    LAS float* BF = (LAS float*)(lds + GL_BF); LAS float* BBk = (LAS float*)(lds + GL_BB);
    LAS bf16_t* KDF = (LAS bf16_t*)(lds + GL_X); LAS bf16_t* KDB = KDF + 64 * 72;
    LAS bf16_t* A1 = (LAS bf16_t*)(lds + GL_A1); LAS bf16_t* B1 = (LAS bf16_t*)(lds + GL_B1); LAS float* RS = (LAS float*)(lds + GL_RS);
    const float* gnorm = p.in[24] + (size_t)l * 512;
    for (int task = c; task < 8 * GCH; task += G) {
        const int n = task % GCH, bh = task / GCH, b = bh >> 2, hh = bh & 3;
        const int row0 = gla_row0(b, n), ntok = n == 0 ? 16 : 64;
        gla_prep(lds, p, l, zbuf, hh, row0, ntok);
        {
            const int t = tid >> 3, d0 = (tid & 7) * 8; u32x4 qv = (u32x4){0u, 0u, 0u, 0u}, kv = qv;
            if (t < ntok) { qv = *(const u32x4*)(qbuf + (size_t)(row0 + t) * 256 + hh * 64 + d0); kv = *(const u32x4*)(kbuf + (size_t)(row0 + t) * 256 + hh * 64 + d0); }
            const unsigned qw[4] = {qv.x, qv.y, qv.z, qv.w}, kw[4] = {kv.x, kv.y, kv.z, kv.w};
            unsigned oqf[4], oqb[4], okf[4], okb[4];
#pragma unroll
            for (int i = 0; i < 4; ++i) {
                const int d = d0 + 2 * i; const float bf0 = BF[t * 64 + d], bf1 = BF[t * 64 + d + 1], bb0 = BBk[t * 64 + d], bb1 = BBk[t * 64 + d + 1];
                const float q0 = lo16(qw[i]), q1 = hi16(qw[i]), k0 = lo16(kw[i]), k1 = hi16(kw[i]);
                oqf[i] = pk2(q0 * __expf(bf0), q1 * __expf(bf1)); oqb[i] = pk2(q0 * __expf(bb0), q1 * __expf(bb1));
                okf[i] = pk2(k0 * __expf(-bf0), k1 * __expf(-bf1)); okb[i] = pk2(k0 * __expf(-bb0), k1 * __expf(-bb1));
            }
            *(LAS u32x4*)(A1 + t * 200 + 64 + d0) = (u32x4){oqf[0], oqf[1], oqf[2], oqf[3]};
            *(LAS u32x4*)(A1 + t * 200 + 128 + d0) = (u32x4){oqb[0], oqb[1], oqb[2], oqb[3]};
            *(LAS u32x4*)(KDF + t * 72 + d0) = (u32x4){okf[0], okf[1], okf[2], okf[3]};
            *(LAS u32x4*)(KDB + t * 72 + d0) = (u32x4){okb[0], okb[1], okb[2], okb[3]};
            const int v0 = (tid & 7) * 16;
#pragma unroll
            for (int hv = 0; hv < 2; ++hv) {
                u32x4 vv = (u32x4){0u, 0u, 0u, 0u};
                if (t < ntok) vv = *(const u32x4*)(vbuf + (size_t)(row0 + t) * 512 + hh * 128 + v0 + hv * 8);
                const unsigned vw[4] = {vv.x, vv.y, vv.z, vv.w};
#pragma unroll
                for (int i = 0; i < 8; ++i) B1[(v0 + hv * 8 + i) * 200 + t] = (bf16_t)((i & 1) ? (vw[i >> 1] >> 16) : (vw[i >> 1] & 0xffffu));
            }
            const int vr = tid >> 2, dq = (tid & 3) * 16;
#pragma unroll
            for (int dir = 0; dir < 2; ++dir) {
                const bf16_t* src = gs + ((size_t)(bh * 2 + dir) * GCH + n) * 8192 + vr * 64 + dq;
#ifdef DBG_NO_INTER
                const u32x4 h0 = (u32x4){0u,0u,0u,0u}, h1 = h0; (void)src;
#else
                const u32x4 h0 = *(const u32x4*)src, h1 = *(const u32x4*)(src + 8);
#endif
                *(LAS u32x4*)(B1 + vr * 200 + 64 + dir * 64 + dq) = h0; *(LAS u32x4*)(B1 + vr * 200 + 64 + dir * 64 + dq + 8) = h1;
            }
        }
        __syncthreads();
        {
            const int ti = wid >> 1;
            const bf16x8 qf0 = *(const LAS bf16x8*)(A1 + (ti * 16 + fr) * 200 + 64 + fq * 8), qf1 = *(const LAS bf16x8*)(A1 + (ti * 16 + fr) * 200 + 96 + fq * 8);
            const bf16x8 qb0 = *(const LAS bf16x8*)(A1 + (ti * 16 + fr) * 200 + 128 + fq * 8), qb1 = *(const LAS bf16x8*)(A1 + (ti * 16 + fr) * 200 + 160 + fq * 8);
#pragma unroll
            for (int tj2 = 0; tj2 < 2; ++tj2) {
                const int tj = (wid & 1) * 2 + tj2;
                const bf16x8 kf0 = *(const LAS bf16x8*)(KDF + (tj * 16 + fr) * 72 + fq * 8), kf1 = *(const LAS bf16x8*)(KDF + (tj * 16 + fr) * 72 + 32 + fq * 8);
                const bf16x8 kb0 = *(const LAS bf16x8*)(KDB + (tj * 16 + fr) * 72 + fq * 8), kb1 = *(const LAS bf16x8*)(KDB + (tj * 16 + fr) * 72 + 32 + fq * 8);
                f32x4 sf = (f32x4){0.f, 0.f, 0.f, 0.f}, sb = sf;
                sf = __builtin_amdgcn_mfma_f32_16x16x32_bf16(kf0, qf0, sf, 0, 0, 0); sf = __builtin_amdgcn_mfma_f32_16x16x32_bf16(kf1, qf1, sf, 0, 0, 0);
                sb = __builtin_amdgcn_mfma_f32_16x16x32_bf16(kb0, qb0, sb, 0, 0, 0); sb = __builtin_amdgcn_mfma_f32_16x16x32_bf16(kb1, qb1, sb, 0, 0, 0);
                const int i = ti * 16 + fr, j0 = tj * 16 + fq * 4; float pv[4];
#pragma unroll
                for (int jj = 0; jj < 4; ++jj) pv[jj] = (j0 + jj <= i) ? sf[jj] : sb[jj];
                *(LAS u32x2*)(A1 + i * 200 + j0) = (u32x2){pk2(pv[0], pv[1]), pk2(pv[2], pv[3])};
            }
        }
        __syncthreads();
        {
            const int it = wid & 3, vh = wid >> 2;
            bf16x8 bfr[6];
#pragma unroll
            for (int ks = 0; ks < 6; ++ks) bfr[ks] = *(const LAS bf16x8*)(A1 + (it * 16 + fr) * 200 + ks * 32 + fq * 8);
            f32x4 o[4]; float ss = 0.f;
#pragma unroll
            for (int vt = 0; vt < 4; ++vt) {
                f32x4 a = (f32x4){0.f, 0.f, 0.f, 0.f};
#pragma unroll
                for (int ks = 0; ks < 6; ++ks) { const bf16x8 af = *(const LAS bf16x8*)(B1 + (vh * 64 + vt * 16 + fr) * 200 + ks * 32 + fq * 8); a = __builtin_amdgcn_mfma_f32_16x16x32_bf16(af, bfr[ks], a, 0, 0, 0); }
                o[vt] = a; ss += (a[0] * a[0] + a[1] * a[1]) + (a[2] * a[2] + a[3] * a[3]);
            }
            ss += __shfl_xor(ss, 16); ss += __shfl_xor(ss, 32);
            if (fq == 0) RS[vh * 64 + it * 16 + fr] = ss;
            __syncthreads();
            const int i = it * 16 + fr; const float tot = RS[i] + RS[64 + i]; const float rn = rsqrtf(tot * (1.f / 128.f) + 1e-6f);
            if (i < ntok) {
                const int row = row0 + i;
#pragma unroll
                for (int vt = 0; vt < 4; ++vt) {
                    const int vcol = hh * 128 + vh * 64 + vt * 16 + fq * 4;
                    const f32x4 gn = *(const f32x4*)(gnorm + vcol); const u32x2 rv = *(const u32x2*)(rbuf + (size_t)row * 512 + vcol);
                    const float r0 = lo16(rv.x), r1 = hi16(rv.x), r2 = lo16(rv.y), r3 = hi16(rv.y);
                    u32x2 w; w.x = pk2(o[vt][0] * rn * gn[0] * siluf_(r0), o[vt][1] * rn * gn[1] * siluf_(r1)); w.y = pk2(o[vt][2] * rn * gn[2] * siluf_(r2), o[vt][3] * rn * gn[3] * siluf_(r3));
                    *(u32x2*)(obuf + (size_t)row * 512 + vcol) = w;
                }
            }
        }
        __syncthreads();
    }
}

__device__ void s5_scan(const float* S, bf16_t* ubuf, const float* lamtab, int G, int c) {
    const int tid = opaque_tid();
    for (int idx = c * NTHR + tid; idx < 8192; idx += G * NTHR) {
        const int pp = idx & 63, dir = (idx >> 6) & 1, g = (idx >> 7) & 31, b = idx >> 12;
        const f32x2 lam = *(const f32x2*)(lamtab + ((size_t)(g * 2 + dir) * 64 + pp) * 2);
        const float* sb = S + ((size_t)g * MCH + b * NCH) * 256 + dir * 128 + pp;
        bf16_t* hb = ubuf + ((size_t)g * MCH + b * NCH) * 512 + 256 + dir * 128 + pp;
        float hr = 0.f, hi = 0.f;
        for (int c0 = 0; c0 < NCH; c0 += 8) {
            float sr[8], si[8];
#pragma unroll
            for (int i = 0; i < 8; ++i) { const int cc = c0 + i; const int ch = dir ? NCH - 1 - cc : cc; if (cc < NCH) { sr[i] = sb[(size_t)ch * 256]; si[i] = sb[(size_t)ch * 256 + 64]; } else { sr[i] = 0.f; si[i] = 0.f; } }
#pragma unroll
            for (int i = 0; i < 8; ++i) { const int cc = c0 + i; const int ch = dir ? NCH - 1 - cc : cc;
                if (cc < NCH) { hb[(size_t)ch * 512] = f2bf(hr); hb[(size_t)ch * 512 + 64] = f2bf(hi); const float nr = lam.x * hr - lam.y * hi + sr[i], ni = lam.x * hi + lam.y * hr + si[i]; hr = nr; hi = ni; } }
        }
    }
}

enum { GK_UP1 = 0, GK_DN1, GK_PROJ, GK_S5S, GK_S5Y, GK_GLU, GK_WO, GK_GATE, GK_OUTP, GK_UP2, GK_DN2 };
__device__ __forceinline__ pg8::Gemm make_gemm(int kind, unsigned char* ws) {
    bf16_t* W = (bf16_t*)(ws + OFF_W); const bf16_t* hb = (const bf16_t*)(ws + OFF_HB); const bf16_t* hid = (const bf16_t*)(ws + OFF_HID); const bf16_t* ubuf = (const bf16_t*)(ws + OFF_UBUF);
    switch (kind) {
    case GK_UP1:  return pg8::Gemm{hb, W + W_UP1, 1024, 1024, 129, 22, 1, 0, 0};
    case GK_DN1:  return pg8::Gemm{hid, W + W_DN1, DFF, DFF, 129, 4, 1, 0, 0};
    case GK_PROJ: return pg8::Gemm{hb, W + W_INP, 1024, 1024, 129, 9, 1, 0, 0};
    case GK_S5S:  return pg8::Gemm{ubuf, W + W_S1, 512, 256, 9, 1, 32, (size_t)MCH * 512, (size_t)256 * 256};
    case GK_S5Y:  return pg8::Gemm{ubuf, W + W_S2, 512, 512, 9, 1, 32, (size_t)MCH * 512, (size_t)256 * 512};
    case GK_GLU:  return pg8::Gemm{(const bf16_t*)(ws + OFF_Y), W + W_GLU, 512, 512, 129, 8, 1, 0, 0};
    case GK_WO:   return pg8::Gemm{(const bf16_t*)(ws + OFF_O), W + W_O, 512, 512, 129, 4, 1, 0, 0};
    case GK_GATE: return pg8::Gemm{hb, W + W_ING, 1024, 1024, 129, 8, 1, 0, 0};
    case GK_OUTP: return pg8::Gemm{(const bf16_t*)(ws + OFF_SB), W + W_OUT, 1024, 1024, 129, 4, 1, 0, 0};
    case GK_UP2:  return pg8::Gemm{hb, W + W_UP2, 1024, 1024, 129, 22, 1, 0, 0};
    default:      return pg8::Gemm{hid, W + W_DN2, DFF, DFF, 129, 4, 1, 0, 0};
    }
}
struct EpiSwitch {
    int kind; unsigned char* ws; float* out;
    __device__ __forceinline__ void operator()(const Acc& acc, const Unit& u, int wr, int wc, int fr, int fq) const {
        float* rowpart = (float*)(ws + OFF_ROWPART); bf16_t* hb = (bf16_t*)(ws + OFF_HB); float* metah = (float*)(ws + OFF_METAH);
        switch (kind) {
        case GK_UP1: case GK_UP2: { EpiUp E{rowpart, (bf16_t*)(ws + OFF_HID), T}; E(acc, u, wr, wc, fr, fq); } break;
        case GK_DN1: case GK_DN2: case GK_OUTP: { EpiRes E{out, metah, hb, rowpart, kind == GK_OUTP ? 1.0f : 0.5f, T}; E(acc, u, wr, wc, fr, fq); } break;
        case GK_PROJ: { EpiProj E{rowpart, (bf16_t*)(ws + OFF_UBUF), (bf16_t*)(ws + OFF_Q), (bf16_t*)(ws + OFF_K), (bf16_t*)(ws + OFF_V), (bf16_t*)(ws + OFF_R), (float*)(ws + OFF_Z), T}; E(acc, u, wr, wc, fr, fq); } break;
        case GK_S5S: { EpiS5S E{(float*)(ws + OFF_S5S)}; E(acc, u, wr, wc, fr, fq); } break;
        case GK_S5Y: { EpiS5Y E{(bf16_t*)(ws + OFF_Y)}; E(acc, u, wr, wc, fr, fq); } break;
        case GK_GLU: { EpiGlu E{(bf16_t*)(ws + OFF_SB), T}; E(acc, u, wr, wc, fr, fq); } break;
        case GK_WO: { EpiBf E{(bf16_t*)(ws + OFF_GB), T}; E(acc, u, wr, wc, fr, fq); } break;
        default: { EpiGate E{rowpart, (bf16_t*)(ws + OFF_SB), (const bf16_t*)(ws + OFF_GB), T}; E(acc, u, wr, wc, fr, fq); } break;
        }
    }
};

__device__ __forceinline__ void grid_barrier(unsigned* ctr, unsigned& epoch, int G) {
    asm volatile("s_waitcnt vmcnt(0) lgkmcnt(0)" ::: "memory");
    __syncthreads();
    epoch += 1u;
    if (threadIdx.x < 64) {
        __builtin_amdgcn_fence(__ATOMIC_RELEASE, "agent");
        asm volatile("s_waitcnt vmcnt(0)" ::: "memory");
        if (threadIdx.x == 0) __hip_atomic_fetch_add(ctr, 1u, __ATOMIC_RELAXED, __HIP_MEMORY_SCOPE_AGENT);
        const unsigned target = epoch * (unsigned)G;
        while ((unsigned)__builtin_amdgcn_readfirstlane(__hip_atomic_load(ctr, __ATOMIC_RELAXED, __HIP_MEMORY_SCOPE_AGENT)) < target) __builtin_amdgcn_s_sleep(2);
    }
    __syncthreads();
    __builtin_amdgcn_fence(__ATOMIC_ACQUIRE, "agent");
    asm volatile("s_waitcnt vmcnt(0)" ::: "memory");
}

__global__ void __launch_bounds__(NTHR, 2) fwd_mega(Params p) {
    extern __shared__ __attribute__((aligned(16))) unsigned char lds_raw[];
    LAS unsigned char* lds = (LAS unsigned char*)lds_raw;
    cg::grid_group grid = cg::this_grid();
    const int G = gridDim.x, c = blockIdx.x;
    unsigned char* ws = p.ws;
    float* out = p.out;
    unsigned* bar_ctr = (unsigned*)(ws + OFF_BAR); unsigned epoch = 0;
    grid.sync();

    {
        const int tid_ = opaque_tid(); const int wid = tid_ >> 6, lane = tid_ & 63;
        bf16_t* hb = (bf16_t*)(ws + OFF_HB); float* metah = (float*)(ws + OFF_METAH); float* rowpart = (float*)(ws + OFF_ROWPART);
        for (int row = c * 8 + wid; row < T; row += G * 8) {
            const float* src = row < TR ? p.in[0] + (size_t)row * DM : p.in[1] + (size_t)((row - TR) & 15) * DM;
            float* dst = row < TR ? out + (size_t)row * DM : metah + (size_t)(row - TR) * DM;
            float ss = 0.f;
#pragma unroll
            for (int i = 0; i < 4; ++i) {
                const int col = (i * 64 + lane) * 4; const f32x4 v = *(const f32x4*)(src + col);
                *(f32x4*)(dst + col) = v; u32x2 w; w.x = pk2(v[0], v[1]); w.y = pk2(v[2], v[3]); *(u32x2*)(hb + (size_t)row * DM + col) = w;
                ss += (v[0] * v[0] + v[1] * v[1]) + (v[2] * v[2] + v[3] * v[3]);
            }
#pragma unroll
            for (int o = 32; o >= 1; o >>= 1) ss += __shfl_xor(ss, o);
            if (lane < 16) rowpart[(size_t)row * 16 + lane] = lane == 0 ? ss : 0.f;
        }
    }

    for (int step = 0; step < 24; ++step) {
        const int l = step / 12, s = step % 12;
        if (s == 0) {
            PH(0) {
                int rot = 0;
                for (int job = 0; job < 9; ++job) { const CvtJob j = make_job(p, l, job); convert_wt(lds, j, G, c, rot); }
                bf16_t* W = (bf16_t*)(ws + OFF_W);
                for (int g = c; g < 32; g += G) s5_gen(lds, p, l, g, W + W_S1 + (size_t)g * 256 * 256, W + W_S2 + (size_t)g * 256 * 512, (float*)(ws + OFF_LAM));
            }
        }
        int k0 = -1, k1 = -1;
#ifdef DBG_SKIP_LO
        if (s >= DBG_SKIP_LO && s <= DBG_SKIP_HI) { grid_barrier(bar_ctr, epoch, G); continue; }
#endif
        switch (s) {
        case 1: k0 = GK_UP1; break;
        case 2: k0 = GK_DN1; break;
        case 3: k0 = GK_PROJ; break;
        case 4: k0 = GK_S5S; break;
        case 6: k0 = GK_S5Y; break;
        case 7: k0 = GK_GLU; k1 = GK_WO; break;
        case 8: k0 = GK_GATE; break;
        case 9: k0 = GK_OUTP; break;
        case 10: k0 = GK_UP2; break;
        case 11: k0 = GK_DN2; break;
        default: break;
        }
#ifdef DBG_NO_GLA
        if (k1 == GK_WO) k1 = -1;
#endif
#ifdef DBG_NO_S5
        if (k0 == GK_S5S || k0 == GK_S5Y) k0 = -1;
        if (k0 == GK_GLU) { k0 = k1; k1 = -1; }
#endif
        PH(1) {
            for (int sub = 0; sub < 2; ++sub) {
                const int kk = sub ? k1 : k0;
                if (kk >= 0) { const pg8::Gemm g = make_gemm(kk, ws); const EpiSwitch E{kk, ws, out}; pg8::gemm_phase(lds, g, E, G, sub ? (c + 8) % G : c); }
            }
        }
        if (s == 4) { PH(5) gla_g1(lds, p, l, (const bf16_t*)(ws + OFF_K), (const bf16_t*)(ws + OFF_V), (const float*)(ws + OFF_Z), (bf16_t*)(ws + OFF_GS), (float*)(ws + OFF_DEC), G, (c + 32) % G); }
        if (s == 5) {
            PH(6) s5_scan((const float*)(ws + OFF_S5S), (bf16_t*)(ws + OFF_UBUF), (const float*)(ws + OFF_LAM), G, c);
            PH(7) gla_g2((bf16_t*)(ws + OFF_GS), (const float*)(ws + OFF_DEC), G, c);
        }
        if (s == 6) { PH(9) gla_g3(lds, p, l, (const bf16_t*)(ws + OFF_Q), (const bf16_t*)(ws + OFF_K), (const bf16_t*)(ws + OFF_V), (const bf16_t*)(ws + OFF_R), (const float*)(ws + OFF_Z),
                                   (const bf16_t*)(ws + OFF_GS), (bf16_t*)(ws + OFF_O), G, (c + 32) % G); }
        grid_barrier(bar_ctr, epoch, G);
    }
    {
        const int tid_ = opaque_tid(); const int wid = tid_ >> 6, lane = tid_ & 63;
        const float* gf = p.in[31]; const float* rowpart = (const float*)(ws + OFF_ROWPART);
        for (int row = c * 8 + wid; row < TR; row += G * 8) {
            float s = lane < 16 ? rowpart[(size_t)row * 16 + lane] : 0.f;
#pragma unroll
            for (int o = 8; o >= 1; o >>= 1) s += __shfl_xor(s, o);
            s = __shfl(s, 0);
            const float rs = rsqrtf(s * (1.f / 1024.f) + 1e-6f);
#pragma unroll
            for (int i = 0; i < 4; ++i) { const int col = (i * 64 + lane) * 4; f32x4 v = *(const f32x4*)(out + (size_t)row * DM + col); const f32x4 gv = *(const f32x4*)(gf + col); v = v * rs * gv; *(f32x4*)(out + (size_t)row * DM + col) = v; }
        }
    }
}

extern "C" void kernel_launch(void* const* d_in, const int* in_sizes, int n_in, void* d_out, int out_size, void* d_ws, size_t ws_size, hipStream_t stream) {
    static int grid_blocks = 0;
    if (grid_blocks == 0) {
        if (n_in != 32 || ws_size < WS_END || out_size != TR * DM) { fprintf(stderr, "kernel_launch: unexpected shapes / workspace (%d inputs, ws %zu < %zu)\n", n_in, ws_size, (size_t)WS_END); grid_blocks = -1; return; }
        int dev = 0, cus = 0, per_cu = 0;
        hipGetDevice(&dev); hipDeviceGetAttribute(&cus, hipDeviceAttributeMultiprocessorCount, dev);
        hipFuncSetAttribute((const void*)fwd_mega, hipFuncAttributeMaxDynamicSharedMemorySize, LDS_BYTES);
        hipOccupancyMaxActiveBlocksPerMultiprocessor(&per_cu, (const void*)fwd_mega, NTHR, LDS_BYTES);
        if (per_cu < 1) per_cu = 1;
        if (per_cu > 1) per_cu = 1;
        grid_blocks = cus * per_cu;
    }
    if (grid_blocks < 0) return;
    if (hipMemsetAsync((char*)d_ws + OFF_BAR, 0, 256, stream) != hipSuccess) { fprintf(stderr, "memset failed\n"); return; }
    Params p{};
    for (int i = 0; i < 32; ++i) p.in[i] = (const float*)d_in[i];
    p.out = (float*)d_out; p.ws = (unsigned char*)d_ws;
    void* args[] = {&p};
    hipError_t e = hipLaunchCooperativeKernel((const void*)fwd_mega, dim3(grid_blocks), dim3(NTHR), args, LDS_BYTES, stream);
    if (e != hipSuccess) fprintf(stderr, "cooperative launch failed: %s (grid %d)\n", hipGetErrorString(e), grid_blocks);
}
```

```cpp
#include <hip/hip_runtime.h>
#include <hip/hip_cooperative_groups.h>
#include <cstdio>
namespace cg = cooperative_groups;

#define LAS __attribute__((address_space(3)))
typedef unsigned short bf16_t;
typedef short bf16x8 __attribute__((ext_vector_type(8)));
typedef float f32x4 __attribute__((ext_vector_type(4)));
typedef float f32x2 __attribute__((ext_vector_type(2)));
typedef unsigned u32x4 __attribute__((ext_vector_type(4)));
typedef unsigned u32x2 __attribute__((ext_vector_type(2)));

constexpr int T = 32800, TR = 32768, DM = 1024, DFF = 2816, DIN = 4128;
constexpr int NCH = 1025, MCH = 2050;
constexpr int GCH = 257;
constexpr int NTHR = 512;
constexpr int LDS_BYTES = 131072;

constexpr size_t AL(size_t x) { return (x + 255) & ~size_t(255); }
constexpr size_t SLACK = size_t(2) << 20;
constexpr size_t OFF_HB = 0;
constexpr size_t OFF_METAH = OFF_HB + AL((size_t)T * 1024 * 2) + SLACK;
constexpr size_t OFF_ROWPART = OFF_METAH + 32 * 1024 * 4;
constexpr size_t OFF_LAM = OFF_ROWPART + AL((size_t)T * 16 * 4);
constexpr size_t OFF_W = OFF_LAM + 32 * 2 * 64 * 2 * 4;
constexpr size_t W_UP1 = 0, W_DN1 = W_UP1 + (size_t)5632 * 1024, W_INP = W_DN1 + (size_t)1024 * 2816, W_ING = W_INP + (size_t)2304 * 1024,
                 W_GLU = W_ING + (size_t)2048 * 1024, W_O = W_GLU + (size_t)2048 * 512, W_OUT = W_O + (size_t)1024 * 512,
                 W_UP2 = W_OUT + (size_t)1024 * 1024, W_DN2 = W_UP2 + (size_t)5632 * 1024, W_S1 = W_DN2 + (size_t)1024 * 2816,
                 W_S2 = W_S1 + (size_t)32 * 256 * 256, W_END = W_S2 + (size_t)32 * 256 * 512;
constexpr size_t OFF_R1 = OFF_W + AL(W_END * 2);
constexpr size_t R1_SIZE = AL((size_t)T * 2816 * 2) + SLACK;
constexpr size_t OFF_HID = OFF_R1;
constexpr size_t OFF_UBUF = OFF_R1;
constexpr size_t OFF_Q = OFF_UBUF + AL((size_t)32 * MCH * 512 * 2) + SLACK;
constexpr size_t OFF_K = OFF_Q + AL((size_t)T * 256 * 2);
constexpr size_t OFF_V = OFF_K + AL((size_t)T * 256 * 2);
constexpr size_t OFF_R = OFF_V + AL((size_t)T * 512 * 2);
constexpr size_t OFF_Z = OFF_R + AL((size_t)T * 512 * 2);
constexpr size_t OFF_ZEND = OFF_Z + AL((size_t)T * 32 * 4);
static_assert(OFF_ZEND <= OFF_R1 + R1_SIZE, "R1 overflow");
constexpr size_t OFF_SB = OFF_R1;
constexpr size_t OFF_GB = OFF_SB + AL((size_t)T * 1024 * 2) + SLACK;
static_assert(OFF_GB + AL((size_t)T * 1024 * 2) + SLACK <= OFF_R1 + R1_SIZE, "R1 overflow 2");
constexpr size_t OFF_R2 = OFF_R1 + R1_SIZE;
constexpr size_t OFF_S5S = OFF_R2;
constexpr size_t OFF_Y = OFF_R2;
constexpr size_t OFF_O = OFF_Y + AL((size_t)T * 512 * 2) + SLACK;
constexpr size_t R2A_A = AL((size_t)32 * MCH * 256 * 4), R2A_B = 2 * (AL((size_t)T * 512 * 2) + SLACK);
constexpr size_t R2A_SIZE = R2A_A > R2A_B ? R2A_A : R2A_B;
constexpr size_t OFF_GS = OFF_R2 + R2A_SIZE;
constexpr size_t OFF_DEC = OFF_GS + AL((size_t)4112 * 8192 * 2);
constexpr size_t OFF_BAR = OFF_DEC + AL((size_t)4112 * 64 * 4);
constexpr size_t WS_END = OFF_BAR + 256;

#ifndef PHMASK
#if defined(DBG_NO_GLA)
#define PHMASK 0xFFFD5F
#elif defined(DBG_NO_INTER)
#define PHMASK 0xFFFF1F
#elif defined(DBG_NO_S5)
#define PHMASK 0xFFFFBF
#else
#define PHMASK 0xFFFFFF
#endif
#endif
#define PH(n) if constexpr (((PHMASK) >> (n)) & 1)
struct Params { const float* in[32]; float* out; unsigned char* ws; };

__device__ __forceinline__ float bf2f(bf16_t b) { return __uint_as_float(((unsigned)b) << 16); }
typedef __bf16 bf16x2_t __attribute__((ext_vector_type(2)));
__device__ __forceinline__ unsigned pk2(float lo, float hi) { bf16x2_t v; v.x = (__bf16)lo; v.y = (__bf16)hi; return __builtin_bit_cast(unsigned, v); }
__device__ __forceinline__ bf16_t f2bf(float f) { return (bf16_t)(pk2(f, 0.f) & 0xffffu); }
__device__ __forceinline__ float sigm(float x) { return __builtin_amdgcn_rcpf(1.f + __expf(-x)); }
__device__ __forceinline__ float siluf_(float x) { return x * sigm(x); }
__device__ __forceinline__ float gelu_tanh(float x) { const float u = 0.7978845608028654f * (x + 0.044715f * x * x * x); return x * sigm(2.f * u); }
__device__ __forceinline__ float logsig(float x) { return fminf(x, 0.f) - log1pf(__expf(-fabsf(x))); }
__device__ __forceinline__ float lo16(unsigned w) { return __uint_as_float(w << 16); }
__device__ __forceinline__ float hi16(unsigned w) { return __uint_as_float(w & 0xffff0000u); }
__device__ __forceinline__ float row_rstd(const float* rowpart, int rowc, int fq) {
    const f32x4 p = *(const f32x4*)(rowpart + (size_t)rowc * 16 + 4 * fq);
    float s = (p[0] + p[1]) + (p[2] + p[3]);
    s += __shfl_xor(s, 16); s += __shfl_xor(s, 32);
    return rsqrtf(s * (1.f / 1024.f) + 1e-6f);
}
__device__ __forceinline__ float rstd_finish(const f32x4 p) {
    float s = (p[0] + p[1]) + (p[2] + p[3]);
    s += __shfl_xor(s, 16); s += __shfl_xor(s, 32);
    return rsqrtf(s * (1.f / 1024.f) + 1e-6f);
}
#define LOAD_RS8(rs, rowpart, u, wr, fr, fq, Mv) float rs[2][4]; { f32x4 _p[2][4]; \
    _Pragma("unroll") for (int ai = 0; ai < 2; ++ai) _Pragma("unroll") for (int m = 0; m < 4; ++m) { const int _r = (u).pm * 256 + ai * 128 + (wr) * 64 + m * 16 + (fr); const int _rc = _r < (Mv) ? _r : (Mv) - 1; \
        _p[ai][m] = *(const f32x4*)((rowpart) + (size_t)_rc * 16 + 4 * (fq)); } \
    _Pragma("unroll") for (int ai = 0; ai < 2; ++ai) _Pragma("unroll") for (int m = 0; m < 4; ++m) rs[ai][m] = rstd_finish(_p[ai][m]); }
__device__ __forceinline__ int opaque_tid() { int t = threadIdx.x; asm volatile("" : "+v"(t)); return t; }
__device__ __forceinline__ void row_to_mt(int row, int& m, int& t) {
    if (row < TR) { const int b = row >> 14, s = row & 16383, p = s + 16; m = b * NCH + (p >> 4); t = p & 15; }
    else { const int rr = row - TR; m = (rr >> 4) * NCH; t = rr & 15; }
}

namespace pg8 {
constexpr int BM = 256, BK = 64, HALF = 128, HTB = HALF * BK * 2, NXCD = 8, WGM = 8;
__device__ __forceinline__ int lds_byte(int r, int c) { const int st = (r >> 4) * 2 + (c >> 5), rr = r & 15, cc = c & 31, ob = rr * 64 + cc * 2; return st * 1024 + (ob ^ (((ob >> 9) & 1) << 5)); }
__device__ __forceinline__ void stage_rc(int b, int& R, int& C) { const int st = b / 1024, sb = b % 1024, swz = sb ^ (((sb >> 9) & 1) << 5); R = (st >> 1) * 16 + swz / 64; C = (st & 1) * 32 + (swz % 64) / 2; }
struct Unit { int pm, pn, pg; };
struct Gemm { const bf16_t* A; const bf16_t* Bt; int lda, K, nM, nN, nG; size_t gsA, gsB; int tail; };

__device__ __forceinline__ int next_unit(const Gemm& g, int i, int G, int c) {
    const int nwg = g.nM * g.nN, tot = nwg * g.nG;
    const int L = i * G + c; if (L >= tot) return -1;
    int pm, pn, pg;
    if (g.nG > 1) { pg = L / nwg; const int r = L - pg * nwg; pm = r / g.nN; pn = r - pm * g.nN; }
    else {
        int wgid = L; { const int q = nwg / NXCD, r = nwg % NXCD, xcd = wgid % NXCD, off = wgid / NXCD; wgid = (xcd < r ? xcd * (q + 1) : r * (q + 1) + (xcd - r) * q) + off; }
        const int nig = WGM * g.nN, gid = wgid / nig, fm = gid * WGM, gsz = (g.nM - fm) < WGM ? (g.nM - fm) : WGM;
        const int rem = wgid - gid * nig; pn = rem / gsz; pm = fm + (rem - pn * gsz); pg = 0;
    }
    return pm | (pn << 10) | (pg << 20);
}
__device__ __forceinline__ Unit unpack_unit(int v) { Unit u; u.pm = v & 1023; u.pn = (v >> 10) & 1023; u.pg = v >> 20; return u; }

template <class Epi>
__device__ __forceinline__ void gemm_phase(LAS unsigned char* lds, const Gemm g, const Epi& E, const int G, const int c) {
    const int tid = opaque_tid(), wid = __builtin_amdgcn_readfirstlane(tid >> 6), lane = tid & 63, wr = wid >> 2, wc = wid & 3, fr = lane & 15, fq = lane >> 4;
    const int K = g.K, nt = K / BK;
    unsigned voffA[2], voffB[2];
#pragma unroll
    for (int i = 0; i < 2; ++i) { int R, C; stage_rc(tid * 16 + i * 8192, R, C); voffA[i] = (unsigned)(R * g.lda + C) * 2u; voffB[i] = (unsigned)(R * K + C) * 2u; }
    const size_t kstep = (size_t)(BK * 2);
    const size_t hstepA = (size_t)HALF * g.lda * 2, hstepB = (size_t)HALF * K * 2;
    const size_t tstepA = 2 * hstepA, tstepB = 2 * hstepB;
    const unsigned ldsw = (unsigned)wid * 1024u;
    const int aoff = lds_byte(wr * 64 + fr, fq * 8), boff = lds_byte(wc * 32 + fr, fq * 8);
#define PG8_SA(b, h) (((b) * 2 + (h)) * HTB)
#define PG8_SB(b, h) ((4 + (b) * 2 + (h)) * HTB)
#define PG8_STAGE(bufoff, gbase, voff) do { _Pragma("unroll") for (int _i = 0; _i < 2; ++_i) \
        __builtin_amdgcn_global_load_lds((const unsigned*)((const char*)(gbase) + (voff)[_i]), (LAS unsigned*)(lds + (bufoff) + ldsw + _i * 8192), 16, 0, 0); } while (0)
#define PG8_LDA(dst, b, h) do { _Pragma("unroll") for (int m = 0; m < 4; ++m) _Pragma("unroll") for (int k = 0; k < 2; ++k) dst[m][k] = *(const LAS bf16x8*)(lds + PG8_SA(b, h) + aoff + m * 2048 + k * 1024); } while (0)
#define PG8_LDB(dst, b, h) do { _Pragma("unroll") for (int n = 0; n < 2; ++n) _Pragma("unroll") for (int k = 0; k < 2; ++k) dst[n][k] = *(const LAS bf16x8*)(lds + PG8_SB(b, h) + boff + n * 2048 + k * 1024); } while (0)
#define PG8_MMA(ai, bj, At, Bt) do { __builtin_amdgcn_s_setprio(1); _Pragma("unroll") for (int m = 0; m < 4; ++m) _Pragma("unroll") for (int n = 0; n < 2; ++n) _Pragma("unroll") for (int k = 0; k < 2; ++k) \
        acc[ai][bj][m][n] = __builtin_amdgcn_mfma_f32_16x16x32_bf16(Bt[n][k], At[m][k], acc[ai][bj][m][n], 0, 0, 0); __builtin_amdgcn_s_setprio(0); } while (0)
#define PG8_WAIT_V(n) asm volatile("s_waitcnt vmcnt(" #n ")" ::: "memory")
#define PG8_WAIT_L(n) asm volatile("s_waitcnt lgkmcnt(" #n ")" ::: "memory")
#define PG8_BAR __builtin_amdgcn_s_barrier()
#define PG8_SCHED __builtin_amdgcn_sched_barrier(0)
    int ui = 0;
    int curp = next_unit(g, 0, G, c);
    Unit cur = unpack_unit(curp < 0 ? 0 : curp);
    f32x4 acc[2][2][4][2];
#pragma unroll
    for (int a = 0; a < 2; ++a)
#pragma unroll
        for (int b = 0; b < 2; ++b)
#pragma unroll
            for (int m = 0; m < 4; ++m)
#pragma unroll
                for (int n = 0; n < 2; ++n) acc[a][b][m][n] = (f32x4){0.f, 0.f, 0.f, 0.f};
    if (curp >= 0) {
    bf16x8 At[4][2], B0[2][2], B1[2][2];
    const char* cA = (const char*)(g.A + (size_t)cur.pg * g.gsA) + (size_t)cur.pm * tstepA;
    const char* cB = (const char*)(g.Bt + (size_t)cur.pg * g.gsB) + (size_t)cur.pn * tstepB;
    PG8_STAGE(PG8_SB(0, 0), cB, voffB); PG8_STAGE(PG8_SA(0, 0), cA, voffA); PG8_STAGE(PG8_SB(0, 1), cB + hstepB, voffB); PG8_STAGE(PG8_SA(0, 1), cA + hstepA, voffA);
    if (wr == 1) PG8_BAR;
    PG8_WAIT_V(4); PG8_BAR;
    PG8_STAGE(PG8_SB(1, 0), cB + kstep, voffB); PG8_STAGE(PG8_SA(1, 0), cA + kstep, voffA); PG8_STAGE(PG8_SB(1, 1), cB + hstepB + kstep, voffB);
    PG8_WAIT_V(6); PG8_BAR;
    for (;;) {
        const int nxtp = next_unit(g, ui + 1, G, c); const bool has_next = nxtp >= 0; const Unit nxt = unpack_unit(has_next ? nxtp : curp);
        const char* nA = has_next ? (const char*)(g.A + (size_t)nxt.pg * g.gsA) + (size_t)nxt.pm * tstepA : cA;
        const char* nB = has_next ? (const char*)(g.Bt + (size_t)nxt.pg * g.gsB) + (size_t)nxt.pn * tstepB : cB;
        for (int t = 0; t < nt; t += 2) {
            const bool last = (t == nt - 2);
            const char* a1 = cA + (size_t)(t + 1) * kstep;
            const char* a2 = last ? nA : cA + (size_t)(t + 2) * kstep; const char* b2 = last ? nB : cB + (size_t)(t + 2) * kstep;
            const char* a3 = a2 + kstep; const char* b3 = b2 + kstep;
            PG8_LDB(B0, 0, 0); PG8_SCHED; PG8_LDA(At, 0, 0); PG8_STAGE(PG8_SA(1, 1), a1 + hstepA, voffA);
            PG8_WAIT_L(8); PG8_BAR; PG8_WAIT_L(0); PG8_MMA(0, 0, At, B0); PG8_BAR; PG8_SCHED;
            PG8_LDB(B1, 0, 1); PG8_STAGE(PG8_SB(0, 0), b2, voffB);
            PG8_BAR; PG8_WAIT_L(0); PG8_MMA(0, 1, At, B1); PG8_BAR;
            PG8_LDA(At, 0, 1); PG8_STAGE(PG8_SA(0, 0), a2, voffA);
            PG8_BAR; PG8_WAIT_L(0); PG8_MMA(1, 0, At, B0); PG8_BAR; PG8_SCHED;
            PG8_STAGE(PG8_SB(0, 1), b2 + hstepB, voffB);
            PG8_WAIT_V(6); PG8_BAR; PG8_MMA(1, 1, At, B1); PG8_BAR;
            PG8_LDB(B0, 1, 0); PG8_SCHED; PG8_LDA(At, 1, 0); PG8_STAGE(PG8_SA(0, 1), a2 + hstepA, voffA);
            PG8_WAIT_L(8); PG8_BAR; PG8_WAIT_L(0); PG8_MMA(0, 0, At, B0); PG8_BAR; PG8_SCHED;
            PG8_LDB(B1, 1, 1); PG8_STAGE(PG8_SB(1, 0), b3, voffB);
            PG8_BAR; PG8_WAIT_L(0); PG8_MMA(0, 1, At, B1); PG8_BAR;
            PG8_LDA(At, 1, 1); PG8_STAGE(PG8_SA(1, 0), a3, voffA);
            PG8_BAR; PG8_WAIT_L(0); PG8_MMA(1, 0, At, B0); PG8_BAR; PG8_SCHED;
            PG8_STAGE(PG8_SB(1, 1), b3 + hstepB, voffB);
            PG8_WAIT_V(6); PG8_BAR; PG8_MMA(1, 1, At, B1); PG8_BAR;
        }
        { int efr = fr, efq = fq; asm volatile("" : "+v"(efr), "+v"(efq)); E(acc, cur, wr, wc, efr, efq); }
        if (!has_next) break;
#pragma unroll
        for (int a = 0; a < 2; ++a)
#pragma unroll
            for (int b = 0; b < 2; ++b)
#pragma unroll
                for (int m = 0; m < 4; ++m)
#pragma unroll
                    for (int n = 0; n < 2; ++n) acc[a][b][m][n] = (f32x4){0.f, 0.f, 0.f, 0.f};
        cur = nxt; curp = nxtp; cA = nA; cB = nB; ++ui;
    }
    PG8_WAIT_V(0);
    if (wr == 0) PG8_BAR;
    PG8_BAR;
    }
    if (g.tail) {
        const int kh = K >> 1;
        for (int j = G - 1 - c; j < g.nN; j += G) {
#pragma unroll
            for (int a = 0; a < 2; ++a)
#pragma unroll
                for (int b = 0; b < 2; ++b)
#pragma unroll
                    for (int m = 0; m < 4; ++m)
#pragma unroll
                        for (int n = 0; n < 2; ++n) acc[a][b][m][n] = (f32x4){0.f, 0.f, 0.f, 0.f};
            const bf16_t* Ap = g.A + (size_t)(g.nM * 256 + fr) * g.lda + wr * kh + fq * 8;
            const bf16_t* Bp = g.Bt + (size_t)(j * 256 + wc * 32 + fr) * K + wr * kh + fq * 8;
            const size_t a16 = (size_t)16 * g.lda, b16 = (size_t)16 * K, b128 = (size_t)128 * K;
            for (int k = 0; k < kh; k += 128) {
                bf16x8 av[4][2], bv[4][4];
#pragma unroll
                for (int q = 0; q < 4; ++q) {
                    av[q][0] = *(const bf16x8*)(Ap + k + q * 32); av[q][1] = *(const bf16x8*)(Ap + a16 + k + q * 32);
                    bv[q][0] = *(const bf16x8*)(Bp + k + q * 32); bv[q][1] = *(const bf16x8*)(Bp + b16 + k + q * 32);
                    bv[q][2] = *(const bf16x8*)(Bp + b128 + k + q * 32); bv[q][3] = *(const bf16x8*)(Bp + b128 + b16 + k + q * 32);
                }
#pragma unroll
                for (int q = 0; q < 4; ++q) {
                    acc[0][0][0][0] = __builtin_amdgcn_mfma_f32_16x16x32_bf16(bv[q][0], av[q][0], acc[0][0][0][0], 0, 0, 0);
                    acc[0][0][1][0] = __builtin_amdgcn_mfma_f32_16x16x32_bf16(bv[q][0], av[q][1], acc[0][0][1][0], 0, 0, 0);
                    acc[0][0][0][1] = __builtin_amdgcn_mfma_f32_16x16x32_bf16(bv[q][1], av[q][0], acc[0][0][0][1], 0, 0, 0);
                    acc[0][0][1][1] = __builtin_amdgcn_mfma_f32_16x16x32_bf16(bv[q][1], av[q][1], acc[0][0][1][1], 0, 0, 0);
                    acc[0][1][0][0] = __builtin_amdgcn_mfma_f32_16x16x32_bf16(bv[q][2], av[q][0], acc[0][1][0][0], 0, 0, 0);
                    acc[0][1][1][0] = __builtin_amdgcn_mfma_f32_16x16x32_bf16(bv[q][2], av[q][1], acc[0][1][1][0], 0, 0, 0);
                    acc[0][1][0][1] = __builtin_amdgcn_mfma_f32_16x16x32_bf16(bv[q][3], av[q][0], acc[0][1][0][1], 0, 0, 0);
                    acc[0][1][1][1] = __builtin_amdgcn_mfma_f32_16x16x32_bf16(bv[q][3], av[q][1], acc[0][1][1][1], 0, 0, 0);
                }
            }
            LAS f32x4* red = (LAS f32x4*)lds;
            if (wr == 1) {
#pragma unroll
                for (int bj = 0; bj < 2; ++bj)
#pragma unroll
                    for (int m = 0; m < 2; ++m)
#pragma unroll
                        for (int n = 0; n < 2; ++n) { red[(wc * 8 + bj * 4 + m * 2 + n) * 64 + lane] = acc[0][bj][m][n]; acc[0][bj][m][n] = (f32x4){0.f, 0.f, 0.f, 0.f}; }
            }
            __syncthreads();
            if (wr == 0) {
#pragma unroll
                for (int bj = 0; bj < 2; ++bj)
#pragma unroll
                    for (int m = 0; m < 2; ++m)
#pragma unroll
                        for (int n = 0; n < 2; ++n) acc[0][bj][m][n] += red[(wc * 8 + bj * 4 + m * 2 + n) * 64 + lane];
            }
            { Unit tu; tu.pm = g.nM; tu.pn = j; tu.pg = 0; int efr = fr, efq = fq; asm volatile("" : "+v"(efr), "+v"(efq)); E(acc, tu, wr, wc, efr, efq); }
            __syncthreads();
        }
    }
#undef PG8_SA
#undef PG8_SB
#undef PG8_STAGE
#undef PG8_LDA
#undef PG8_LDB
#undef PG8_MMA
#undef PG8_WAIT_V
#undef PG8_WAIT_L
#undef PG8_BAR
#undef PG8_SCHED
}
}
using pg8::Unit;
typedef f32x4 Acc[2][2][4][2];

struct EpiUp {
    const float* rowpart; bf16_t* hid; int Mv;
    __device__ __forceinline__ void operator()(const Acc& acc, const Unit& u, int wr, int wc, int fr, int fq) const {
        LOAD_RS8(rsv, rowpart, u, wr, fr, fq, Mv)
#pragma unroll
        for (int ai = 0; ai < 2; ++ai)
#pragma unroll
            for (int m = 0; m < 4; ++m) {
                const int row = u.pm * 256 + ai * 128 + wr * 64 + m * 16 + fr;
                const float rs = rsv[ai][m];
#pragma unroll
                for (int bj = 0; bj < 2; ++bj) {
                    const f32x4 gv = acc[ai][bj][m][0] * rs, uv = acc[ai][bj][m][1] * rs;
                    u32x2 w; w.x = pk2(siluf_(gv[0]) * uv[0], siluf_(gv[1]) * uv[1]); w.y = pk2(siluf_(gv[2]) * uv[2], siluf_(gv[3]) * uv[3]);
                    const int col = 128 * u.pn + 64 * bj + 16 * wc + 4 * fq;
                    if (row < Mv) *(u32x2*)(hid + (size_t)row * DFF + col) = w;
                }
            }
    }
};
struct EpiRes {
    float* out; float* metah; bf16_t* hb; float* rowpart; float scale; int Mv;
    __device__ __forceinline__ void operator()(const Acc& acc, const Unit& u, int wr, int wc, int fr, int fq) const {
#pragma unroll
        for (int ai = 0; ai < 2; ++ai)
#pragma unroll
            for (int mh = 0; mh < 2; ++mh) {
                f32x4 old[2][2][2];
#pragma unroll
                for (int m2 = 0; m2 < 2; ++m2) {
                    const int m = mh * 2 + m2; const int row = u.pm * 256 + ai * 128 + wr * 64 + m * 16 + fr; const int rc = row < Mv ? row : Mv - 1;
                    const float* hp = rc < TR ? out + (size_t)rc * DM : metah + (size_t)(rc - TR) * DM;
#pragma unroll
                    for (int bj = 0; bj < 2; ++bj)
#pragma unroll
                        for (int n = 0; n < 2; ++n) old[m2][bj][n] = *(const f32x4*)(hp + 256 * u.pn + 128 * bj + 32 * wc + 16 * n + 4 * fq);
                }
#pragma unroll
                for (int m2 = 0; m2 < 2; ++m2) {
                    const int m = mh * 2 + m2; const int row = u.pm * 256 + ai * 128 + wr * 64 + m * 16 + fr; const bool valid = row < Mv; const int rc = valid ? row : Mv - 1;
                    float* hp = rc < TR ? out + (size_t)rc * DM : metah + (size_t)(rc - TR) * DM;
                    float ss = 0.f;
#pragma unroll
                    for (int bj = 0; bj < 2; ++bj)
#pragma unroll
                        for (int n = 0; n < 2; ++n) {
                            const int col = 256 * u.pn + 128 * bj + 32 * wc + 16 * n + 4 * fq;
                            const f32x4 nv = old[m2][bj][n] + acc[ai][bj][m][n] * scale;
                            ss += (nv[0] * nv[0] + nv[1] * nv[1]) + (nv[2] * nv[2] + nv[3] * nv[3]);
                            if (valid) { *(f32x4*)(hp + col) = nv; u32x2 w; w.x = pk2(nv[0], nv[1]); w.y = pk2(nv[2], nv[3]); *(u32x2*)(hb + (size_t)row * DM + col) = w; }
                        }
                    ss += __shfl_xor(ss, 16); ss += __shfl_xor(ss, 32);
                    if (valid && fq == 0) rowpart[(size_t)row * 16 + u.pn * 4 + wc] = ss;
                }
                asm volatile("" ::: "memory");
            }
    }
};
struct EpiProj {
    const float* rowpart; bf16_t* ubuf; bf16_t* q; bf16_t* k; bf16_t* v; bf16_t* r; float* z; int Mv;
    __device__ __forceinline__ void operator()(const Acc& acc, const Unit& u, int wr, int wc, int fr, int fq) const {
        const int pn = u.pn;
        LOAD_RS8(rsv, rowpart, u, wr, fr, fq, Mv)
#pragma unroll
        for (int ai = 0; ai < 2; ++ai)
#pragma unroll
            for (int m = 0; m < 4; ++m) {
                const int row = u.pm * 256 + ai * 128 + wr * 64 + m * 16 + fr; const bool valid = row < Mv; const int rc = valid ? row : Mv - 1;
                const float rs = rsv[ai][m];
                int mm, tt; row_to_mt(rc, mm, tt);
#pragma unroll
                for (int bj = 0; bj < 2; ++bj)
#pragma unroll
                    for (int n = 0; n < 2; ++n) {
                        const f32x4 val = acc[ai][bj][m][n] * rs;
                        const int cl = 128 * bj + 32 * wc + 16 * n + 4 * fq;
                        u32x2 w; w.x = pk2(val[0], val[1]); w.y = pk2(val[2], val[3]);
                        if (!valid) continue;
                        if (pn < 2) { const int cc = 256 * pn + cl; const int gg = cc >> 4, j = cc & 15; *(u32x2*)(ubuf + ((size_t)gg * MCH + mm) * 512 + tt * 16 + j) = w; }
                        else if (pn == 2) *(u32x2*)(q + (size_t)row * 256 + cl) = w;
                        else if (pn == 3) *(u32x2*)(k + (size_t)row * 256 + cl) = w;
                        else if (pn < 6) *(u32x2*)(v + (size_t)row * 512 + (pn - 4) * 256 + cl) = w;
                        else if (pn < 8) *(u32x2*)(r + (size_t)row * 512 + (pn - 6) * 256 + cl) = w;
                        else if (cl < 32) *(f32x4*)(z + (size_t)row * 32 + cl) = val;
                    }
            }
    }
};
struct EpiS5S {
    float* S;
    __device__ __forceinline__ void operator()(const Acc& acc, const Unit& u, int wr, int wc, int fr, int fq) const {
#pragma unroll
        for (int ai = 0; ai < 2; ++ai)
#pragma unroll
            for (int m = 0; m < 4; ++m) {
                const int row = u.pm * 256 + ai * 128 + wr * 64 + m * 16 + fr;
                if (row < MCH) {
#pragma unroll
                    for (int bj = 0; bj < 2; ++bj)
#pragma unroll
                        for (int n = 0; n < 2; ++n) *(f32x4*)(S + ((size_t)u.pg * MCH + row) * 256 + 128 * bj + 32 * wc + 16 * n + 4 * fq) = acc[ai][bj][m][n];
                }
            }
    }
};
struct EpiS5Y {
    bf16_t* y;
    __device__ __forceinline__ void operator()(const Acc& acc, const Unit& u, int wr, int wc, int fr, int fq) const {
#pragma unroll
        for (int ai = 0; ai < 2; ++ai)
#pragma unroll
            for (int m = 0; m < 4; ++m) {
                const int mrow = u.pm * 256 + ai * 128 + wr * 64 + m * 16 + fr;
                if (mrow < MCH) {
                    const int b = mrow >= NCH ? 1 : 0, cch = mrow - b * NCH;
                    const int rbase = cch == 0 ? TR + 16 * b : b * 16384 + 16 * (cch - 1);
#pragma unroll
                    for (int bj = 0; bj < 2; ++bj)
#pragma unroll
                        for (int n = 0; n < 2; ++n) {
                            const int tt = 8 * bj + 2 * wc + n; const f32x4 a = acc[ai][bj][m][n];
                            u32x2 w; w.x = pk2(gelu_tanh(a[0]), gelu_tanh(a[1])); w.y = pk2(gelu_tanh(a[2]), gelu_tanh(a[3]));
                            *(u32x2*)(y + (size_t)(rbase + tt) * 512 + u.pg * 16 + 4 * fq) = w;
                        }
                }
            }
    }
};
struct EpiGlu {
    bf16_t* S; int Mv;
    __device__ __forceinline__ void operator()(const Acc& acc, const Unit& u, int wr, int wc, int fr, int fq) const {
#pragma unroll
        for (int ai = 0; ai < 2; ++ai)
#pragma unroll
            for (int m = 0; m < 4; ++m) {
                const int row = u.pm * 256 + ai * 128 + wr * 64 + m * 16 + fr;
#pragma unroll
                for (int bj = 0; bj < 2; ++bj) {
                    const f32x4 a = acc[ai][bj][m][0], b = acc[ai][bj][m][1];
                    u32x2 w; w.x = pk2(a[0] * sigm(b[0]), a[1] * sigm(b[1])); w.y = pk2(a[2] * sigm(b[2]), a[3] * sigm(b[3]));
                    const int col = 128 * u.pn + 64 * bj + 16 * wc + 4 * fq;
                    if (row < Mv) *(u32x2*)(S + (size_t)row * DM + col) = w;
                }
            }
    }
};
struct EpiBf {
    bf16_t* O; int Mv;
    __device__ __forceinline__ void operator()(const Acc& acc, const Unit& u, int wr, int wc, int fr, int fq) const {
#pragma unroll
        for (int ai = 0; ai < 2; ++ai)
#pragma unroll
            for (int m = 0; m < 4; ++m) {
                const int row = u.pm * 256 + ai * 128 + wr * 64 + m * 16 + fr;
#pragma unroll
                for (int bj = 0; bj < 2; ++bj)
#pragma unroll
                    for (int n = 0; n < 2; ++n) {
                        const f32x4 a = acc[ai][bj][m][n]; u32x2 w; w.x = pk2(a[0], a[1]); w.y = pk2(a[2], a[3]);
                        const int col = 256 * u.pn + 128 * bj + 32 * wc + 16 * n + 4 * fq;
                        if (row < Mv) *(u32x2*)(O + (size_t)row * DM + col) = w;
                    }
            }
    }
};
struct EpiGate {
    const float* rowpart; bf16_t* S; const bf16_t* Gm; int Mv;
    __device__ __forceinline__ void operator()(const Acc& acc, const Unit& u, int wr, int wc, int fr, int fq) const {
        LOAD_RS8(rsv, rowpart, u, wr, fr, fq, Mv)
#pragma unroll
        for (int ai = 0; ai < 2; ++ai) {
            u32x2 sv[4][2], gv[4][2];
#pragma unroll
            for (int m = 0; m < 4; ++m)
#pragma unroll
                for (int bj = 0; bj < 2; ++bj) {
                    const int row = u.pm * 256 + ai * 128 + wr * 64 + m * 16 + fr; const int rc = row < Mv ? row : Mv - 1; const int col = 128 * u.pn + 64 * bj + 16 * wc + 4 * fq;
                    sv[m][bj] = *(const u32x2*)(S + (size_t)rc * DM + col); gv[m][bj] = *(const u32x2*)(Gm + (size_t)rc * DM + col);
                }
#pragma unroll
            for (int m = 0; m < 4; ++m) {
                const int row = u.pm * 256 + ai * 128 + wr * 64 + m * 16 + fr; const bool valid = row < Mv;
                const float rs = rsv[ai][m];
#pragma unroll
                for (int bj = 0; bj < 2; ++bj) {
                    const int col = 128 * u.pn + 64 * bj + 16 * wc + 4 * fq;
                    const f32x4 g0 = acc[ai][bj][m][0] * rs, g1 = acc[ai][bj][m][1] * rs;
                    const u32x2 s2 = sv[m][bj], g2 = gv[m][bj];
                    const float o0 = sigm(g0[0]) * lo16(s2.x) + sigm(g1[0]) * lo16(g2.x), o1 = sigm(g0[1]) * hi16(s2.x) + sigm(g1[1]) * hi16(g2.x);
                    const float o2 = sigm(g0[2]) * lo16(s2.y) + sigm(g1[2]) * lo16(g2.y), o3 = sigm(g0[3]) * hi16(s2.y) + sigm(g1[3]) * hi16(g2.y);
                    u32x2 w; w.x = pk2(o0, o1); w.y = pk2(o2, o3);
                    if (valid) *(u32x2*)(S + (size_t)row * DM + col) = w;
                }
            }
        }
    }
};

struct CvtJob { const float* s0; const float* s1; const float* scale; bf16_t* dst; int K, N, ld, pair, nvalid, q0, q1; };
__device__ __forceinline__ const float* cvt_map(const CvtJob& j, int c, float& mul) {
    mul = 1.f;
    if (j.pair) { const int col = (c >> 5) * 16 + (c & 15); return ((c >> 4) & 1) ? j.s1 + col : j.s0 + col; }
    if (c >= j.q0 && c < j.q1) mul = 0.125f;
    return c < j.nvalid ? j.s0 + c : nullptr;
}
__device__ __forceinline__ void convert_wt(LAS unsigned char* lds, const CvtJob& j, int G, int c, int& rot) {
    LAS float* tile = (LAS float*)lds;
    const int tid = opaque_tid();
    const int K = j.K, ld = j.ld;
    const int nkt = K / 64, nct = j.N / 256, ntile = nkt * nct;
    for (int ti = (c + G - (rot % G)) % G; ti < ntile; ti += G) {
        const int k0 = (ti % nkt) * 64, c0 = (ti / nkt) * 256;
        {
            const int cq = (tid & 15) * 4, kk0 = tid >> 4;
            f32x4 v[2][4];
#pragma unroll
            for (int cb = 0; cb < 4; ++cb) {
                float mul; const float* sp = cvt_map(j, c0 + cb * 64 + cq, mul);
#pragma unroll
                for (int ps = 0; ps < 2; ++ps) {
                    const int kk = kk0 + 32 * ps;
                    v[ps][cb] = (f32x4){0.f, 0.f, 0.f, 0.f};
                    if (sp) { v[ps][cb] = *(const f32x4*)(sp + (size_t)(k0 + kk) * ld); const float sc = (j.scale ? j.scale[k0 + kk] : 1.f) * mul; v[ps][cb] = v[ps][cb] * sc; }
                }
            }
#pragma unroll
            for (int cb = 0; cb < 4; ++cb)
#pragma unroll
                for (int ps = 0; ps < 2; ++ps) {
                    const int kk = kk0 + 32 * ps; LAS float* tp = tile + kk * 257 + cb * 64 + cq;
                    tp[0] = v[ps][cb][0]; tp[1] = v[ps][cb][1]; tp[2] = v[ps][cb][2]; tp[3] = v[ps][cb][3];
                }
        }
        __syncthreads();
        {
            const int cc = tid >> 1, kq = (tid & 1) * 32;
#pragma unroll
            for (int q = 0; q < 4; ++q) {
                const int kb = kq + q * 8; u32x4 w;
                w.x = pk2(tile[(kb + 0) * 257 + cc], tile[(kb + 1) * 257 + cc]); w.y = pk2(tile[(kb + 2) * 257 + cc], tile[(kb + 3) * 257 + cc]);
                w.z = pk2(tile[(kb + 4) * 257 + cc], tile[(kb + 5) * 257 + cc]); w.w = pk2(tile[(kb + 6) * 257 + cc], tile[(kb + 7) * 257 + cc]);
                *(u32x4*)(j.dst + (size_t)(c0 + cc) * K + k0 + kb) = w;
            }
        }
        __syncthreads();
    }
    rot += ntile;
}
__device__ __forceinline__ CvtJob make_job(const Params& p, int l, int job) {
    bf16_t* W = (bf16_t*)(p.ws + OFF_W);
    const float* win = p.in[7] + (size_t)l * DM * DIN; const float* wglu = p.in[19] + (size_t)l * 512 * 2048;
    const float* n1 = p.in[2] + (size_t)l * DM; const float* nm = p.in[6] + (size_t)l * DM; const float* n2 = p.in[27] + (size_t)l * DM;
    switch (job) {
    case 0: return CvtJob{p.in[3] + (size_t)l * DM * DFF, p.in[4] + (size_t)l * DM * DFF, n1, W + W_UP1, 1024, 5632, DFF, 1, 0, 0, 0};
    case 1: return CvtJob{p.in[5] + (size_t)l * DFF * DM, nullptr, nullptr, W + W_DN1, 2816, 1024, DM, 0, 1024, 0, 0};
    case 2: return CvtJob{win, nullptr, nm, W + W_INP, 1024, 2304, DIN, 0, 2080, 512, 768};
    case 3: return CvtJob{win + 2080, win + 2080 + 1024, nm, W + W_ING, 1024, 2048, DIN, 1, 0, 0, 0};
    case 4: return CvtJob{wglu, wglu + 1024, nullptr, W + W_GLU, 512, 2048, 2048, 1, 0, 0, 0};
    case 5: return CvtJob{p.in[25] + (size_t)l * 512 * DM, nullptr, nullptr, W + W_O, 512, 1024, DM, 0, 1024, 0, 0};
    case 6: return CvtJob{p.in[26] + (size_t)l * DM * DM, nullptr, nullptr, W + W_OUT, 1024, 1024, DM, 0, 1024, 0, 0};
    case 7: return CvtJob{p.in[28] + (size_t)l * DM * DFF, p.in[29] + (size_t)l * DM * DFF, n2, W + W_UP2, 1024, 5632, DFF, 1, 0, 0, 0};
    default: return CvtJob{p.in[30] + (size_t)l * DFF * DM, nullptr, nullptr, W + W_DN2, 2816, 1024, DM, 0, 1024, 0, 0};
    }
}

__device__ __forceinline__ void s5_gen(LAS unsigned char* lds, const Params& p, int l, int g, bf16_t* B1, bf16_t* B2, float* lamtab) {
    const int tid = opaque_tid();
    LAS f32x2* P = (LAS f32x2*)lds;
    LAS f32x2* BB = P + 2 * 17 * 64;
    LAS f32x2* CC = BB + 2 * 64 * 16;
    LAS f32x2* F = CC + 16 * 64;
    LAS float* KT = (LAS float*)(F + 128);
    const float* a_re0 = p.in[8] + (size_t)(l * 32 + g) * 64; const float* a_re1 = p.in[11] + (size_t)(l * 32 + g) * 64;
    const float* a_im0 = p.in[9] + (size_t)(l * 32 + g) * 64; const float* a_im1 = p.in[12] + (size_t)(l * 32 + g) * 64;
    const float ldt0 = p.in[10][l * 32 + g], ldt1 = p.in[13][l * 32 + g];
    const float* b_re = p.in[14] + (size_t)(l * 32 + g) * 1024; const float* b_im = p.in[15] + (size_t)(l * 32 + g) * 1024;
    const float* c_re = p.in[16] + (size_t)(l * 32 + g) * 1024; const float* c_im = p.in[17] + (size_t)(l * 32 + g) * 1024;
    const float* dd = p.in[18] + (size_t)l * 512 + g * 16;
    __syncthreads();
    for (int e = tid; e < 2 * 17 * 64; e += NTHR) {
        const int dir = e / (17 * 64), n = (e / 64) % 17, pp = e & 63;
        const float dt = expf(dir ? ldt1 : ldt0); const float ar = (dir ? a_re1 : a_re0)[pp], ai = (dir ? a_im1 : a_im0)[pp];
        const float mag = expf(ar * dt * (float)n), ang = ai * dt * (float)n;
        P[e] = (f32x2){mag * cosf(ang), mag * sinf(ang)};
    }
    if (tid < 128) {
        const int dir = tid >> 6, pp = tid & 63;
        const float dt = expf(dir ? ldt1 : ldt0); const float ar = (dir ? a_re1 : a_re0)[pp], ai = (dir ? a_im1 : a_im0)[pp];
        const float mag = expf(ar * dt); const float lr = mag * cosf(ai * dt), li = mag * sinf(ai * dt);
        const float den = ar * ar + ai * ai; const float ir = ar / den, ii = -ai / den;
        const float xr = lr - 1.f, xi = li;
        F[tid] = (f32x2){xr * ir - xi * ii, xr * ii + xi * ir};
        const float m16 = expf(ar * dt * 16.f), a16 = ai * dt * 16.f;
        *(f32x2*)(lamtab + ((size_t)(g * 2 + dir) * 64 + pp) * 2) = (f32x2){m16 * cosf(a16), m16 * sinf(a16)};
    }
    for (int e = tid; e < 1024; e += NTHR) { const int i = e >> 6, pp = e & 63; CC[e] = (f32x2){c_re[i * 64 + pp], c_im[i * 64 + pp]}; }
    __syncthreads();
    for (int e = tid; e < 2048; e += NTHR) {
        const int dir = e >> 10, pj = e & 1023, pp = pj >> 4; const f32x2 f = F[dir * 64 + pp]; const float br = b_re[pj], bi = b_im[pj];
        BB[e] = (f32x2){f.x * br - f.y * bi, f.x * bi + f.y * br};
    }
    __syncthreads();
    for (int e = tid; e < 2 * 16 * 256; e += NTHR) {
        const int dir = e >> 12, n = (e >> 8) & 15, i = (e >> 4) & 15, j = e & 15; float s = 0.f;
        for (int pp = 0; pp < 64; ++pp) {
            const f32x2 cv = CC[i * 64 + pp], pv = P[(dir * 17 + n) * 64 + pp], bv = BB[(dir * 64 + pp) * 16 + j];
            const float xr = cv.x * pv.x - cv.y * pv.y, xi = cv.x * pv.y + cv.y * pv.x;
            s += xr * bv.x - xi * bv.y;
        }
        KT[e] = s;
    }
    __syncthreads();
    for (int e = tid; e < 256 * 32; e += NTHR) {
        const int n = e >> 5, k0 = (e & 31) * 8; const int dir = n >> 7, reim = (n >> 6) & 1, pp = n & 63; const int s = k0 >> 4, j0 = k0 & 15;
        const f32x2 pv = P[(dir * 17 + (dir == 0 ? 15 - s : s)) * 64 + pp]; float o[8];
#pragma unroll
        for (int jj = 0; jj < 8; ++jj) { const f32x2 bv = BB[(dir * 64 + pp) * 16 + j0 + jj]; o[jj] = reim == 0 ? pv.x * bv.x - pv.y * bv.y : pv.x * bv.y + pv.y * bv.x; }
        u32x4 w; w.x = pk2(o[0], o[1]); w.y = pk2(o[2], o[3]); w.z = pk2(o[4], o[5]); w.w = pk2(o[6], o[7]);
        *(u32x4*)(B1 + (size_t)n * 256 + k0) = w;
    }
    for (int e = tid; e < 256 * 64; e += NTHR) {
        const int n = e >> 6, k0 = (e & 63) * 8; const int t = n >> 4, i = n & 15; float o[8];
        if (k0 < 256) {
            const int s = k0 >> 4, j0 = k0 & 15;
#pragma unroll
            for (int jj = 0; jj < 8; ++jj) {
                const int j = j0 + jj; float v = 0.f;
                if (t >= s) v += KT[((0 * 16) + (t - s)) * 256 + i * 16 + j];
                if (s >= t) v += KT[((1 * 16) + (s - t)) * 256 + i * 16 + j];
                if (s == t && i == j) v += dd[i];
                o[jj] = v;
            }
        } else {
            const int kk = k0 - 256; const int dir = kk >> 7, reim = (kk >> 6) & 1, p0 = kk & 63; const int pw = dir == 0 ? t + 1 : 16 - t;
#pragma unroll
            for (int jj = 0; jj < 8; ++jj) {
                const f32x2 cv = CC[i * 64 + p0 + jj], pv = P[(dir * 17 + pw) * 64 + p0 + jj];
                o[jj] = reim == 0 ? (cv.x * pv.x - cv.y * pv.y) : -(cv.x * pv.y + cv.y * pv.x);
            }
        }
        u32x4 w; w.x = pk2(o[0], o[1]); w.y = pk2(o[2], o[3]); w.z = pk2(o[4], o[5]); w.w = pk2(o[6], o[7]);
        *(u32x4*)(B2 + (size_t)n * 512 + k0) = w;
    }
    __syncthreads();
}

constexpr int GL_BF = 0, GL_BB = 16384, GL_X = 32768;
__device__ __forceinline__ int gla_row0(int b, int n) { return n == 0 ? TR + 16 * b : b * 16384 + 64 * (n - 1); }
__device__ __forceinline__ void gla_prep(LAS unsigned char* lds, const Params& p, int l, const float* zbuf, int hh, int row0, int ntok) {
    const int tid = opaque_tid();
    LAS float* BF = (LAS float*)(lds + GL_BF); LAS float* BBk = (LAS float*)(lds + GL_BB);
    LAS float* Z = (LAS float*)(lds + GL_X); LAS float* W2 = Z + 2048; LAS float* BI = W2 + 2048; LAS float* TOT = BI + 128;
    {
        const int t = tid >> 3, c4 = (tid & 7) * 4; f32x4 v = (f32x4){0.f, 0.f, 0.f, 0.f};
        if (t < ntok) v = *(const f32x4*)(zbuf + (size_t)(row0 + t) * 32 + c4);
        *(LAS f32x4*)(Z + t * 32 + c4) = v;
    }
    for (int e = tid; e < 2048; e += NTHR) { const int dir = e >> 10, r = (e >> 6) & 15, d = e & 63; W2[e] = (dir ? p.in[22] : p.in[20])[(size_t)l * 16 * 256 + r * 256 + hh * 64 + d]; }
    if (tid < 128) { const int dir = tid >> 6, d = tid & 63; BI[tid] = (dir ? p.in[23] : p.in[21])[l * 256 + hh * 64 + d]; }
    __syncthreads();
    const int dir = tid >> 8, tb = (tid >> 6) & 3, d = tid & 63;
    LAS float* BX = dir ? BBk : BF;
    {
        float w[16];
#pragma unroll
        for (int r = 0; r < 16; ++r) w[r] = W2[(dir * 16 + r) * 64 + d];
        const float bias = BI[dir * 64 + d];
        float pre = 0.f;
#pragma unroll
        for (int j = 0; j < 16; ++j) {
            const int t = dir ? 16 * tb + 15 - j : 16 * tb + j;
            float x = bias;
#pragma unroll
            for (int r4 = 0; r4 < 4; ++r4) { const f32x4 zv = *(const LAS f32x4*)(Z + t * 32 + dir * 16 + r4 * 4); x += zv[0] * w[r4 * 4] + zv[1] * w[r4 * 4 + 1] + zv[2] * w[r4 * 4 + 2] + zv[3] * w[r4 * 4 + 3]; }
            const float gg = t < ntok ? logsig(x) * (1.f / 16.f) : 0.f;
            pre += gg; BX[t * 64 + d] = pre;
        }
        TOT[(dir * 4 + tb) * 64 + d] = pre;
    }
    __syncthreads();
    {
        float off = 0.f;
#pragma unroll
        for (int t2 = 0; t2 < 4; ++t2) { const float tv = TOT[(dir * 4 + t2) * 64 + d]; if (dir ? (t2 > tb) : (t2 < tb)) off += tv; }
#pragma unroll
        for (int j = 0; j < 16; ++j) BX[(16 * tb + j) * 64 + d] += off;
    }
    __syncthreads();
}

__device__ __forceinline__ void gla_g1(LAS unsigned char* lds, const Params& p, int l, const bf16_t* kbuf, const bf16_t* vbuf, const float* zbuf, bf16_t* gs, float* dec, int G, int c) {
    const int tid = opaque_tid(), wid = tid >> 6, lane = tid & 63, fr = lane & 15, fq = lane >> 4;
    LAS float* BF = (LAS float*)(lds + GL_BF); LAS float* BBk = (LAS float*)(lds + GL_BB);
    LAS bf16_t* KF = (LAS bf16_t*)(lds + GL_X); LAS bf16_t* KB = KF + 64 * 72; LAS bf16_t* VT = KB + 64 * 72;
    for (int task = c; task < 8 * GCH; task += G) {
        const int n = task % GCH, bh = task / GCH, b = bh >> 2, hh = bh & 3;
        const int row0 = gla_row0(b, n), ntok = n == 0 ? 16 : 64;
        gla_prep(lds, p, l, zbuf, hh, row0, ntok);
        {
            const int t = tid >> 3, d0 = (tid & 7) * 8; u32x4 kv = (u32x4){0u, 0u, 0u, 0u};
            if (t < ntok) kv = *(const u32x4*)(kbuf + (size_t)(row0 + t) * 256 + hh * 64 + d0);
            const unsigned kw[4] = {kv.x, kv.y, kv.z, kv.w};
#pragma unroll
            for (int i = 0; i < 8; ++i) {
                const int d = d0 + i; const float kk = (i & 1) ? hi16(kw[i >> 1]) : lo16(kw[i >> 1]);
                KF[d * 72 + t] = f2bf(kk * __expf(BF[63 * 64 + d] - BF[t * 64 + d]));
                KB[d * 72 + t] = f2bf(kk * __expf(BBk[0 * 64 + d] - BBk[t * 64 + d]));
            }
            const int v0 = (tid & 7) * 16;
#pragma unroll
            for (int hv = 0; hv < 2; ++hv) {
                u32x4 vv = (u32x4){0u, 0u, 0u, 0u};
                if (t < ntok) vv = *(const u32x4*)(vbuf + (size_t)(row0 + t) * 512 + hh * 128 + v0 + hv * 8);
                const unsigned vw[4] = {vv.x, vv.y, vv.z, vv.w};
#pragma unroll
                for (int i = 0; i < 8; ++i) VT[(v0 + hv * 8 + i) * 72 + t] = (bf16_t)((i & 1) ? (vw[i >> 1] >> 16) : (vw[i >> 1] & 0xffffu));
            }
        }
        if (tid < 128) { const int dir = tid >> 6, d = tid & 63; dec[((size_t)(bh * 2 + dir) * GCH + n) * 64 + d] = __expf(dir ? BBk[d] : BF[63 * 64 + d]); }
        __syncthreads();
        {
            const int dir = wid >> 2, dt = wid & 3; LAS bf16_t* KS = dir ? KB : KF;
            const bf16x8 a0 = *(const LAS bf16x8*)(KS + (dt * 16 + fr) * 72 + fq * 8), a1 = *(const LAS bf16x8*)(KS + (dt * 16 + fr) * 72 + 32 + fq * 8);
            bf16_t* dst = gs + ((size_t)(bh * 2 + dir) * GCH + n) * 8192;
#pragma unroll
            for (int vt = 0; vt < 8; ++vt) {
                const bf16x8 b0 = *(const LAS bf16x8*)(VT + (vt * 16 + fr) * 72 + fq * 8), b1 = *(const LAS bf16x8*)(VT + (vt * 16 + fr) * 72 + 32 + fq * 8);
                f32x4 a = (f32x4){0.f, 0.f, 0.f, 0.f};
                a = __builtin_amdgcn_mfma_f32_16x16x32_bf16(a0, b0, a, 0, 0, 0);
                a = __builtin_amdgcn_mfma_f32_16x16x32_bf16(a1, b1, a, 0, 0, 0);
#ifdef DBG_CLAMP
#pragma unroll
                for (int j = 0; j < 4; ++j) { float x = a[j]; x = (x == x) ? x : 0.f; x = fminf(fmaxf(x, -1000.f), 1000.f); a[j] = x; }
#endif
                u32x2 w; w.x = pk2(a[0], a[1]); w.y = pk2(a[2], a[3]);
                *(u32x2*)(dst + (size_t)(vt * 16 + fr) * 64 + dt * 16 + fq * 4) = w;
            }
        }
        __syncthreads();
    }
}

__device__ __forceinline__ void gla_g2(bf16_t* gs, const float* dec, int G, int c) {
    const int tid = opaque_tid();
    for (int gid = c * NTHR + tid; gid < 16 * 8192; gid += G * NTHR) {
        const int seq = gid >> 13, e = gid & 8191, d = e & 63, dir = seq & 1;
        bf16_t* base = gs + (size_t)seq * GCH * 8192 + e; const float* db = dec + (size_t)seq * GCH * 64 + d;
        float st = 0.f;
        for (int n0 = 0; n0 < GCH; n0 += 8) {
            float sv[8], dv[8];
#pragma unroll
            for (int i = 0; i < 8; ++i) { const int n = n0 + i; const int nn = dir ? GCH - 1 - n : n; if (n < GCH) { sv[i] = bf2f(base[(size_t)nn * 8192]); dv[i] = db[nn * 64]; } else { sv[i] = 0.f; dv[i] = 0.f; } }
#pragma unroll
            for (int i = 0; i < 8; ++i) { const int n = n0 + i; const int nn = dir ? GCH - 1 - n : n; if (n < GCH) { base[(size_t)nn * 8192] = f2bf(st); st = dv[i] * st + sv[i]; } }
        }
    }
}

constexpr int GL_A1 = GL_X + 18432, GL_B1 = GL_A1 + 25600, GL_RS = GL_B1 + 51200;
static_assert(GL_RS + 512 <= LDS_BYTES, "G3 LDS");
__device__ __forceinline__ void gla_g3(LAS unsigned char* lds, const Params& p, int l, const bf16_t* qbuf, const bf16_t* kbuf, const bf16_t* vbuf, const bf16_t* rbuf, const float* zbuf,
                       const bf16_t* gs, bf16_t* obuf, int G, int c) {
    const int tid = opaque_tid(), wid = tid >> 6, lane = tid & 63, fr = lane & 15, fq = lane >> 4;
    LAS float* BF = (LAS float*)(lds + GL_BF); LAS float* BBk = (LAS float*)(lds + GL_BB);
    LAS bf16_t* KDF = (LAS bf16_t*)(lds + GL_X); LAS bf16_t* KDB = KDF + 64 * 72;
    LAS bf16_t* A1 = (LAS bf16_t*)(lds + GL_A1); LAS bf16_t* B1 = (LAS bf16_t*)(lds + GL_B1); LAS float* RS = (LAS float*)(lds + GL_RS);
    const float* gnorm = p.in[24] + (size_t)l * 512;
    for (int task = c; task < 8 * GCH; task += G) {
        const int n = task % GCH, bh = task / GCH, b = bh >> 2, hh = bh & 3;
        const int row0 = gla_row0(b, n), ntok = n == 0 ? 16 : 64;
        gla_prep(lds, p, l, zbuf, hh, row0, ntok);
        {
            const int t = tid >> 3, d0 = (tid & 7) * 8; u32x4 qv = (u32x4){0u, 0u, 0u, 0u}, kv = qv;
            if (t < ntok) { qv = *(const u32x4*)(qbuf + (size_t)(row0 + t) * 256 + hh * 64 + d0); kv = *(const u32x4*)(kbuf + (size_t)(row0 + t) * 256 + hh * 64 + d0); }
            const unsigned qw[4] = {qv.x, qv.y, qv.z, qv.w}, kw[4] = {kv.x, kv.y, kv.z, kv.w};
            unsigned oqf[4], oqb[4], okf[4], okb[4];
#pragma unroll
            for (int i = 0; i < 4; ++i) {
                const int d = d0 + 2 * i; const float bf0 = BF[t * 64 + d], bf1 = BF[t * 64 + d + 1], bb0 = BBk[t * 64 + d], bb1 = BBk[t * 64 + d + 1];
                const float q0 = lo16(qw[i]), q1 = hi16(qw[i]), k0 = lo16(kw[i]), k1 = hi16(kw[i]);
                oqf[i] = pk2(q0 * __expf(bf0), q1 * __expf(bf1)); oqb[i] = pk2(q0 * __expf(bb0), q1 * __expf(bb1));
                okf[i] = pk2(k0 * __expf(-bf0), k1 * __expf(-bf1)); okb[i] = pk2(k0 * __expf(-bb0), k1 * __expf(-bb1));
            }
            *(LAS u32x4*)(A1 + t * 200 + 64 + d0) = (u32x4){oqf[0], oqf[1], oqf[2], oqf[3]};
            *(LAS u32x4*)(A1 + t * 200 + 128 + d0) = (u32x4){oqb[0], oqb[1], oqb[2], oqb[3]};
            *(LAS u32x4*)(KDF + t * 72 + d0) = (u32x4){okf[0], okf[1], okf[2], okf[3]};
            *(LAS u32x4*)(KDB + t * 72 + d0) = (u32x4){okb[0], okb[1], okb[2], okb[3]};
            const int v0 = (tid & 7) * 16;
#pragma unroll
            for (int hv = 0; hv < 2; ++hv) {
                u32x4 vv = (u32x4){0u, 0u, 0u, 0u};
                if (t < ntok) vv = *(const u32x4*)(vbuf + (size_t)(row0 + t) * 512 + hh * 128 + v0 + hv * 8);
                const unsigned vw[4] = {vv.x, vv.y, vv.z, vv.w};
#pragma unroll
                for (int i = 0; i < 8; ++i) B1[(v0 + hv * 8 + i) * 200 + t] = (bf16_t)((i & 1) ? (vw[i >> 1] >> 16) : (vw[i >> 1] & 0xffffu));
            }
            const int vr = tid >> 2, dq = (tid & 3) * 16;
#pragma unroll
            for (int dir = 0; dir < 2; ++dir) {
                const bf16_t* src = gs + ((size_t)(bh * 2 + dir) * GCH + n) * 8192 + vr * 64 + dq;
#ifdef DBG_NO_INTER
                const u32x4 h0 = (u32x4){0u,0u,0u,0u}, h1 = h0; (void)src;
#else
                const u32x4 h0 = *(const u32x4*)src, h1 = *(const u32x4*)(src + 8);
#endif
                *(LAS u32x4*)(B1 + vr * 200 + 64 + dir * 64 + dq) = h0; *(LAS u32x4*)(B1 + vr * 200 + 64 + dir * 64 + dq + 8) = h1;
            }
        }
        __syncthreads();
        {
            const int ti = wid >> 1;
            const bf16x8 qf0 = *(const LAS bf16x8*)(A1 + (ti * 16 + fr) * 200 + 64 + fq * 8), qf1 = *(const LAS bf16x8*)(A1 + (ti * 16 + fr) * 200 + 96 + fq * 8);
            const bf16x8 qb0 = *(const LAS bf16x8*)(A1 + (ti * 16 + fr) * 200 + 128 + fq * 8), qb1 = *(const LAS bf16x8*)(A1 + (ti * 16 + fr) * 200 + 160 + fq * 8);
#pragma unroll
            for (int tj2 = 0; tj2 < 2; ++tj2) {
                const int tj = (wid & 1) * 2 + tj2;
                const bf16x8 kf0 = *(const LAS bf16x8*)(KDF + (tj * 16 + fr) * 72 + fq * 8), kf1 = *(const LAS bf16x8*)(KDF + (tj * 16 + fr) * 72 + 32 + fq * 8);
                const bf16x8 kb0 = *(const LAS bf16x8*)(KDB + (tj * 16 + fr) * 72 + fq * 8), kb1 = *(const LAS bf16x8*)(KDB + (tj * 16 + fr) * 72 + 32 + fq * 8);
                f32x4 sf = (f32x4){0.f, 0.f, 0.f, 0.f}, sb = sf;
                sf = __builtin_amdgcn_mfma_f32_16x16x32_bf16(kf0, qf0, sf, 0, 0, 0); sf = __builtin_amdgcn_mfma_f32_16x16x32_bf16(kf1, qf1, sf, 0, 0, 0);
                sb = __builtin_amdgcn_mfma_f32_16x16x32_bf16(kb0, qb0, sb, 0, 0, 0); sb = __builtin_amdgcn_mfma_f32_16x16x32_bf16(kb1, qb1, sb, 0, 0, 0);
                const int i = ti * 16 + fr, j0 = tj * 16 + fq * 4; float pv[4];
#pragma unroll
                for (int jj = 0; jj < 4; ++jj) pv[jj] = (j0 + jj <= i) ? sf[jj] : sb[jj];
                *(LAS u32x2*)(A1 + i * 200 + j0) = (u32x2){pk2(pv[0], pv[1]), pk2(pv[2], pv[3])};
            }
        }
        __syncthreads();
        {
            const int it = wid & 3, vh = wid >> 2;
            bf16x8 bfr[6];
#pragma unroll
            for (int ks = 0; ks < 6; ++ks) bfr[ks] = *(const LAS bf16x8*)(A1 + (it * 16 + fr) * 200 + ks * 32 + fq * 8);
            f32x4 o[4]; float ss = 0.f;
#pragma unroll
            for (int vt = 0; vt < 4; ++vt) {
                f32x4 a = (f32x4){0.f, 0.f, 0.f, 0.f};
#pragma unroll
                for (int ks = 0; ks < 6; ++ks) { const bf16x8 af = *(const LAS bf16x8*)(B1 + (vh * 64 + vt * 16 + fr) * 200 + ks * 32 + fq * 8); a = __builtin_amdgcn_mfma_f32_16x16x32_bf16(af, bfr[ks], a, 0, 0, 0); }
                o[vt] = a; ss += (a[0] * a[0] + a[1] * a[1]) + (a[2] * a[2] + a[3] * a[3]);
            }
            ss += __shfl_xor(ss, 16); ss += __shfl_xor(ss, 32);
            if (fq == 0) RS[vh * 64 + it * 16 + fr] = ss;
            __syncthreads();
            const int i = it * 16 + fr; const float tot = RS[i] + RS[64 + i]; const float rn = rsqrtf(tot * (1.f / 128.f) + 1e-6f);
            if (i < ntok) {
                const int row = row0 + i;
#pragma unroll
                for (int vt = 0; vt < 4; ++vt) {
                    const int vcol = hh * 128 + vh * 64 + vt * 16 + fq * 4;
                    const f32x4 gn = *(const f32x4*)(gnorm + vcol); const u32x2 rv = *(const u32x2*)(rbuf + (size_t)row * 512 + vcol);
                    const float r0 = lo16(rv.x), r1 = hi16(rv.x), r2 = lo16(rv.y), r3 = hi16(rv.y);
                    u32x2 w; w.x = pk2(o[vt][0] * rn * gn[0] * siluf_(r0), o[vt][1] * rn * gn[1] * siluf_(r1)); w.y = pk2(o[vt][2] * rn * gn[2] * siluf_(r2), o[vt][3] * rn * gn[3] * siluf_(r3));
                    *(u32x2*)(obuf + (size_t)row * 512 + vcol) = w;
                }
            }
        }
        __syncthreads();
    }
}

__device__ __forceinline__ void s5_scan(LAS unsigned char* lds, const float* S, bf16_t* ubuf, const float* lamtab, int G, int c) {
    const int tid = opaque_tid(); const int pp = tid & 63, sg = tid >> 6;
    LAS f32x2* E = (LAS f32x2*)lds; LAS f32x2* PW = E + 512;
    for (int combo = c; combo < 128; combo += G) {
        const int dir = combo & 1, g = (combo >> 1) & 31, b = combo >> 6;
        const f32x2 lam = *(const f32x2*)(lamtab + ((size_t)(g * 2 + dir) * 64 + pp) * 2);
        const float* sb = S + ((size_t)g * MCH + b * NCH) * 256 + dir * 128 + pp;
        bf16_t* hb = ubuf + ((size_t)g * MCH + b * NCH) * 512 + 256 + dir * 128 + pp;
        const int c_lo = sg * 129, c_hi = (c_lo + 129) < NCH ? (c_lo + 129) : NCH;
        float lr = 0.f, li = 0.f, pr = 1.f, pi = 0.f;
        for (int c0 = c_lo; c0 < c_hi; c0 += 16) {
            float sr[16], si[16];
#pragma unroll
            for (int i = 0; i < 16; ++i) { const int cc = c0 + i; const int ch = dir ? NCH - 1 - cc : cc; if (cc < c_hi) { sr[i] = sb[(size_t)ch * 256]; si[i] = sb[(size_t)ch * 256 + 64]; } else { sr[i] = 0.f; si[i] = 0.f; } }
#pragma unroll
            for (int i = 0; i < 16; ++i) { const int cc = c0 + i;
                if (cc < c_hi) { const float nr = lam.x * lr - lam.y * li + sr[i], ni = lam.x * li + lam.y * lr + si[i]; lr = nr; li = ni;
                                 const float tr = lam.x * pr - lam.y * pi; pi = lam.x * pi + lam.y * pr; pr = tr; } }
        }
        E[sg * 64 + pp] = (f32x2){lr, li}; PW[sg * 64 + pp] = (f32x2){pr, pi};
        __syncthreads();
        float hr = 0.f, hi = 0.f;
        for (int s2 = 0; s2 < sg; ++s2) { const f32x2 e = E[s2 * 64 + pp], w = PW[s2 * 64 + pp]; const float nr = w.x * hr - w.y * hi + e.x, ni = w.x * hi + w.y * hr + e.y; hr = nr; hi = ni; }
        for (int c0 = c_lo; c0 < c_hi; c0 += 16) {
            float sr[16], si[16];
#pragma unroll
            for (int i = 0; i < 16; ++i) { const int cc = c0 + i; const int ch = dir ? NCH - 1 - cc : cc; if (cc < c_hi) { sr[i] = sb[(size_t)ch * 256]; si[i] = sb[(size_t)ch * 256 + 64]; } else { sr[i] = 0.f; si[i] = 0.f; } }
#pragma unroll
            for (int i = 0; i < 16; ++i) { const int cc = c0 + i; const int ch = dir ? NCH - 1 - cc : cc;
                if (cc < c_hi) { hb[(size_t)ch * 512] = f2bf(hr); hb[(size_t)ch * 512 + 64] = f2bf(hi); const float nr = lam.x * hr - lam.y * hi + sr[i], ni = lam.x * hi + lam.y * hr + si[i]; hr = nr; hi = ni; } }
        }
        __syncthreads();
    }
}

enum { GK_UP1 = 0, GK_DN1, GK_PROJ, GK_S5S, GK_S5Y, GK_GLU, GK_WO, GK_GATE, GK_OUTP, GK_UP2, GK_DN2 };
__device__ __forceinline__ pg8::Gemm make_gemm(int kind, unsigned char* ws) {
    bf16_t* W = (bf16_t*)(ws + OFF_W); const bf16_t* hb = (const bf16_t*)(ws + OFF_HB); const bf16_t* hid = (const bf16_t*)(ws + OFF_HID); const bf16_t* ubuf = (const bf16_t*)(ws + OFF_UBUF);
    switch (kind) {
    case GK_UP1:  return pg8::Gemm{hb, W + W_UP1, 1024, 1024, 128, 22, 1, 0, 0, 1};
    case GK_DN1:  return pg8::Gemm{hid, W + W_DN1, DFF, DFF, 128, 4, 1, 0, 0, 1};
    case GK_PROJ: return pg8::Gemm{hb, W + W_INP, 1024, 1024, 128, 9, 1, 0, 0, 1};
    case GK_S5S:  return pg8::Gemm{ubuf, W + W_S1, 512, 256, 9, 1, 32, (size_t)MCH * 512, (size_t)256 * 256, 0};
    case GK_S5Y:  return pg8::Gemm{ubuf, W + W_S2, 512, 512, 9, 1, 32, (size_t)MCH * 512, (size_t)256 * 512, 0};
    case GK_GLU:  return pg8::Gemm{(const bf16_t*)(ws + OFF_Y), W + W_GLU, 512, 512, 128, 8, 1, 0, 0, 1};
    case GK_WO:   return pg8::Gemm{(const bf16_t*)(ws + OFF_O), W + W_O, 512, 512, 128, 4, 1, 0, 0, 1};
    case GK_GATE: return pg8::Gemm{hb, W + W_ING, 1024, 1024, 128, 8, 1, 0, 0, 1};
    case GK_OUTP: return pg8::Gemm{(const bf16_t*)(ws + OFF_SB), W + W_OUT, 1024, 1024, 128, 4, 1, 0, 0, 1};
    case GK_UP2:  return pg8::Gemm{hb, W + W_UP2, 1024, 1024, 128, 22, 1, 0, 0, 1};
    default:      return pg8::Gemm{hid, W + W_DN2, DFF, DFF, 128, 4, 1, 0, 0, 1};
    }
}
struct EpiSwitch {
    int kind; unsigned char* ws; float* out;
    __device__ __forceinline__ void operator()(const Acc& acc, const Unit& u, int wr, int wc, int fr, int fq) const {
        float* rowpart = (float*)(ws + OFF_ROWPART); bf16_t* hb = (bf16_t*)(ws + OFF_HB); float* metah = (float*)(ws + OFF_METAH);
        switch (kind) {
        case GK_UP1: case GK_UP2: { EpiUp E{rowpart, (bf16_t*)(ws + OFF_HID), T}; E(acc, u, wr, wc, fr, fq); } break;
        case GK_DN1: case GK_DN2: case GK_OUTP: { EpiRes E{out, metah, hb, rowpart, kind == GK_OUTP ? 1.0f : 0.5f, T}; E(acc, u, wr, wc, fr, fq); } break;
        case GK_PROJ: { EpiProj E{rowpart, (bf16_t*)(ws + OFF_UBUF), (bf16_t*)(ws + OFF_Q), (bf16_t*)(ws + OFF_K), (bf16_t*)(ws + OFF_V), (bf16_t*)(ws + OFF_R), (float*)(ws + OFF_Z), T}; E(acc, u, wr, wc, fr, fq); } break;
        case GK_S5S: { EpiS5S E{(float*)(ws + OFF_S5S)}; E(acc, u, wr, wc, fr, fq); } break;
        case GK_S5Y: { EpiS5Y E{(bf16_t*)(ws + OFF_Y)}; E(acc, u, wr, wc, fr, fq); } break;
        case GK_GLU: { EpiGlu E{(bf16_t*)(ws + OFF_SB), T}; E(acc, u, wr, wc, fr, fq); } break;
        case GK_WO: { EpiBf E{(bf16_t*)(ws + OFF_GB), T}; E(acc, u, wr, wc, fr, fq); } break;
        default: { EpiGate E{rowpart, (bf16_t*)(ws + OFF_SB), (const bf16_t*)(ws + OFF_GB), T}; E(acc, u, wr, wc, fr, fq); } break;
        }
    }
};

__device__ __forceinline__ void grid_barrier(unsigned* ctr, unsigned& epoch, int G) {
    asm volatile("s_waitcnt vmcnt(0) lgkmcnt(0)" ::: "memory");
    __syncthreads();
    epoch += 1u;
    if (threadIdx.x < 64) {
        __builtin_amdgcn_fence(__ATOMIC_RELEASE, "agent");
        asm volatile("s_waitcnt vmcnt(0)" ::: "memory");
        if (threadIdx.x == 0) __hip_atomic_fetch_add(ctr, 1u, __ATOMIC_RELAXED, __HIP_MEMORY_SCOPE_AGENT);
        const unsigned target = epoch * (unsigned)G;
        while ((unsigned)__builtin_amdgcn_readfirstlane(__hip_atomic_load(ctr, __ATOMIC_RELAXED, __HIP_MEMORY_SCOPE_AGENT)) < target) __builtin_amdgcn_s_sleep(2);
    }
    __syncthreads();
    __builtin_amdgcn_fence(__ATOMIC_ACQUIRE, "agent");
    asm volatile("s_waitcnt vmcnt(0)" ::: "memory");
}

__global__ void __launch_bounds__(NTHR, 2) fwd_mega(Params p) {
    extern __shared__ __attribute__((aligned(16))) unsigned char lds_raw[];
    LAS unsigned char* lds = (LAS unsigned char*)lds_raw;
    cg::grid_group grid = cg::this_grid();
    const int G = gridDim.x, c = blockIdx.x;
    unsigned char* ws = p.ws;
    float* out = p.out;
    unsigned* bar_ctr = (unsigned*)(ws + OFF_BAR); unsigned epoch = 0;
    grid.sync();

    {
        const int tid_ = opaque_tid(); const int wid = tid_ >> 6, lane = tid_ & 63;
        bf16_t* hb = (bf16_t*)(ws + OFF_HB); float* metah = (float*)(ws + OFF_METAH); float* rowpart = (float*)(ws + OFF_ROWPART);
        for (int row = c * 8 + wid; row < T; row += G * 8) {
            const float* src = row < TR ? p.in[0] + (size_t)row * DM : p.in[1] + (size_t)((row - TR) & 15) * DM;
            float* dst = row < TR ? out + (size_t)row * DM : metah + (size_t)(row - TR) * DM;
            float ss = 0.f;
#pragma unroll
            for (int i = 0; i < 4; ++i) {
                const int col = (i * 64 + lane) * 4; const f32x4 v = *(const f32x4*)(src + col);
                *(f32x4*)(dst + col) = v; u32x2 w; w.x = pk2(v[0], v[1]); w.y = pk2(v[2], v[3]); *(u32x2*)(hb + (size_t)row * DM + col) = w;
                ss += (v[0] * v[0] + v[1] * v[1]) + (v[2] * v[2] + v[3] * v[3]);
            }
#pragma unroll
            for (int o = 32; o >= 1; o >>= 1) ss += __shfl_xor(ss, o);
            if (lane < 16) rowpart[(size_t)row * 16 + lane] = lane == 0 ? ss : 0.f;
        }
    }

    for (int step = 0; step < 24; ++step) {
        const int l = step / 12, s = step % 12;
        if (s == 0) {
            PH(0) {
                int rot = 0;
                for (int job = 0; job < 9; ++job) { const CvtJob j = make_job(p, l, job); convert_wt(lds, j, G, c, rot); }
                bf16_t* W = (bf16_t*)(ws + OFF_W);
                for (int g = c; g < 32; g += G) s5_gen(lds, p, l, g, W + W_S1 + (size_t)g * 256 * 256, W + W_S2 + (size_t)g * 256 * 512, (float*)(ws + OFF_LAM));
            }
        }
        int k0 = -1, k1 = -1;
#ifdef DBG_SKIP_LO
        if (s >= DBG_SKIP_LO && s <= DBG_SKIP_HI) { grid_barrier(bar_ctr, epoch, G); continue; }
#endif
        switch (s) {
        case 1: k0 = GK_UP1; break;
        case 2: k0 = GK_DN1; break;
        case 3: k0 = GK_PROJ; break;
        case 4: k0 = GK_S5S; break;
        case 6: k0 = GK_S5Y; break;
        case 7: k0 = GK_GLU; k1 = GK_WO; break;
        case 8: k0 = GK_GATE; break;
        case 9: k0 = GK_OUTP; break;
        case 10: k0 = GK_UP2; break;
        case 11: k0 = GK_DN2; break;
        default: break;
        }
#ifdef DBG_NO_GLA
        if (k1 == GK_WO) k1 = -1;
#endif
#ifdef DBG_NO_S5
        if (k0 == GK_S5S || k0 == GK_S5Y) k0 = -1;
        if (k0 == GK_GLU) { k0 = k1; k1 = -1; }
#endif
#ifdef DBG_DUP_UP
        if (s == 1 || s == 10) k1 = k0;
#endif
        PH(1) {
            for (int sub = 0; sub < 2; ++sub) {
                const int kk = sub ? k1 : k0;
                if (kk >= 0) { const pg8::Gemm g = make_gemm(kk, ws); const EpiSwitch E{kk, ws, out}; pg8::gemm_phase(lds, g, E, G, sub ? (c + 8) % G : c); }
            }
        }
#ifdef DBG_DUP_GLA
        if (s == 4) { gla_g1(lds, p, l, (const bf16_t*)(ws + OFF_K), (const bf16_t*)(ws + OFF_V), (const float*)(ws + OFF_Z), (bf16_t*)(ws + OFF_GS), (float*)(ws + OFF_DEC), G, (c + 32) % G); }
        if (s == 6) { gla_g3(lds, p, l, (const bf16_t*)(ws + OFF_Q), (const bf16_t*)(ws + OFF_K), (const bf16_t*)(ws + OFF_V), (const bf16_t*)(ws + OFF_R), (const float*)(ws + OFF_Z),
                             (const bf16_t*)(ws + OFF_GS), (bf16_t*)(ws + OFF_O), G, (c + 32) % G); }
#endif
#ifdef DBG_DUP_MISC
        if (s == 0) { int rot = 0; for (int job = 0; job < 9; ++job) { const CvtJob j = make_job(p, l, job); convert_wt(lds, j, G, c, rot); } }
        if (s == 5) { s5_scan(lds, (const float*)(ws + OFF_S5S), (bf16_t*)(ws + OFF_UBUF), (const float*)(ws + OFF_LAM), G, c); }
        grid_barrier(bar_ctr, epoch, G);
#endif
        if (s == 4) { PH(5) gla_g1(lds, p, l, (const bf16_t*)(ws + OFF_K), (const bf16_t*)(ws + OFF_V), (const float*)(ws + OFF_Z), (bf16_t*)(ws + OFF_GS), (float*)(ws + OFF_DEC), G, (c + 32) % G); }
        if (s == 5) {
            PH(6) s5_scan(lds, (const float*)(ws + OFF_S5S), (bf16_t*)(ws + OFF_UBUF), (const float*)(ws + OFF_LAM), G, c);
            PH(7) gla_g2((bf16_t*)(ws + OFF_GS), (const float*)(ws + OFF_DEC), G, c);
        }
        if (s == 6) { PH(9) gla_g3(lds, p, l, (const bf16_t*)(ws + OFF_Q), (const bf16_t*)(ws + OFF_K), (const bf16_t*)(ws + OFF_V), (const bf16_t*)(ws + OFF_R), (const float*)(ws + OFF_Z),
                                   (const bf16_t*)(ws + OFF_GS), (bf16_t*)(ws + OFF_O), G, (c + 32) % G); }
        grid_barrier(bar_ctr, epoch, G);
    }
    {
        const int tid_ = opaque_tid(); const int wid = tid_ >> 6, lane = tid_ & 63;
        const float* gf = p.in[31]; const float* rowpart = (const float*)(ws + OFF_ROWPART);
        for (int row = c * 8 + wid; row < TR; row += G * 8) {
            float s = lane < 16 ? rowpart[(size_t)row * 16 + lane] : 0.f;
#pragma unroll
            for (int o = 8; o >= 1; o >>= 1) s += __shfl_xor(s, o);
            s = __shfl(s, 0);
            const float rs = rsqrtf(s * (1.f / 1024.f) + 1e-6f);
#pragma unroll
            for (int i = 0; i < 4; ++i) { const int col = (i * 64 + lane) * 4; f32x4 v = *(const f32x4*)(out + (size_t)row * DM + col); const f32x4 gv = *(const f32x4*)(gf + col); v = v * rs * gv; *(f32x4*)(out + (size_t)row * DM + col) = v; }
        }
    }
}

extern "C" void kernel_launch(void* const* d_in, const int* in_sizes, int n_in, void* d_out, int out_size, void* d_ws, size_t ws_size, hipStream_t stream) {
    static int grid_blocks = 0;
    if (grid_blocks == 0) {
        if (n_in != 32 || ws_size < WS_END || out_size != TR * DM) { fprintf(stderr, "kernel_launch: unexpected shapes / workspace (%d inputs, ws %zu < %zu)\n", n_in, ws_size, (size_t)WS_END); grid_blocks = -1; return; }
        int dev = 0, cus = 0, per_cu = 0;
        hipGetDevice(&dev); hipDeviceGetAttribute(&cus, hipDeviceAttributeMultiprocessorCount, dev);
        hipFuncSetAttribute((const void*)fwd_mega, hipFuncAttributeMaxDynamicSharedMemorySize, LDS_BYTES);
        hipOccupancyMaxActiveBlocksPerMultiprocessor(&per_cu, (const void*)fwd_mega, NTHR, LDS_BYTES);
        if (per_cu < 1) per_cu = 1;
        if (per_cu > 1) per_cu = 1;
        grid_blocks = cus * per_cu;
    }
    if (grid_blocks < 0) return;
    if (hipMemsetAsync((char*)d_ws + OFF_BAR, 0, 256, stream) != hipSuccess) { fprintf(stderr, "memset failed\n"); return; }
    Params p{};
    for (int i = 0; i < 32; ++i) p.in[i] = (const float*)d_in[i];
    p.out = (float*)d_out; p.ws = (unsigned char*)d_ws;
    void* args[] = {&p};
    hipError_t e = hipLaunchCooperativeKernel((const void*)fwd_mega, dim3(grid_blocks), dim3(NTHR), args, LDS_BYTES, stream);
    if (e != hipSuccess) fprintf(stderr, "cooperative launch failed: %s (grid %d)\n", hipGetErrorString(e), grid_blocks);
}
```

```cpp
#include <hip/hip_runtime.h>
#include <hip/hip_cooperative_groups.h>
#include <cstdio>
namespace cg = cooperative_groups;

#define LAS __attribute__((address_space(3)))
typedef unsigned short bf16_t;
typedef short bf16x8 __attribute__((ext_vector_type(8)));
typedef float f32x4 __attribute__((ext_vector_type(4)));
typedef float f32x2 __attribute__((ext_vector_type(2)));
typedef unsigned u32x4 __attribute__((ext_vector_type(4)));
typedef unsigned u32x2 __attribute__((ext_vector_type(2)));

constexpr int T = 32800, TR = 32768, DM = 1024, DFF = 2816, DIN = 4128;
constexpr int NCH = 1025, MCH = 2050;
constexpr int GCH = 257;
constexpr int NTHR = 512;
constexpr int LDS_BYTES = 131072;

constexpr size_t AL(size_t x) { return (x + 255) & ~size_t(255); }
constexpr size_t SLACK = size_t(2) << 20;
constexpr size_t OFF_HB = 0;
constexpr size_t OFF_METAH = OFF_HB + AL((size_t)T * 1024 * 2) + SLACK;
constexpr size_t OFF_ROWPART = OFF_METAH + 32 * 1024 * 4;
constexpr size_t OFF_LAM = OFF_ROWPART + AL((size_t)T * 16 * 4);
constexpr size_t LAM_BYTES = 32 * 2 * 64 * 2 * 4;
constexpr size_t OFF_W = OFF_LAM + 2 * LAM_BYTES;
constexpr size_t W_UP1 = 0, W_DN1 = W_UP1 + (size_t)5632 * 1024, W_INP = W_DN1 + (size_t)1024 * 2816, W_ING = W_INP + (size_t)2304 * 1024,
                 W_GLU = W_ING + (size_t)2048 * 1024, W_O = W_GLU + (size_t)2048 * 512, W_OUT = W_O + (size_t)1024 * 512,
                 W_UP2 = W_OUT + (size_t)1024 * 1024, W_DN2 = W_UP2 + (size_t)5632 * 1024, W_S1 = W_DN2 + (size_t)1024 * 2816,
                 W_S2 = W_S1 + (size_t)32 * 256 * 256, W_END = W_S2 + (size_t)32 * 256 * 512;
constexpr size_t W_BYTES = AL(W_END * 2);
constexpr size_t OFF_R1 = OFF_W + 2 * W_BYTES;
constexpr size_t R1_SIZE = AL((size_t)T * 2816 * 2) + SLACK;
constexpr size_t OFF_HID = OFF_R1;
constexpr size_t OFF_UBUF = OFF_R1;
constexpr size_t OFF_Q = OFF_UBUF + AL((size_t)32 * MCH * 512 * 2) + SLACK;
constexpr size_t OFF_K = OFF_Q + AL((size_t)T * 256 * 2);
constexpr size_t OFF_V = OFF_K + AL((size_t)T * 256 * 2);
constexpr size_t OFF_R = OFF_V + AL((size_t)T * 512 * 2);
constexpr size_t OFF_Z = OFF_R + AL((size_t)T * 512 * 2);
constexpr size_t OFF_ZEND = OFF_Z + AL((size_t)T * 32 * 4);
static_assert(OFF_ZEND <= OFF_R1 + R1_SIZE, "R1 overflow");
constexpr size_t OFF_SB = OFF_R1;
constexpr size_t OFF_GB = OFF_SB + AL((size_t)T * 1024 * 2) + SLACK;
static_assert(OFF_GB + AL((size_t)T * 1024 * 2) + SLACK <= OFF_R1 + R1_SIZE, "R1 overflow 2");
constexpr size_t OFF_R2 = OFF_R1 + R1_SIZE;
constexpr size_t OFF_S5S = OFF_R2;
constexpr size_t OFF_Y = OFF_R2;
constexpr size_t OFF_O = OFF_Y + AL((size_t)T * 512 * 2) + SLACK;
constexpr size_t R2A_A = AL((size_t)32 * MCH * 256 * 4), R2A_B = 2 * (AL((size_t)T * 512 * 2) + SLACK);
constexpr size_t R2A_SIZE = R2A_A > R2A_B ? R2A_A : R2A_B;
constexpr size_t OFF_GS = OFF_R2 + R2A_SIZE;
constexpr size_t OFF_DEC = OFF_GS + AL((size_t)4112 * 8192 * 2);
constexpr size_t OFF_BAR = OFF_DEC + AL((size_t)4112 * 64 * 4);
#ifdef DBG_DUP_ALLGEMM
constexpr size_t OFF_DUMMY = OFF_BAR + 4096;
constexpr size_t WS_END = OFF_DUMMY + AL((size_t)T * 1024 * 2) + SLACK;
#else
constexpr size_t WS_END = OFF_BAR + 4096;
#endif

#ifndef PHMASK
#if defined(DBG_NO_GLA)
#define PHMASK 0xFFFD5F
#elif defined(DBG_NO_INTER)
#define PHMASK 0xFFFF1F
#elif defined(DBG_NO_S5)
#define PHMASK 0xFFFFBF
#else
#define PHMASK 0xFFFFFF
#endif
#endif
#define PH(n) if constexpr (((PHMASK) >> (n)) & 1)
struct Params { const float* in[32]; float* out; unsigned char* ws; };

__device__ __forceinline__ float bf2f(bf16_t b) { return __uint_as_float(((unsigned)b) << 16); }
typedef __bf16 bf16x2_t __attribute__((ext_vector_type(2)));
__device__ __forceinline__ unsigned pk2(float lo, float hi) { bf16x2_t v; v.x = (__bf16)lo; v.y = (__bf16)hi; return __builtin_bit_cast(unsigned, v); }
__device__ __forceinline__ bf16_t f2bf(float f) { return (bf16_t)(pk2(f, 0.f) & 0xffffu); }
__device__ __forceinline__ float sigm(float x) { return __builtin_amdgcn_rcpf(1.f + __expf(-x)); }
__device__ __forceinline__ float siluf_(float x) { return x * sigm(x); }
__device__ __forceinline__ float gelu_tanh(float x) { const float u = 0.7978845608028654f * (x + 0.044715f * x * x * x); return x * sigm(2.f * u); }
__device__ __forceinline__ float logsig(float x) { return fminf(x, 0.f) - __logf(1.f + __expf(-fabsf(x))); }
__device__ __forceinline__ float lo16(unsigned w) { return __uint_as_float(w << 16); }
__device__ __forceinline__ float hi16(unsigned w) { return __uint_as_float(w & 0xffff0000u); }
__device__ __forceinline__ float row_rstd(const float* rowpart, int rowc, int fq) {
    const f32x4 p = *(const f32x4*)(rowpart + (size_t)rowc * 16 + 4 * fq);
    float s = (p[0] + p[1]) + (p[2] + p[3]);
    s += __shfl_xor(s, 16); s += __shfl_xor(s, 32);
    return rsqrtf(s * (1.f / 1024.f) + 1e-6f);
}
__device__ __forceinline__ float rstd_finish(const f32x4 p) {
    float s = (p[0] + p[1]) + (p[2] + p[3]);
    s += __shfl_xor(s, 16); s += __shfl_xor(s, 32);
    return rsqrtf(s * (1.f / 1024.f) + 1e-6f);
}
#define LOAD_RS8(rs, rowpart, u, wr, fr, fq, Mv) float rs[2][4]; { f32x4 _p[2][4]; \
    _Pragma("unroll") for (int ai = 0; ai < 2; ++ai) _Pragma("unroll") for (int m = 0; m < 4; ++m) { const int _r = (u).pm * 256 + ai * 128 + (wr) * 64 + m * 16 + (fr); const int _rc = _r < (Mv) ? _r : (Mv) - 1; \
        _p[ai][m] = *(const f32x4*)((rowpart) + (size_t)_rc * 16 + 4 * (fq)); } \
    _Pragma("unroll") for (int ai = 0; ai < 2; ++ai) _Pragma("unroll") for (int m = 0; m < 4; ++m) rs[ai][m] = rstd_finish(_p[ai][m]); }
__device__ __forceinline__ int opaque_tid() { int t = threadIdx.x; asm volatile("" : "+v"(t)); return t; }
__device__ __forceinline__ void row_to_mt(int row, int& m, int& t) {
    if (row < TR) { const int b = row >> 14, s = row & 16383, p = s + 16; m = b * NCH + (p >> 4); t = p & 15; }
    else { const int rr = row - TR; m = (rr >> 4) * NCH; t = rr & 15; }
}

namespace pg8 {
constexpr int BM = 256, BK = 64, HALF = 128, HTB = HALF * BK * 2, NXCD = 8, WGM = 8;
__device__ __forceinline__ int lds_byte(int r, int c) { const int st = (r >> 4) * 2 + (c >> 5), rr = r & 15, cc = c & 31, ob = rr * 64 + cc * 2; return st * 1024 + (ob ^ (((ob >> 9) & 1) << 5)); }
__device__ __forceinline__ void stage_rc(int b, int& R, int& C) { const int st = b / 1024, sb = b % 1024, swz = sb ^ (((sb >> 9) & 1) << 5); R = (st >> 1) * 16 + swz / 64; C = (st & 1) * 32 + (swz % 64) / 2; }
struct Unit { int pm, pn, pg; };
struct Gemm { const bf16_t* A; const bf16_t* Bt; int lda, K, nM, nN, nG; size_t gsA, gsB; int tail; int blkA; int rev; };

__device__ __forceinline__ int next_unit(const Gemm& g, int i, int G, int c) {
    const int nwg = g.nM * g.nN, tot = nwg * g.nG;
    const int L = i * G + c; if (L >= tot) return -1;
    int pm, pn, pg;
    if (g.nG > 1) { pg = L / nwg; const int r = L - pg * nwg; pm = r / g.nN; pn = r - pm * g.nN; }
    else {
        int wgid = L; { const int q = nwg / NXCD, r = nwg % NXCD, xcd = wgid % NXCD, off = wgid / NXCD; wgid = (xcd < r ? xcd * (q + 1) : r * (q + 1) + (xcd - r) * q) + off; }
        const int nig = WGM * g.nN, gid = wgid / nig, fm = gid * WGM, gsz = (g.nM - fm) < WGM ? (g.nM - fm) : WGM;
        const int rem = wgid - gid * nig; pn = rem / gsz; pm = fm + (rem - pn * gsz); pg = 0;
        if (g.rev) pm = g.nM - 1 - pm;
    }
    return pm | (pn << 10) | (pg << 20);
}
__device__ __forceinline__ Unit unpack_unit(int v) { Unit u; u.pm = v & 1023; u.pn = (v >> 10) & 1023; u.pg = v >> 20; return u; }

template <class Epi>
__device__ __forceinline__ void gemm_phase(LAS unsigned char* lds, const Gemm g, const Epi& E, const int G, const int c) {
    const int tid = opaque_tid(), wid = __builtin_amdgcn_readfirstlane(tid >> 6), lane = tid & 63, wr = wid >> 2, wc = wid & 3, fr = lane & 15, fq = lane >> 4;
    const int K = g.K, nt = K / BK;
    unsigned voffA[2], voffB[2];
#pragma unroll
    for (int i = 0; i < 2; ++i) { int R, C; stage_rc(tid * 16 + i * 8192, R, C); voffA[i] = (unsigned)(R * (g.blkA ? 64 : g.lda) + C) * 2u; voffB[i] = (unsigned)(R * K + C) * 2u; }
    const size_t kstep = (size_t)(BK * 2);
    const size_t kstepA = g.blkA ? (size_t)32768 : kstep;
    const size_t hstepA = g.blkA ? (size_t)16384 : (size_t)HALF * g.lda * 2, hstepB = (size_t)HALF * K * 2;
    const size_t tstepA = g.blkA ? (size_t)nt * 32768 : 2 * hstepA, tstepB = 2 * hstepB;
    const unsigned ldsw = (unsigned)wid * 1024u;
    const int aoff = lds_byte(wr * 64 + fr, fq * 8), boff = lds_byte(wc * 32 + fr, fq * 8);
#define PG8_SA(b, h) (((b) * 2 + (h)) * HTB)
#define PG8_SB(b, h) ((4 + (b) * 2 + (h)) * HTB)
#define PG8_STAGE(bufoff, gbase, voff) do { _Pragma("unroll") for (int _i = 0; _i < 2; ++_i) \
        __builtin_amdgcn_global_load_lds((const unsigned*)((const char*)(gbase) + (voff)[_i]), (LAS unsigned*)(lds + (bufoff) + ldsw + _i * 8192), 16, 0, 0); } while (0)
#define PG8_LDA(dst, b, h) do { _Pragma("unroll") for (int m = 0; m < 4; ++m) _Pragma("unroll") for (int k = 0; k < 2; ++k) dst[m][k] = *(const LAS bf16x8*)(lds + PG8_SA(b, h) + aoff + m * 2048 + k * 1024); } while (0)
#define PG8_LDB(dst, b, h) do { _Pragma("unroll") for (int n = 0; n < 2; ++n) _Pragma("unroll") for (int k = 0; k < 2; ++k) dst[n][k] = *(const LAS bf16x8*)(lds + PG8_SB(b, h) + boff + n * 2048 + k * 1024); } while (0)
#define PG8_MMA(ai, bj, At, Bt) do { __builtin_amdgcn_s_setprio(1); _Pragma("unroll") for (int m = 0; m < 4; ++m) _Pragma("unroll") for (int n = 0; n < 2; ++n) _Pragma("unroll") for (int k = 0; k < 2; ++k) \
        acc[ai][bj][m][n] = __builtin_amdgcn_mfma_f32_16x16x32_bf16(Bt[n][k], At[m][k], acc[ai][bj][m][n], 0, 0, 0); __builtin_amdgcn_s_setprio(0); } while (0)
#define PG8_WAIT_V(n) asm volatile("s_waitcnt vmcnt(" #n ")" ::: "memory")
#define PG8_WAIT_L(n) asm volatile("s_waitcnt lgkmcnt(" #n ")" ::: "memory")
#define PG8_BAR __builtin_amdgcn_s_barrier()
#define PG8_SCHED __builtin_amdgcn_sched_barrier(0)
    int ui = 0;
    int curp = next_unit(g, 0, G, c);
    Unit cur = unpack_unit(curp < 0 ? 0 : curp);
    f32x4 acc[2][2][4][2];
#pragma unroll
    for (int a = 0; a < 2; ++a)
#pragma unroll
        for (int b = 0; b < 2; ++b)
#pragma unroll
            for (int m = 0; m < 4; ++m)
#pragma unroll
                for (int n = 0; n < 2; ++n) acc[a][b][m][n] = (f32x4){0.f, 0.f, 0.f, 0.f};
    if (curp >= 0) {
    bf16x8 At[4][2], B0[2][2], B1[2][2];
    const char* cA = (const char*)(g.A + (size_t)cur.pg * g.gsA) + (size_t)cur.pm * tstepA;
    const char* cB = (const char*)(g.Bt + (size_t)cur.pg * g.gsB) + (size_t)cur.pn * tstepB;
    PG8_STAGE(PG8_SB(0, 0), cB, voffB); PG8_STAGE(PG8_SA(0, 0), cA, voffA); PG8_STAGE(PG8_SB(0, 1), cB + hstepB, voffB); PG8_STAGE(PG8_SA(0, 1), cA + hstepA, voffA);
    if (wr == 1) PG8_BAR;
    PG8_WAIT_V(4); PG8_BAR;
    PG8_STAGE(PG8_SB(1, 0), cB + kstep, voffB); PG8_STAGE(PG8_SA(1, 0), cA + kstepA, voffA); PG8_STAGE(PG8_SB(1, 1), cB + hstepB + kstep, voffB);
    PG8_WAIT_V(6); PG8_BAR;
    for (;;) {
        const int nxtp = next_unit(g, ui + 1, G, c); const bool has_next = nxtp >= 0; const Unit nxt = unpack_unit(has_next ? nxtp : curp);
        const char* nA = has_next ? (const char*)(g.A + (size_t)nxt.pg * g.gsA) + (size_t)nxt.pm * tstepA : cA;
        const char* nB = has_next ? (const char*)(g.Bt + (size_t)nxt.pg * g.gsB) + (size_t)nxt.pn * tstepB : cB;
        for (int t = 0; t < nt; t += 2) {
            const bool last = (t == nt - 2);
            const char* a1 = cA + (size_t)(t + 1) * kstepA;
            const char* a2 = last ? nA : cA + (size_t)(t + 2) * kstepA; const char* b2 = last ? nB : cB + (size_t)(t + 2) * kstep;
            const char* a3 = a2 + kstepA; const char* b3 = b2 + kstep;
            PG8_LDB(B0, 0, 0); PG8_SCHED; PG8_LDA(At, 0, 0); PG8_STAGE(PG8_SA(1, 1), a1 + hstepA, voffA);
            PG8_WAIT_L(8); PG8_BAR; PG8_WAIT_L(0); PG8_MMA(0, 0, At, B0); PG8_BAR; PG8_SCHED;
            PG8_LDB(B1, 0, 1); PG8_STAGE(PG8_SB(0, 0), b2, voffB);
            PG8_BAR; PG8_WAIT_L(0); PG8_MMA(0, 1, At, B1); PG8_BAR;
            PG8_LDA(At, 0, 1); PG8_STAGE(PG8_SA(0, 0), a2, voffA);
            PG8_BAR; PG8_WAIT_L(0); PG8_MMA(1, 0, At, B0); PG8_BAR; PG8_SCHED;
            PG8_STAGE(PG8_SB(0, 1), b2 + hstepB, voffB);
            PG8_WAIT_V(6); PG8_BAR; PG8_MMA(1, 1, At, B1); PG8_BAR;
            PG8_LDB(B0, 1, 0); PG8_SCHED; PG8_LDA(At, 1, 0); PG8_STAGE(PG8_SA(0, 1), a2 + hstepA, voffA);
            PG8_WAIT_L(8); PG8_BAR; PG8_WAIT_L(0); PG8_MMA(0, 0, At, B0); PG8_BAR; PG8_SCHED;
            PG8_LDB(B1, 1, 1); PG8_STAGE(PG8_SB(1, 0), b3, voffB);
            PG8_BAR; PG8_WAIT_L(0); PG8_MMA(0, 1, At, B1); PG8_BAR;
            PG8_LDA(At, 1, 1); PG8_STAGE(PG8_SA(1, 0), a3, voffA);
            PG8_BAR; PG8_WAIT_L(0); PG8_MMA(1, 0, At, B0); PG8_BAR; PG8_SCHED;
            PG8_STAGE(PG8_SB(1, 1), b3 + hstepB, voffB);
            PG8_WAIT_V(6); PG8_BAR; PG8_MMA(1, 1, At, B1); PG8_BAR;
        }
        { int efr = fr, efq = fq; asm volatile("" : "+v"(efr), "+v"(efq)); E(acc, cur, wr, wc, efr, efq); }
        if (!has_next) break;
#pragma unroll
        for (int a = 0; a < 2; ++a)
#pragma unroll
            for (int b = 0; b < 2; ++b)
#pragma unroll
                for (int m = 0; m < 4; ++m)
#pragma unroll
                    for (int n = 0; n < 2; ++n) acc[a][b][m][n] = (f32x4){0.f, 0.f, 0.f, 0.f};
        cur = nxt; curp = nxtp; cA = nA; cB = nB; ++ui;
    }
    PG8_WAIT_V(0);
    if (wr == 0) PG8_BAR;
    PG8_BAR;
    }
    if (g.tail) {
        const int ks = K >> 3;
        for (int j = G - 1 - c; j < 4 * g.nN; j += G) {
            const int pn = j >> 2, q = j & 3;
#pragma unroll
            for (int a = 0; a < 2; ++a)
#pragma unroll
                for (int b = 0; b < 2; ++b)
#pragma unroll
                    for (int m = 0; m < 4; ++m)
#pragma unroll
                        for (int n = 0; n < 2; ++n) acc[a][b][m][n] = (f32x4){0.f, 0.f, 0.f, 0.f};
            const bf16_t* Ap = g.blkA ? g.A + (size_t)g.nM * nt * 16384 + fr * 64 + fq * 8 : g.A + (size_t)(g.nM * 256 + fr) * g.lda + fq * 8;
            const bf16_t* Bp = g.Bt + (size_t)(pn * 256 + q * 32 + fr) * K + wid * ks + fq * 8;
            const size_t a16 = g.blkA ? (size_t)16 * 64 : (size_t)16 * g.lda, b16 = (size_t)16 * K, b128 = (size_t)128 * K;
            for (int k0 = 0; k0 < ks; k0 += 64) {
                bf16x8 av[2][2], bv[2][4];
#pragma unroll
                for (int qq = 0; qq < 2; ++qq) if (k0 + qq * 32 < ks) {
                    const int kk = k0 + qq * 32, ka = wid * ks + kk; const size_t ao = g.blkA ? (size_t)(ka >> 6) * 16384 + (ka & 63) : (size_t)ka;
                    av[qq][0] = *(const bf16x8*)(Ap + ao); av[qq][1] = *(const bf16x8*)(Ap + a16 + ao);
                    bv[qq][0] = *(const bf16x8*)(Bp + kk); bv[qq][1] = *(const bf16x8*)(Bp + b16 + kk);
                    bv[qq][2] = *(const bf16x8*)(Bp + b128 + kk); bv[qq][3] = *(const bf16x8*)(Bp + b128 + b16 + kk);
                }
#pragma unroll
                for (int qq = 0; qq < 2; ++qq) if (k0 + qq * 32 < ks) {
                    acc[0][0][0][0] = __builtin_amdgcn_mfma_f32_16x16x32_bf16(bv[qq][0], av[qq][0], acc[0][0][0][0], 0, 0, 0);
                    acc[0][0][1][0] = __builtin_amdgcn_mfma_f32_16x16x32_bf16(bv[qq][0], av[qq][1], acc[0][0][1][0], 0, 0, 0);
                    acc[0][0][0][1] = __builtin_amdgcn_mfma_f32_16x16x32_bf16(bv[qq][1], av[qq][0], acc[0][0][0][1], 0, 0, 0);
                    acc[0][0][1][1] = __builtin_amdgcn_mfma_f32_16x16x32_bf16(bv[qq][1], av[qq][1], acc[0][0][1][1], 0, 0, 0);
                    acc[0][1][0][0] = __builtin_amdgcn_mfma_f32_16x16x32_bf16(bv[qq][2], av[qq][0], acc[0][1][0][0], 0, 0, 0);
                    acc[0][1][1][0] = __builtin_amdgcn_mfma_f32_16x16x32_bf16(bv[qq][2], av[qq][1], acc[0][1][1][0], 0, 0, 0);
                    acc[0][1][0][1] = __builtin_amdgcn_mfma_f32_16x16x32_bf16(bv[qq][3], av[qq][0], acc[0][1][0][1], 0, 0, 0);
                    acc[0][1][1][1] = __builtin_amdgcn_mfma_f32_16x16x32_bf16(bv[qq][3], av[qq][1], acc[0][1][1][1], 0, 0, 0);
                }
            }
            LAS f32x4* red = (LAS f32x4*)lds;
#pragma unroll
            for (int bj = 0; bj < 2; ++bj)
#pragma unroll
                for (int m = 0; m < 2; ++m)
#pragma unroll
                    for (int n = 0; n < 2; ++n) red[(wid * 8 + bj * 4 + m * 2 + n) * 64 + lane] = acc[0][bj][m][n];
            __syncthreads();
            if (wid == q) {
#pragma unroll
                for (int bj = 0; bj < 2; ++bj)
#pragma unroll
                    for (int m = 0; m < 2; ++m)
#pragma unroll
                        for (int n = 0; n < 2; ++n) {
                            f32x4 sum = (f32x4){0.f, 0.f, 0.f, 0.f};
#pragma unroll 2
                            for (int w = 0; w < 8; ++w) sum += red[(w * 8 + bj * 4 + m * 2 + n) * 64 + lane];
                            acc[0][bj][m][n] = sum;
                            asm volatile("" ::: "memory");
                        }
                Unit tu; tu.pm = g.nM; tu.pn = pn; tu.pg = 0; int efr = fr, efq = fq; asm volatile("" : "+v"(efr), "+v"(efq)); E(acc, tu, 0, q, efr, efq);
            }
            __syncthreads();
        }
    }
#undef PG8_SA
#undef PG8_SB
#undef PG8_STAGE
#undef PG8_LDA
#undef PG8_LDB
#undef PG8_MMA
#undef PG8_WAIT_V
#undef PG8_WAIT_L
#undef PG8_BAR
#undef PG8_SCHED
}
}
using pg8::Unit;
typedef f32x4 Acc[2][2][4][2];

struct EpiUp {
    const float* rowpart; bf16_t* hid; int Mv;
    __device__ __forceinline__ void operator()(const Acc& acc, const Unit& u, int wr, int wc, int fr, int fq) const {
        LOAD_RS8(rsv, rowpart, u, wr, fr, fq, Mv)
#pragma unroll
        for (int ai = 0; ai < 2; ++ai)
#pragma unroll
            for (int m = 0; m < 4; ++m) {
                const int row = u.pm * 256 + ai * 128 + wr * 64 + m * 16 + fr;
                const float rs = rsv[ai][m];
#pragma unroll
                for (int bj = 0; bj < 2; ++bj) {
                    const f32x4 gv = acc[ai][bj][m][0] * rs, uv = acc[ai][bj][m][1] * rs;
                    u32x2 w; w.x = pk2(siluf_(gv[0]) * uv[0], siluf_(gv[1]) * uv[1]); w.y = pk2(siluf_(gv[2]) * uv[2], siluf_(gv[3]) * uv[3]);
                    const int col = 128 * u.pn + 64 * bj + 16 * wc + 4 * fq;
                    if (row < Mv) *(u32x2*)(hid + ((size_t)((row >> 8) * 44 + (col >> 6)) * 256 + (row & 255)) * 64 + (col & 63)) = w;
                }
            }
    }
};
struct EpiRes {
    float* out; float* metah; bf16_t* hb; float* rowpart; float scale; int Mv;
    __device__ __forceinline__ void operator()(const Acc& acc, const Unit& u, int wr, int wc, int fr, int fq) const {
#pragma unroll
        for (int ai = 0; ai < 2; ++ai) {
            u32x2 old[4][2][2];
#pragma unroll
            for (int m = 0; m < 4; ++m) {
                const int row = u.pm * 256 + ai * 128 + wr * 64 + m * 16 + fr; const int rc = row < Mv ? row : Mv - 1;
                const bf16_t* hp = hb + (size_t)rc * DM + 256 * u.pn + 32 * wc + 4 * fq;
#pragma unroll
                for (int bj = 0; bj < 2; ++bj)
#pragma unroll
                    for (int n = 0; n < 2; ++n) old[m][bj][n] = *(const u32x2*)(hp + 128 * bj + 16 * n);
            }
#pragma unroll
            for (int m = 0; m < 4; ++m) {
                const int row = u.pm * 256 + ai * 128 + wr * 64 + m * 16 + fr; const bool valid = row < Mv; const int rc = valid ? row : Mv - 1;
                bf16_t* hp = hb + (size_t)rc * DM + 256 * u.pn + 32 * wc + 4 * fq;
                float ss = 0.f;
#pragma unroll
                for (int bj = 0; bj < 2; ++bj)
#pragma unroll
                    for (int n = 0; n < 2; ++n) {
                        const u32x2 o = old[m][bj][n]; const f32x4 a = acc[ai][bj][m][n];
                        f32x4 nv; nv[0] = lo16(o.x) + a[0] * scale; nv[1] = hi16(o.x) + a[1] * scale; nv[2] = lo16(o.y) + a[2] * scale; nv[3] = hi16(o.y) + a[3] * scale;
                        ss += (nv[0] * nv[0] + nv[1] * nv[1]) + (nv[2] * nv[2] + nv[3] * nv[3]);
                        if (valid) { u32x2 w; w.x = pk2(nv[0], nv[1]); w.y = pk2(nv[2], nv[3]); *(u32x2*)(hp + 128 * bj + 16 * n) = w; }
                    }
                ss += __shfl_xor(ss, 16); ss += __shfl_xor(ss, 32);
                if (valid && fq == 0) rowpart[(size_t)row * 16 + u.pn * 4 + wc] = ss;
            }
            asm volatile("" ::: "memory");
        }
    }
};
struct EpiProj {
    const float* rowpart; bf16_t* ubuf; bf16_t* q; bf16_t* k; bf16_t* v; bf16_t* r; float* z; int Mv;
    __device__ __forceinline__ void operator()(const Acc& acc, const Unit& u, int wr, int wc, int fr, int fq) const {
        const int pn = u.pn;
        LOAD_RS8(rsv, rowpart, u, wr, fr, fq, Mv)
#pragma unroll
        for (int ai = 0; ai < 2; ++ai)
#pragma unroll
            for (int m = 0; m < 4; ++m) {
                const int row = u.pm * 256 + ai * 128 + wr * 64 + m * 16 + fr; const bool valid = row < Mv; const int rc = valid ? row : Mv - 1;
                const float rs = rsv[ai][m];
                int mm, tt; row_to_mt(rc, mm, tt);
#pragma unroll
                for (int bj = 0; bj < 2; ++bj)
#pragma unroll
                    for (int n = 0; n < 2; ++n) {
                        const f32x4 val = acc[ai][bj][m][n] * rs;
                        const int cl = 128 * bj + 32 * wc + 16 * n + 4 * fq;
                        u32x2 w; w.x = pk2(val[0], val[1]); w.y = pk2(val[2], val[3]);
                        if (!valid) continue;
                        if (pn < 2) { const int cc = 256 * pn + cl; const int gg = cc >> 4, j = cc & 15; *(u32x2*)(ubuf + ((size_t)gg * MCH + mm) * 512 + tt * 16 + j) = w; }
                        else if (pn == 2) *(u32x2*)(q + (size_t)row * 256 + cl) = w;
                        else if (pn == 3) *(u32x2*)(k + (size_t)row * 256 + cl) = w;
                        else if (pn < 6) *(u32x2*)(v + (size_t)row * 512 + (pn - 4) * 256 + cl) = w;
                        else if (pn < 8) *(u32x2*)(r + (size_t)row * 512 + (pn - 6) * 256 + cl) = w;
                        else if (cl < 32) *(f32x4*)(z + (size_t)row * 32 + cl) = val;
                    }
            }
    }
};
struct EpiS5S {
    float* S;
    __device__ __forceinline__ void operator()(const Acc& acc, const Unit& u, int wr, int wc, int fr, int fq) const {
#pragma unroll
        for (int ai = 0; ai < 2; ++ai)
#pragma unroll
            for (int m = 0; m < 4; ++m) {
                const int row = u.pm * 256 + ai * 128 + wr * 64 + m * 16 + fr;
                if (row < MCH) {
#pragma unroll
                    for (int bj = 0; bj < 2; ++bj)
#pragma unroll
                        for (int n = 0; n < 2; ++n) *(f32x4*)(S + ((size_t)u.pg * MCH + row) * 256 + 128 * bj + 32 * wc + 16 * n + 4 * fq) = acc[ai][bj][m][n];
                }
            }
    }
};
struct EpiS5Y {
    bf16_t* y;
    __device__ __forceinline__ void operator()(const Acc& acc, const Unit& u, int wr, int wc, int fr, int fq) const {
#pragma unroll
        for (int ai = 0; ai < 2; ++ai)
#pragma unroll
            for (int m = 0; m < 4; ++m) {
                const int mrow = u.pm * 256 + ai * 128 + wr * 64 + m * 16 + fr;
                if (mrow < MCH) {
                    const int b = mrow >= NCH ? 1 : 0, cch = mrow - b * NCH;
                    const int rbase = cch == 0 ? TR + 16 * b : b * 16384 + 16 * (cch - 1);
#pragma unroll
                    for (int bj = 0; bj < 2; ++bj)
#pragma unroll
                        for (int n = 0; n < 2; ++n) {
                            const int tt = 8 * bj + 2 * wc + n; const f32x4 a = acc[ai][bj][m][n];
                            u32x2 w; w.x = pk2(gelu_tanh(a[0]), gelu_tanh(a[1])); w.y = pk2(gelu_tanh(a[2]), gelu_tanh(a[3]));
                            *(u32x2*)(y + (size_t)(rbase + tt) * 512 + u.pg * 16 + 4 * fq) = w;
                        }
                }
            }
    }
};
struct EpiGlu {
    bf16_t* S; int Mv;
    __device__ __forceinline__ void operator()(const Acc& acc, const Unit& u, int wr, int wc, int fr, int fq) const {
#pragma unroll
        for (int ai = 0; ai < 2; ++ai)
#pragma unroll
            for (int m = 0; m < 4; ++m) {
                const int row = u.pm * 256 + ai * 128 + wr * 64 + m * 16 + fr;
#pragma unroll
                for (int bj = 0; bj < 2; ++bj) {
                    const f32x4 a = acc[ai][bj][m][0], b = acc[ai][bj][m][1];
                    u32x2 w; w.x = pk2(a[0] * sigm(b[0]), a[1] * sigm(b[1])); w.y = pk2(a[2] * sigm(b[2]), a[3] * sigm(b[3]));
                    const int col = 128 * u.pn + 64 * bj + 16 * wc + 4 * fq;
                    if (row < Mv) *(u32x2*)(S + (size_t)row * DM + col) = w;
                }
            }
    }
};
struct EpiBf {
    bf16_t* O; int Mv;
    __device__ __forceinline__ void operator()(const Acc& acc, const Unit& u, int wr, int wc, int fr, int fq) const {
#pragma unroll
        for (int ai = 0; ai < 2; ++ai)
#pragma unroll
            for (int m = 0; m < 4; ++m) {
                const int row = u.pm * 256 + ai * 128 + wr * 64 + m * 16 + fr;
#pragma unroll
                for (int bj = 0; bj < 2; ++bj)
#pragma unroll
                    for (int n = 0; n < 2; ++n) {
                        const f32x4 a = acc[ai][bj][m][n]; u32x2 w; w.x = pk2(a[0], a[1]); w.y = pk2(a[2], a[3]);
                        const int col = 256 * u.pn + 128 * bj + 32 * wc + 16 * n + 4 * fq;
                        if (row < Mv) *(u32x2*)(O + (size_t)row * DM + col) = w;
                    }
            }
    }
};
struct EpiGate {
    const float* rowpart; bf16_t* S; const bf16_t* Gm; int Mv;
    __device__ __forceinline__ void operator()(const Acc& acc, const Unit& u, int wr, int wc, int fr, int fq) const {
        LOAD_RS8(rsv, rowpart, u, wr, fr, fq, Mv)
#pragma unroll
        for (int ai = 0; ai < 2; ++ai) {
            u32x2 sv[4][2], gv[4][2];
#pragma unroll
            for (int m = 0; m < 4; ++m)
#pragma unroll
                for (int bj = 0; bj < 2; ++bj) {
                    const int row = u.pm * 256 + ai * 128 + wr * 64 + m * 16 + fr; const int rc = row < Mv ? row : Mv - 1; const int col = 128 * u.pn + 64 * bj + 16 * wc + 4 * fq;
                    sv[m][bj] = *(const u32x2*)(S + (size_t)rc * DM + col); gv[m][bj] = *(const u32x2*)(Gm + (size_t)rc * DM + col);
                }
#pragma unroll
            for (int m = 0; m < 4; ++m) {
                const int row = u.pm * 256 + ai * 128 + wr * 64 + m * 16 + fr; const bool valid = row < Mv;
                const float rs = rsv[ai][m];
#pragma unroll
                for (int bj = 0; bj < 2; ++bj) {
                    const int col = 128 * u.pn + 64 * bj + 16 * wc + 4 * fq;
                    const f32x4 g0 = acc[ai][bj][m][0] * rs, g1 = acc[ai][bj][m][1] * rs;
                    const u32x2 s2 = sv[m][bj], g2 = gv[m][bj];
                    const float o0 = sigm(g0[0]) * lo16(s2.x) + sigm(g1[0]) * lo16(g2.x), o1 = sigm(g0[1]) * hi16(s2.x) + sigm(g1[1]) * hi16(g2.x);
                    const float o2 = sigm(g0[2]) * lo16(s2.y) + sigm(g1[2]) * lo16(g2.y), o3 = sigm(g0[3]) * hi16(s2.y) + sigm(g1[3]) * hi16(g2.y);
                    u32x2 w; w.x = pk2(o0, o1); w.y = pk2(o2, o3);
                    if (valid) *(u32x2*)(S + (size_t)row * DM + col) = w;
                }
            }
            asm volatile("" ::: "memory");
        }
    }
};

struct CvtJob { const float* s0; const float* s1; const float* scale; bf16_t* dst; int K, N, ld, pair, nvalid, q0, q1; };
__device__ __forceinline__ const float* cvt_map(const CvtJob& j, int c, float& mul) {
    mul = 1.f;
    if (j.pair) { const int col = (c >> 5) * 16 + (c & 15); return ((c >> 4) & 1) ? j.s1 + col : j.s0 + col; }
    if (c >= j.q0 && c < j.q1) mul = 0.125f;
    return c < j.nvalid ? j.s0 + c : nullptr;
}
__device__ __forceinline__ void cvt_load(const CvtJob& j, int ti, int nkt, int tid, f32x4 (&v)[2][4]) {
    const int k0 = (ti % nkt) * 64, c0 = (ti / nkt) * 256;
    const int cq = (tid & 15) * 4, kk0 = tid >> 4;
#pragma unroll
    for (int cb = 0; cb < 4; ++cb) {
        float mul; const float* sp = cvt_map(j, c0 + cb * 64 + cq, mul);
#pragma unroll
        for (int ps = 0; ps < 2; ++ps) {
            const int kk = kk0 + 32 * ps;
            v[ps][cb] = (f32x4){0.f, 0.f, 0.f, 0.f};
            if (sp) { v[ps][cb] = *(const f32x4*)(sp + (size_t)(k0 + kk) * j.ld); const float sc = (j.scale ? j.scale[k0 + kk] : 1.f) * mul; v[ps][cb] = v[ps][cb] * sc; }
        }
    }
}
__device__ __forceinline__ void convert_wt(LAS unsigned char* lds, const CvtJob& j, int G, int c, int& rot) {
    LAS float* tile = (LAS float*)lds;
    const int tid = opaque_tid();
    const int K = j.K;
    const int nkt = K / 64, nct = j.N / 256, ntile = nkt * nct;
    int ti = (c + G - (rot % G)) % G;
    f32x4 v[2][4];
    if (ti < ntile) cvt_load(j, ti, nkt, tid, v);
    for (; ti < ntile; ti += G) {
        const int k0 = (ti % nkt) * 64, c0 = (ti / nkt) * 256;
        {
            const int cq = (tid & 15) * 4, kk0 = tid >> 4;
#pragma unroll
            for (int cb = 0; cb < 4; ++cb)
#pragma unroll
                for (int ps = 0; ps < 2; ++ps) {
                    const int kk = kk0 + 32 * ps; LAS float* tp = tile + kk * 257 + cb * 64 + cq;
                    tp[0] = v[ps][cb][0]; tp[1] = v[ps][cb][1]; tp[2] = v[ps][cb][2]; tp[3] = v[ps][cb][3];
                }
        }
        __syncthreads();
        if (ti + G < ntile) cvt_load(j, ti + G, nkt, tid, v);
        {
            const int cc = tid >> 1, kq = (tid & 1) * 32;
#pragma unroll
            for (int q = 0; q < 4; ++q) {
                const int kb = kq + q * 8; u32x4 w;
                w.x = pk2(tile[(kb + 0) * 257 + cc], tile[(kb + 1) * 257 + cc]); w.y = pk2(tile[(kb + 2) * 257 + cc], tile[(kb + 3) * 257 + cc]);
                w.z = pk2(tile[(kb + 4) * 257 + cc], tile[(kb + 5) * 257 + cc]); w.w = pk2(tile[(kb + 6) * 257 + cc], tile[(kb + 7) * 257 + cc]);
                *(u32x4*)(j.dst + (size_t)(c0 + cc) * K + k0 + kb) = w;
            }
        }
        __syncthreads();
    }
    rot += ntile;
}
__device__ __forceinline__ CvtJob make_job(const Params& p, int l, int job) {
    bf16_t* W = (bf16_t*)(p.ws + OFF_W + (size_t)l * W_BYTES);
    const float* win = p.in[7] + (size_t)l * DM * DIN; const float* wglu = p.in[19] + (size_t)l * 512 * 2048;
    const float* n1 = p.in[2] + (size_t)l * DM; const float* nm = p.in[6] + (size_t)l * DM; const float* n2 = p.in[27] + (size_t)l * DM;
    switch (job) {
    case 0: return CvtJob{p.in[3] + (size_t)l * DM * DFF, p.in[4] + (size_t)l * DM * DFF, n1, W + W_UP1, 1024, 5632, DFF, 1, 0, 0, 0};
    case 1: return CvtJob{p.in[5] + (size_t)l * DFF * DM, nullptr, nullptr, W + W_DN1, 2816, 1024, DM, 0, 1024, 0, 0};
    case 2: return CvtJob{win, nullptr, nm, W + W_INP, 1024, 2304, DIN, 0, 2080, 512, 768};
    case 3: return CvtJob{win + 2080, win + 2080 + 1024, nm, W + W_ING, 1024, 2048, DIN, 1, 0, 0, 0};
    case 4: return CvtJob{wglu, wglu + 1024, nullptr, W + W_GLU, 512, 2048, 2048, 1, 0, 0, 0};
    case 5: return CvtJob{p.in[25] + (size_t)l * 512 * DM, nullptr, nullptr, W + W_O, 512, 1024, DM, 0, 1024, 0, 0};
    case 6: return CvtJob{p.in[26] + (size_t)l * DM * DM, nullptr, nullptr, W + W_OUT, 1024, 1024, DM, 0, 1024, 0, 0};
    case 7: return CvtJob{p.in[28] + (size_t)l * DM * DFF, p.in[29] + (size_t)l * DM * DFF, n2, W + W_UP2, 1024, 5632, DFF, 1, 0, 0, 0};
    default: return CvtJob{p.in[30] + (size_t)l * DFF * DM, nullptr, nullptr, W + W_DN2, 2816, 1024, DM, 0, 1024, 0, 0};
    }
}

__device__ __forceinline__ void s5_gen(LAS unsigned char* lds, const Params& p, int l, int g, bf16_t* B1, bf16_t* B2, float* lamtab, int part) {
    const int tid = opaque_tid();
    LAS f32x2* P = (LAS f32x2*)lds;
    LAS f32x2* BB = P + 2 * 17 * 64;
    LAS f32x2* CC = BB + 2 * 64 * 16;
    LAS f32x2* F = CC + 16 * 64;
    LAS float* KT = (LAS float*)(F + 128);
    const float* a_re0 = p.in[8] + (size_t)(l * 32 + g) * 64; const float* a_re1 = p.in[11] + (size_t)(l * 32 + g) * 64;
    const float* a_im0 = p.in[9] + (size_t)(l * 32 + g) * 64; const float* a_im1 = p.in[12] + (size_t)(l * 32 + g) * 64;
    const float ldt0 = p.in[10][l * 32 + g], ldt1 = p.in[13][l * 32 + g];
    const float* b_re = p.in[14] + (size_t)(l * 32 + g) * 1024; const float* b_im = p.in[15] + (size_t)(l * 32 + g) * 1024;
    const float* c_re = p.in[16] + (size_t)(l * 32 + g) * 1024; const float* c_im = p.in[17] + (size_t)(l * 32 + g) * 1024;
    const float* dd = p.in[18] + (size_t)l * 512 + g * 16;
    __syncthreads();
    for (int e = tid; e < 2 * 17 * 64; e += NTHR) {
        const int dir = e / (17 * 64), n = (e / 64) % 17, pp = e & 63;
        const float dt = expf(dir ? ldt1 : ldt0); const float ar = (dir ? a_re1 : a_re0)[pp], ai = (dir ? a_im1 : a_im0)[pp];
        const float mag = expf(ar * dt * (float)n), ang = ai * dt * (float)n;
        P[e] = (f32x2){mag * cosf(ang), mag * sinf(ang)};
    }
    if (tid < 128) {
        const int dir = tid >> 6, pp = tid & 63;
        const float dt = expf(dir ? ldt1 : ldt0); const float ar = (dir ? a_re1 : a_re0)[pp], ai = (dir ? a_im1 : a_im0)[pp];
        const float mag = expf(ar * dt); const float lr = mag * cosf(ai * dt), li = mag * sinf(ai * dt);
        const float den = ar * ar + ai * ai; const float ir = ar / den, ii = -ai / den;
        const float xr = lr - 1.f, xi = li;
        F[tid] = (f32x2){xr * ir - xi * ii, xr * ii + xi * ir};
        const float m16 = expf(ar * dt * 16.f), a16 = ai * dt * 16.f;
        if (part != 1) *(f32x2*)(lamtab + ((size_t)(g * 2 + dir) * 64 + pp) * 2) = (f32x2){m16 * cosf(a16), m16 * sinf(a16)};
    }
    for (int e = tid; e < 1024; e += NTHR) { const int i = e >> 6, pp = e & 63; CC[e] = (f32x2){c_re[i * 64 + pp], c_im[i * 64 + pp]}; }
    __syncthreads();
    for (int e = tid; e < 2048; e += NTHR) {
        const int dir = e >> 10, pj = e & 1023, pp = pj >> 4; const f32x2 f = F[dir * 64 + pp]; const float br = b_re[pj], bi = b_im[pj];
        BB[e] = (f32x2){f.x * br - f.y * bi, f.x * bi + f.y * br};
    }
    __syncthreads();
    if (part != 0) {
        const int dir = tid >> 8, n = (tid >> 4) & 15, i = tid & 15;
        float sj[16];
#pragma unroll
        for (int j = 0; j < 16; ++j) sj[j] = 0.f;
        for (int pp = 0; pp < 64; ++pp) {
            const f32x2 cv = CC[i * 64 + pp], pv = P[(dir * 17 + n) * 64 + pp];
            const float xr = cv.x * pv.x - cv.y * pv.y, xi = cv.x * pv.y + cv.y * pv.x;
#pragma unroll
            for (int j = 0; j < 16; ++j) { const f32x2 bv = BB[(dir * 64 + pp) * 16 + j]; sj[j] += xr * bv.x - xi * bv.y; }
        }
#pragma unroll
        for (int j = 0; j < 16; ++j) KT[(((dir * 16 + n) * 16 + i) << 4) + j] = sj[j];
    }
    __syncthreads();
    if (part != 1) for (int e = tid; e < 256 * 32; e += NTHR) {
        const int n = e >> 5, k0 = (e & 31) * 8; const int dir = n >> 7, reim = (n >> 6) & 1, pp = n & 63; const int s = k0 >> 4, j0 = k0 & 15;
        const f32x2 pv = P[(dir * 17 + (dir == 0 ? 15 - s : s)) * 64 + pp]; float o[8];
#pragma unroll
        for (int jj = 0; jj < 8; ++jj) { const f32x2 bv = BB[(dir * 64 + pp) * 16 + j0 + jj]; o[jj] = reim == 0 ? pv.x * bv.x - pv.y * bv.y : pv.x * bv.y + pv.y * bv.x; }
        u32x4 w; w.x = pk2(o[0], o[1]); w.y = pk2(o[2], o[3]); w.z = pk2(o[4], o[5]); w.w = pk2(o[6], o[7]);
        *(u32x4*)(B1 + (size_t)n * 256 + k0) = w;
    }
    for (int e = tid; e < 256 * 64; e += NTHR) {
        const int n = e >> 6, k0 = (e & 63) * 8; const int t = n >> 4, i = n & 15; float o[8];
        if (part == 0 && k0 < 256) continue;
        if (part == 1 && k0 >= 256) continue;
        if (k0 < 256) {
            const int s = k0 >> 4, j0 = k0 & 15;
#pragma unroll
            for (int jj = 0; jj < 8; ++jj) {
                const int j = j0 + jj; float v = 0.f;
                if (t >= s) v += KT[((0 * 16) + (t - s)) * 256 + i * 16 + j];
                if (s >= t) v += KT[((1 * 16) + (s - t)) * 256 + i * 16 + j];
                if (s == t && i == j) v += dd[i];
                o[jj] = v;
            }
        } else {
            const int kk = k0 - 256; const int dir = kk >> 7, reim = (kk >> 6) & 1, p0 = kk & 63; const int pw = dir == 0 ? t + 1 : 16 - t;
#pragma unroll
            for (int jj = 0; jj < 8; ++jj) {
                const f32x2 cv = CC[i * 64 + p0 + jj], pv = P[(dir * 17 + pw) * 64 + p0 + jj];
                o[jj] = reim == 0 ? (cv.x * pv.x - cv.y * pv.y) : -(cv.x * pv.y + cv.y * pv.x);
            }
        }
        u32x4 w; w.x = pk2(o[0], o[1]); w.y = pk2(o[2], o[3]); w.z = pk2(o[4], o[5]); w.w = pk2(o[6], o[7]);
        *(u32x4*)(B2 + (size_t)n * 512 + k0) = w;
    }
    __syncthreads();
}

constexpr int GL_BF = 0, GL_BB = 16384, GL_X = 32768;
__device__ __forceinline__ int gla_row0(int b, int n) { return n == 0 ? TR + 16 * b : b * 16384 + 64 * (n - 1); }
__device__ __forceinline__ void lds_barrier() { asm volatile("s_waitcnt lgkmcnt(0)" ::: "memory"); __builtin_amdgcn_s_barrier(); asm volatile("" ::: "memory"); }
struct GlaIn { f32x4 z; float w20, w21, w22, w23; float bi; u32x4 k; u32x4 v0, v1; };
struct GlaIn3 { u32x4 q; u32x4 h0, h1, h2, h3; };
__device__ __forceinline__ void gla_task(int task, int& bh, int& hh, int& n, int& row0, int& ntok) {
    n = task % GCH; bh = task / GCH; hh = bh & 3; const int b = bh >> 2; row0 = gla_row0(b, n); ntok = n == 0 ? 16 : 64;
}
template <bool G3>
__device__ __forceinline__ void gla_load(const Params& p, int l, int task, int tid, const float* zbuf, const bf16_t* qbuf, const bf16_t* kbuf, const bf16_t* vbuf, const bf16_t* gs, GlaIn& in, GlaIn3& in3) {
    int bh, hh, n, row0, ntok; gla_task(task, bh, hh, n, row0, ntok);
    const int t = tid >> 3; const bool tv = t < ntok; const u32x4 z4 = (u32x4){0u, 0u, 0u, 0u};
    in.z = tv ? *(const f32x4*)(zbuf + (size_t)(row0 + t) * 32 + (tid & 7) * 4) : (f32x4){0.f, 0.f, 0.f, 0.f};
    { float wv[4];
#pragma unroll
    for (int i = 0; i < 4; ++i) { const int e = tid + NTHR * i; const int dir = e >> 10, r = (e >> 6) & 15, d = e & 63; wv[i] = (dir ? p.in[22] : p.in[20])[(size_t)l * 16 * 256 + r * 256 + hh * 64 + d]; }
    in.w20 = wv[0]; in.w21 = wv[1]; in.w22 = wv[2]; in.w23 = wv[3]; }
    in.bi = 0.f; if (tid < 128) { const int dir = tid >> 6, d = tid & 63; in.bi = (dir ? p.in[23] : p.in[21])[l * 256 + hh * 64 + d]; }
    const int d0 = (tid & 7) * 8, v0 = (tid & 7) * 16;
    in.k = tv ? *(const u32x4*)(kbuf + (size_t)(row0 + t) * 256 + hh * 64 + d0) : z4;
    in.v0 = tv ? *(const u32x4*)(vbuf + (size_t)(row0 + t) * 512 + hh * 128 + v0) : z4;
    in.v1 = tv ? *(const u32x4*)(vbuf + (size_t)(row0 + t) * 512 + hh * 128 + v0 + 8) : z4;
    if (G3) {
        in3.q = tv ? *(const u32x4*)(qbuf + (size_t)(row0 + t) * 256 + hh * 64 + d0) : z4;
        const int vr = tid >> 2, dq = (tid & 3) * 16;
        const bf16_t* s0 = gs + ((size_t)(bh * 2 + 0) * GCH + n) * 8192 + vr * 64 + dq; const bf16_t* s1 = gs + ((size_t)(bh * 2 + 1) * GCH + n) * 8192 + vr * 64 + dq;
        in3.h0 = *(const u32x4*)s0; in3.h1 = *(const u32x4*)(s0 + 8); in3.h2 = *(const u32x4*)s1; in3.h3 = *(const u32x4*)(s1 + 8);
    }
}
__device__ __forceinline__ void gla_prep(LAS unsigned char* lds, const GlaIn& in, int tid, int ntok) {
    LAS float* BF = (LAS float*)(lds + GL_BF); LAS float* BBk = (LAS float*)(lds + GL_BB);
    LAS float* Z = (LAS float*)(lds + GL_X); LAS float* W2 = Z + 2048; LAS float* BI = W2 + 2048; LAS float* TOT = BI + 128;
    *(LAS f32x4*)(Z + (tid >> 3) * 32 + (tid & 7) * 4) = in.z;
    W2[tid] = in.w20; W2[tid + NTHR] = in.w21; W2[tid + 2 * NTHR] = in.w22; W2[tid + 3 * NTHR] = in.w23;
    if (tid < 128) BI[tid] = in.bi;
    lds_barrier();
    const int dir = tid >> 8, tb = (tid >> 6) & 3, d = tid & 63;
    LAS float* BX = dir ? BBk : BF;
    {
        float w[16];
#pragma unroll
        for (int r = 0; r < 16; ++r) w[r] = W2[(dir * 16 + r) * 64 + d];
        const float bias = BI[dir * 64 + d];
        float pre = 0.f;
#pragma unroll
        for (int j = 0; j < 16; ++j) {
            const int t = dir ? 16 * tb + 15 - j : 16 * tb + j;
            float x = bias;
#pragma unroll
            for (int r4 = 0; r4 < 4; ++r4) { const f32x4 zv = *(const LAS f32x4*)(Z + t * 32 + dir * 16 + r4 * 4); x += zv[0] * w[r4 * 4] + zv[1] * w[r4 * 4 + 1] + zv[2] * w[r4 * 4 + 2] + zv[3] * w[r4 * 4 + 3]; }
            const float gg = t < ntok ? logsig(x) * (1.f / 16.f) : 0.f;
            pre += gg; BX[t * 64 + d] = pre;
        }
        TOT[(dir * 4 + tb) * 64 + d] = pre;
    }
    lds_barrier();
    {
        float off = 0.f;
#pragma unroll
        for (int t2 = 0; t2 < 4; ++t2) { const float tv = TOT[(dir * 4 + t2) * 64 + d]; if (dir ? (t2 > tb) : (t2 < tb)) off += tv; }
#pragma unroll
        for (int j = 0; j < 16; ++j) BX[(16 * tb + j) * 64 + d] += off;
    }
    lds_barrier();
}

__device__ __forceinline__ void gla_g1(LAS unsigned char* lds, const Params& p, int l, const bf16_t* kbuf, const bf16_t* vbuf, const float* zbuf, bf16_t* gs, float* dec, int G, int c) {
    const int tid = opaque_tid(), wid = tid >> 6, lane = tid & 63, fr = lane & 15, fq = lane >> 4;
    LAS float* BF = (LAS float*)(lds + GL_BF); LAS float* BBk = (LAS float*)(lds + GL_BB);
    LAS bf16_t* KF = (LAS bf16_t*)(lds + GL_X); LAS bf16_t* KB = KF + 64 * 72; LAS bf16_t* VT = KB + 64 * 72;
    GlaIn cur{}; GlaIn3 dum{};
    if (c < 8 * GCH) gla_load<false>(p, l, c, tid, zbuf, nullptr, kbuf, vbuf, nullptr, cur, dum);
    for (int task = c; task < 8 * GCH; task += G) {
        int bh, hh, n, row0, ntok; gla_task(task, bh, hh, n, row0, ntok);
        GlaIn nxt{};
        if (task + G < 8 * GCH) gla_load<false>(p, l, task + G, tid, zbuf, nullptr, kbuf, vbuf, nullptr, nxt, dum);
        gla_prep(lds, cur, tid, ntok);
        {
            const int t = tid >> 3, d0 = (tid & 7) * 8;
            const unsigned kw[4] = {cur.k.x, cur.k.y, cur.k.z, cur.k.w};
#pragma unroll
            for (int i = 0; i < 8; ++i) {
                const int d = d0 + i; const float kk = (i & 1) ? hi16(kw[i >> 1]) : lo16(kw[i >> 1]);
                const int tc = t ^ (((d >> 3) & 7) << 3);
                KF[d * 72 + tc] = f2bf(kk * __expf(BF[63 * 64 + d] - BF[t * 64 + d]));
                KB[d * 72 + tc] = f2bf(kk * __expf(BBk[0 * 64 + d] - BBk[t * 64 + d]));
            }
            const int v0 = (tid & 7) * 16;
#pragma unroll
            for (int hv = 0; hv < 2; ++hv) {
                const u32x4 vv = hv ? cur.v1 : cur.v0;
                const unsigned vw[4] = {vv.x, vv.y, vv.z, vv.w};
#pragma unroll
                for (int i = 0; i < 8; ++i) { const int vr_ = v0 + hv * 8 + i; VT[vr_ * 72 + (t ^ (((vr_ >> 4) & 7) << 3))] = (bf16_t)((i & 1) ? (vw[i >> 1] >> 16) : (vw[i >> 1] & 0xffffu)); }
            }
        }
        if (tid < 128) { const int dir = tid >> 6, d = tid & 63; dec[((size_t)(bh * 2 + dir) * GCH + n) * 64 + d] = __expf(dir ? BBk[d] : BF[63 * 64 + d]); }
        lds_barrier();
        {
            const int dir = wid >> 2, dt = wid & 3; LAS bf16_t* KS = dir ? KB : KF;
            const int sa = (dt * 2 + (fr >> 3)) & 7;
            const bf16x8 a0 = *(const LAS bf16x8*)(KS + (dt * 16 + fr) * 72 + ((fq ^ sa) << 3)), a1 = *(const LAS bf16x8*)(KS + (dt * 16 + fr) * 72 + (((4 + fq) ^ sa) << 3));
            bf16_t* dst = gs + ((size_t)(bh * 2 + dir) * GCH + n) * 8192;
#pragma unroll
            for (int vt = 0; vt < 8; ++vt) {
                const bf16x8 b0 = *(const LAS bf16x8*)(VT + (vt * 16 + fr) * 72 + ((fq ^ vt) << 3)), b1 = *(const LAS bf16x8*)(VT + (vt * 16 + fr) * 72 + (((4 + fq) ^ vt) << 3));
                f32x4 a = (f32x4){0.f, 0.f, 0.f, 0.f};
                a = __builtin_amdgcn_mfma_f32_16x16x32_bf16(a0, b0, a, 0, 0, 0);
                a = __builtin_amdgcn_mfma_f32_16x16x32_bf16(a1, b1, a, 0, 0, 0);
                u32x2 w; w.x = pk2(a[0], a[1]); w.y = pk2(a[2], a[3]);
                *(u32x2*)(dst + (size_t)(vt * 16 + fr) * 64 + dt * 16 + fq * 4) = w;
            }
        }
        lds_barrier();
        cur = nxt;
    }
    __syncthreads();
}

__device__ __forceinline__ void gla_g2(LAS unsigned char* lds, bf16_t* gs, const float* dec, int G, int c) {
    constexpr int CB = 56;
    const int tid = opaque_tid();
    LAS float* DL = (LAS float*)lds;
    LAS bf16_t* SL = (LAS bf16_t*)(lds + 66048);
    static_assert(66048 + CB * 1024 <= LDS_BYTES, "G2 LDS");
    for (int g0 = c * NTHR; g0 < 16 * 8192; g0 += G * NTHR) {
        const int seq = g0 >> 13, e0 = g0 & 8191, d = (e0 + tid) & 63, dir = seq & 1;
        __syncthreads();
        {
            f32x4 dv[9]; const float* dsrc = dec + (size_t)seq * GCH * 64;
#pragma unroll
            for (int k = 0; k < 9; ++k) { const int idx = tid + k * NTHR; dv[k] = idx < GCH * 16 ? *(const f32x4*)(dsrc + idx * 4) : (f32x4){0.f, 0.f, 0.f, 0.f}; }
#pragma unroll
            for (int k = 0; k < 9; ++k) { const int idx = tid + k * NTHR; if (idx < GCH * 16) *(LAS f32x4*)(DL + idx * 4) = dv[k]; }
        }
        bf16_t* base = gs + (size_t)seq * GCH * 8192 + e0;
        float st = 0.f;
        for (int n0 = 0; n0 < GCH; n0 += CB) {
            const int nb = (GCH - n0) < CB ? (GCH - n0) : CB;
            __syncthreads();
            {
                u32x4 sv[7];
#pragma unroll
                for (int k = 0; k < 7; ++k) { const int i = tid + k * NTHR; const int r = i >> 6, pc = i & 63; const int n = n0 + r; const int nn = dir ? GCH - 1 - n : n;
                    sv[k] = i < nb * 64 ? *(const u32x4*)(base + (size_t)nn * 8192 + pc * 8) : (u32x4){0u, 0u, 0u, 0u}; }
#pragma unroll
                for (int k = 0; k < 7; ++k) { const int i = tid + k * NTHR; const int r = i >> 6, pc = i & 63; if (i < nb * 64) *(LAS u32x4*)(SL + r * 512 + pc * 8) = sv[k]; }
            }
            __syncthreads();
            for (int r = 0; r < nb; ++r) { const int n = n0 + r; const int nn = dir ? GCH - 1 - n : n;
                const float sv = bf2f(SL[r * 512 + tid]); SL[r * 512 + tid] = f2bf(st); st = DL[nn * 64 + d] * st + sv; }
            __syncthreads();
            for (int i = tid; i < nb * 64; i += NTHR) { const int r = i >> 6, pc = i & 63; const int n = n0 + r; const int nn = dir ? GCH - 1 - n : n;
                *(u32x4*)(base + (size_t)nn * 8192 + pc * 8) = *(const LAS u32x4*)(SL + r * 512 + pc * 8); }
        }
    }
    __syncthreads();
}

constexpr int GL_A1 = GL_X + 18432, GL_B1 = GL_A1 + 25600, GL_RS = GL_B1 + 51200;
static_assert(GL_RS + 512 <= LDS_BYTES, "G3 LDS");
__device__ __forceinline__ void gla_g3(LAS unsigned char* lds, const Params& p, int l, const bf16_t* qbuf, const bf16_t* kbuf, const bf16_t* vbuf, const bf16_t* rbuf, const float* zbuf,
                       const bf16_t* gs, bf16_t* obuf, int G, int c) {
    const int tid = opaque_tid(), wid = tid >> 6, lane = tid & 63, fr = lane & 15, fq = lane >> 4;
    LAS float* BF = (LAS float*)(lds + GL_BF); LAS float* BBk = (LAS float*)(lds + GL_BB);
    LAS bf16_t* KDF = (LAS bf16_t*)(lds + GL_X); LAS bf16_t* KDB = KDF + 64 * 72;
    LAS bf16_t* A1 = (LAS bf16_t*)(lds + GL_A1); LAS bf16_t* B1 = (LAS bf16_t*)(lds + GL_B1); LAS float* RS = (LAS float*)(lds + GL_RS);
    const float* gnorm = p.in[24] + (size_t)l * 512;
    GlaIn cur{}; GlaIn3 cur3{};
    if (c < 8 * GCH) gla_load<true>(p, l, c, tid, zbuf, qbuf, kbuf, vbuf, gs, cur, cur3);
    for (int task = c; task < 8 * GCH; task += G) {
        int bh, hh, n, row0, ntok; gla_task(task, bh, hh, n, row0, ntok);
        GlaIn nxt{}; GlaIn3 nxt3{};
        if (task + G < 8 * GCH) gla_load<true>(p, l, task + G, tid, zbuf, qbuf, kbuf, vbuf, gs, nxt, nxt3);
        gla_prep(lds, cur, tid, ntok);
        {
            const int t = tid >> 3, d0 = (tid & 7) * 8;
            const unsigned qw[4] = {cur3.q.x, cur3.q.y, cur3.q.z, cur3.q.w}, kw[4] = {cur.k.x, cur.k.y, cur.k.z, cur.k.w};
            unsigned oqf[4], oqb[4], okf[4], okb[4];
#pragma unroll
            for (int i = 0; i < 4; ++i) {
                const int d = d0 + 2 * i; const float bf0 = BF[t * 64 + d], bf1 = BF[t * 64 + d + 1], bb0 = BBk[t * 64 + d], bb1 = BBk[t * 64 + d + 1];
                const float q0 = lo16(qw[i]), q1 = hi16(qw[i]), k0 = lo16(kw[i]), k1 = hi16(kw[i]);
                oqf[i] = pk2(q0 * __expf(bf0), q1 * __expf(bf1)); oqb[i] = pk2(q0 * __expf(bb0), q1 * __expf(bb1));
                okf[i] = pk2(k0 * __expf(-bf0), k1 * __expf(-bf1)); okb[i] = pk2(k0 * __expf(-bb0), k1 * __expf(-bb1));
            }
            *(LAS u32x4*)(A1 + t * 200 + 64 + d0) = (u32x4){oqf[0], oqf[1], oqf[2], oqf[3]};
            *(LAS u32x4*)(A1 + t * 200 + 128 + d0) = (u32x4){oqb[0], oqb[1], oqb[2], oqb[3]};
            *(LAS u32x4*)(KDF + t * 72 + d0) = (u32x4){okf[0], okf[1], okf[2], okf[3]};
            *(LAS u32x4*)(KDB + t * 72 + d0) = (u32x4){okb[0], okb[1], okb[2], okb[3]};
            const int v0 = (tid & 7) * 16;
#pragma unroll
            for (int hv = 0; hv < 2; ++hv) {
                const u32x4 vv = hv ? cur.v1 : cur.v0;
                const unsigned vw[4] = {vv.x, vv.y, vv.z, vv.w};
#pragma unroll
                for (int i = 0; i < 8; ++i) { const int vr_ = v0 + hv * 8 + i; B1[vr_ * 200 + (t ^ (((vr_ >> 4) & 7) << 3))] = (bf16_t)((i & 1) ? (vw[i >> 1] >> 16) : (vw[i >> 1] & 0xffffu)); }
            }
            const int vr = tid >> 2, dq = (tid & 3) * 16;
#pragma unroll
            for (int dir = 0; dir < 2; ++dir) {
#ifdef DBG_NO_INTER
                const u32x4 h0 = (u32x4){0u,0u,0u,0u}, h1 = h0;
#else
                const u32x4 h0 = dir ? cur3.h2 : cur3.h0, h1 = dir ? cur3.h3 : cur3.h1;
#endif
                *(LAS u32x4*)(B1 + vr * 200 + 64 + dir * 64 + dq) = h0; *(LAS u32x4*)(B1 + vr * 200 + 64 + dir * 64 + dq + 8) = h1;
            }
        }
        lds_barrier();
        {
            const int ti = wid >> 1;
            const bf16x8 qf0 = *(const LAS bf16x8*)(A1 + (ti * 16 + fr) * 200 + 64 + fq * 8), qf1 = *(const LAS bf16x8*)(A1 + (ti * 16 + fr) * 200 + 96 + fq * 8);
            const bf16x8 qb0 = *(const LAS bf16x8*)(A1 + (ti * 16 + fr) * 200 + 128 + fq * 8), qb1 = *(const LAS bf16x8*)(A1 + (ti * 16 + fr) * 200 + 160 + fq * 8);
#pragma unroll
            for (int tj2 = 0; tj2 < 2; ++tj2) {
                const int tj = (wid & 1) * 2 + tj2;
                const bf16x8 kf0 = *(const LAS bf16x8*)(KDF + (tj * 16 + fr) * 72 + fq * 8), kf1 = *(const LAS bf16x8*)(KDF + (tj * 16 + fr) * 72 + 32 + fq * 8);
                const bf16x8 kb0 = *(const LAS bf16x8*)(KDB + (tj * 16 + fr) * 72 + fq * 8), kb1 = *(const LAS bf16x8*)(KDB + (tj * 16 + fr) * 72 + 32 + fq * 8);
                f32x4 sf = (f32x4){0.f, 0.f, 0.f, 0.f}, sb = sf;
                sf = __builtin_amdgcn_mfma_f32_16x16x32_bf16(kf0, qf0, sf, 0, 0, 0); sf = __builtin_amdgcn_mfma_f32_16x16x32_bf16(kf1, qf1, sf, 0, 0, 0);
                sb = __builtin_amdgcn_mfma_f32_16x16x32_bf16(kb0, qb0, sb, 0, 0, 0); sb = __builtin_amdgcn_mfma_f32_16x16x32_bf16(kb1, qb1, sb, 0, 0, 0);
                const int i = ti * 16 + fr, j0 = tj * 16 + fq * 4; float pv[4];
#pragma unroll
                for (int jj = 0; jj < 4; ++jj) pv[jj] = (j0 + jj <= i) ? sf[jj] : sb[jj];
                *(LAS u32x2*)(A1 + i * 200 + j0) = (u32x2){pk2(pv[0], pv[1]), pk2(pv[2], pv[3])};
            }
        }
        lds_barrier();
        {
            const int it = wid & 3, vh = wid >> 2;
            bf16x8 bfr[6];
#pragma unroll
            for (int ks = 0; ks < 6; ++ks) bfr[ks] = *(const LAS bf16x8*)(A1 + (it * 16 + fr) * 200 + ks * 32 + fq * 8);
            f32x4 o[4]; float ss = 0.f;
#pragma unroll
            for (int vt = 0; vt < 4; ++vt) {
                f32x4 a = (f32x4){0.f, 0.f, 0.f, 0.f};
#pragma unroll
                for (int ks = 0; ks < 6; ++ks) { const int cb = ks < 2 ? (((ks * 4 + fq) ^ ((vh * 4 + vt) & 7)) << 3) : ks * 32 + fq * 8;
                    const bf16x8 af = *(const LAS bf16x8*)(B1 + (vh * 64 + vt * 16 + fr) * 200 + cb); a = __builtin_amdgcn_mfma_f32_16x16x32_bf16(af, bfr[ks], a, 0, 0, 0); }
                o[vt] = a; ss += (a[0] * a[0] + a[1] * a[1]) + (a[2] * a[2] + a[3] * a[3]);
            }
            ss += __shfl_xor(ss, 16); ss += __shfl_xor(ss, 32);
            if (fq == 0) RS[vh * 64 + it * 16 + fr] = ss;
            lds_barrier();
            const int i = it * 16 + fr; const float tot = RS[i] + RS[64 + i]; const float rn = rsqrtf(tot * (1.f / 128.f) + 1e-6f);
            if (i < ntok) {
                const int row = row0 + i;
#pragma unroll
                for (int vt = 0; vt < 4; ++vt) {
                    const int vcol = hh * 128 + vh * 64 + vt * 16 + fq * 4;
                    const f32x4 gn = *(const f32x4*)(gnorm + vcol); const u32x2 rv = *(const u32x2*)(rbuf + (size_t)row * 512 + vcol);
                    const float r0 = lo16(rv.x), r1 = hi16(rv.x), r2 = lo16(rv.y), r3 = hi16(rv.y);
                    u32x2 w; w.x = pk2(o[vt][0] * rn * gn[0] * siluf_(r0), o[vt][1] * rn * gn[1] * siluf_(r1)); w.y = pk2(o[vt][2] * rn * gn[2] * siluf_(r2), o[vt][3] * rn * gn[3] * siluf_(r3));
                    *(u32x2*)(obuf + (size_t)row * 512 + vcol) = w;
                }
            }
        }
        lds_barrier();
        cur = nxt; cur3 = nxt3;
    }
    __syncthreads();
}

__device__ __forceinline__ void s5_scan(LAS unsigned char* lds, const float* S, bf16_t* ubuf, const float* lamtab, int G, int c) {
    const int tid = opaque_tid(); const int pl = tid & 31, sg = tid >> 5;
    LAS f32x2* E = (LAS f32x2*)lds; LAS f32x2* PW = E + 512;
    for (int task = c; task < 256; task += G) {
        const int combo = task >> 1, pp = (task & 1) * 32 + pl;
        const int dir = combo & 1, g = (combo >> 1) & 31, b = combo >> 6;
        const f32x2 lam = *(const f32x2*)(lamtab + ((size_t)(g * 2 + dir) * 64 + pp) * 2);
        const float* sb = S + ((size_t)g * MCH + b * NCH) * 256 + dir * 128 + pp;
        bf16_t* hb = ubuf + ((size_t)g * MCH + b * NCH) * 512 + 256 + dir * 128 + pp;
        const int c_lo = sg * 64, c_hi = sg == 15 ? NCH : c_lo + 64;
        float lr = 0.f, li = 0.f, pr = 1.f, pi = 0.f;
        for (int c0 = c_lo; c0 < c_hi; c0 += 16) {
            float sr[16], si[16];
#pragma unroll
            for (int i = 0; i < 16; ++i) { const int cc = c0 + i; const int ch = dir ? NCH - 1 - cc : cc; if (cc < c_hi) { sr[i] = sb[(size_t)ch * 256]; si[i] = sb[(size_t)ch * 256 + 64]; } else { sr[i] = 0.f; si[i] = 0.f; } }
#pragma unroll
            for (int i = 0; i < 16; ++i) { const int cc = c0 + i;
                if (cc < c_hi) { const float nr = lam.x * lr - lam.y * li + sr[i], ni = lam.x * li + lam.y * lr + si[i]; lr = nr; li = ni;
                                 const float tr = lam.x * pr - lam.y * pi; pi = lam.x * pi + lam.y * pr; pr = tr; } }
        }
        E[sg * 32 + pl] = (f32x2){lr, li}; PW[sg * 32 + pl] = (f32x2){pr, pi};
        __syncthreads();
        float hr = 0.f, hi = 0.f;
        for (int s2 = 0; s2 < sg; ++s2) { const f32x2 e = E[s2 * 32 + pl], w = PW[s2 * 32 + pl]; const float nr = w.x * hr - w.y * hi + e.x, ni = w.x * hi + w.y * hr + e.y; hr = nr; hi = ni; }
        for (int c0 = c_lo; c0 < c_hi; c0 += 16) {
            float sr[16], si[16];
#pragma unroll
            for (int i = 0; i < 16; ++i) { const int cc = c0 + i; const int ch = dir ? NCH - 1 - cc : cc; if (cc < c_hi) { sr[i] = sb[(size_t)ch * 256]; si[i] = sb[(size_t)ch * 256 + 64]; } else { sr[i] = 0.f; si[i] = 0.f; } }
#pragma unroll
            for (int i = 0; i < 16; ++i) { const int cc = c0 + i; const int ch = dir ? NCH - 1 - cc : cc;
                if (cc < c_hi) { hb[(size_t)ch * 512] = f2bf(hr); hb[(size_t)ch * 512 + 64] = f2bf(hi); const float nr = lam.x * hr - lam.y * hi + sr[i], ni = lam.x * hi + lam.y * hr + si[i]; hr = nr; hi = ni; } }
        }
        __syncthreads();
    }
}

enum { GK_UP1 = 0, GK_DN1, GK_PROJ, GK_S5S, GK_S5Y, GK_GLU, GK_WO, GK_GATE, GK_OUTP, GK_UP2, GK_DN2 };
__device__ __forceinline__ pg8::Gemm make_gemm(int kind, unsigned char* ws, int l) {
    bf16_t* W = (bf16_t*)(ws + OFF_W + (size_t)l * W_BYTES); const bf16_t* hb = (const bf16_t*)(ws + OFF_HB); const bf16_t* hid = (const bf16_t*)(ws + OFF_HID); const bf16_t* ubuf = (const bf16_t*)(ws + OFF_UBUF);
    switch (kind) {
    case GK_UP1:  return pg8::Gemm{hb, W + W_UP1, 1024, 1024, 128, 22, 1, 0, 0, 1, 0, 0};
    case GK_DN1:  return pg8::Gemm{hid, W + W_DN1, DFF, DFF, 128, 4, 1, 0, 0, 1, 1, 1};
    case GK_PROJ: return pg8::Gemm{hb, W + W_INP, 1024, 1024, 128, 9, 1, 0, 0, 1, 0, 0};
    case GK_S5S:  return pg8::Gemm{ubuf, W + W_S1, 512, 256, 9, 1, 32, (size_t)MCH * 512, (size_t)256 * 256, 0, 0, 0};
    case GK_S5Y:  return pg8::Gemm{ubuf, W + W_S2, 512, 512, 9, 1, 32, (size_t)MCH * 512, (size_t)256 * 512, 0, 0, 0};
    case GK_GLU:  return pg8::Gemm{(const bf16_t*)(ws + OFF_Y), W + W_GLU, 512, 512, 128, 8, 1, 0, 0, 1, 0, 0};
    case GK_WO:   return pg8::Gemm{(const bf16_t*)(ws + OFF_O), W + W_O, 512, 512, 128, 4, 1, 0, 0, 1, 0, 0};
    case GK_GATE: return pg8::Gemm{hb, W + W_ING, 1024, 1024, 128, 8, 1, 0, 0, 1, 0, 0};
    case GK_OUTP: return pg8::Gemm{(const bf16_t*)(ws + OFF_SB), W + W_OUT, 1024, 1024, 128, 4, 1, 0, 0, 1, 0, 0};
    case GK_UP2:  return pg8::Gemm{hb, W + W_UP2, 1024, 1024, 128, 22, 1, 0, 0, 1, 0, 0};
    default:      return pg8::Gemm{hid, W + W_DN2, DFF, DFF, 128, 4, 1, 0, 0, 1, 1, 1};
    }
}
struct EpiSwitch {
    int kind; unsigned char* ws; float* out;
    __device__ __forceinline__ void operator()(const Acc& acc, const Unit& u, int wr, int wc, int fr, int fq) const {
        float* rowpart = (float*)(ws + OFF_ROWPART); bf16_t* hb = (bf16_t*)(ws + OFF_HB); float* metah = (float*)(ws + OFF_METAH);
#ifdef DBG_DUP_ALLGEMM
        if (kind >= 100) { if (u.pg == 0 && u.pn < 4) { EpiBf E{(bf16_t*)(ws + OFF_DUMMY), T}; E(acc, u, wr, wc, fr, fq); } return; }
#endif
        switch (kind) {
        case GK_UP1: case GK_UP2: { EpiUp E{rowpart, (bf16_t*)(ws + OFF_HID), T}; E(acc, u, wr, wc, fr, fq); } break;
        case GK_DN1: case GK_DN2: case GK_OUTP: { EpiRes E{out, metah, hb, rowpart, kind == GK_OUTP ? 1.0f : 0.5f, T}; E(acc, u, wr, wc, fr, fq); } break;
        case GK_PROJ: { EpiProj E{rowpart, (bf16_t*)(ws + OFF_UBUF), (bf16_t*)(ws + OFF_Q), (bf16_t*)(ws + OFF_K), (bf16_t*)(ws + OFF_V), (bf16_t*)(ws + OFF_R), (float*)(ws + OFF_Z), T}; E(acc, u, wr, wc, fr, fq); } break;
        case GK_S5S: { EpiS5S E{(float*)(ws + OFF_S5S)}; E(acc, u, wr, wc, fr, fq); } break;
        case GK_S5Y: { EpiS5Y E{(bf16_t*)(ws + OFF_Y)}; E(acc, u, wr, wc, fr, fq); } break;
        case GK_GLU: { EpiGlu E{(bf16_t*)(ws + OFF_SB), T}; E(acc, u, wr, wc, fr, fq); } break;
        case GK_WO: { EpiBf E{(bf16_t*)(ws + OFF_GB), T}; E(acc, u, wr, wc, fr, fq); } break;
        default: { EpiGate E{rowpart, (bf16_t*)(ws + OFF_SB), (const bf16_t*)(ws + OFF_GB), T}; E(acc, u, wr, wc, fr, fq); } break;
        }
    }
};

struct BarCtx { unsigned* bar; unsigned epoch, xcc, nx, nxcd; };
__device__ __forceinline__ void grid_barrier(BarCtx& b) {
    asm volatile("s_waitcnt vmcnt(0) lgkmcnt(0)" ::: "memory");
    __syncthreads();
    b.epoch += 1u;
    if (threadIdx.x < 64) {
        unsigned old = 0u;
        if (threadIdx.x == 0) old = __hip_atomic_fetch_add(b.bar + 64 + 16 * b.xcc, 1u, __ATOMIC_RELAXED, __HIP_MEMORY_SCOPE_AGENT);
        old = (unsigned)__builtin_amdgcn_readfirstlane((int)old);
        if (old + 1u == b.epoch * b.nx) {
            __builtin_amdgcn_fence(__ATOMIC_RELEASE, "agent");
            asm volatile("s_waitcnt vmcnt(0)" ::: "memory");
            if (threadIdx.x == 0) __hip_atomic_fetch_add(b.bar, 1u, __ATOMIC_RELAXED, __HIP_MEMORY_SCOPE_AGENT);
        }
        const unsigned target = b.epoch * b.nxcd;
        while ((unsigned)__builtin_amdgcn_readfirstlane((int)__hip_atomic_load(b.bar, __ATOMIC_RELAXED, __HIP_MEMORY_SCOPE_AGENT)) < target) __builtin_amdgcn_s_sleep(1);
        __builtin_amdgcn_fence(__ATOMIC_ACQUIRE, "agent");
        asm volatile("s_waitcnt vmcnt(0)" ::: "memory");
    }
    __syncthreads();
}

__global__ void __launch_bounds__(NTHR, 2) fwd_mega(Params p) {
    extern __shared__ __attribute__((aligned(16))) unsigned char lds_raw[];
    LAS unsigned char* lds = (LAS unsigned char*)lds_raw;
    cg::grid_group grid = cg::this_grid();
    const int G = gridDim.x, c = blockIdx.x;
    unsigned char* ws = p.ws;
    float* out = p.out;
    BarCtx bctx; bctx.bar = (unsigned*)(ws + OFF_BAR); bctx.epoch = 0u;
    bctx.xcc = (unsigned)__builtin_amdgcn_s_getreg((3 << 11) | 20) & 0xFu;
    if (threadIdx.x == 0) __hip_atomic_fetch_add(bctx.bar + 512 + bctx.xcc, 1u, __ATOMIC_RELAXED, __HIP_MEMORY_SCOPE_AGENT);
    grid.sync();
    {
        unsigned nx = 0u, nxcd = 0u;
        for (int x = 0; x < 16; ++x) { const unsigned v = (unsigned)__builtin_amdgcn_readfirstlane((int)__hip_atomic_load(bctx.bar + 512 + x, __ATOMIC_RELAXED, __HIP_MEMORY_SCOPE_AGENT)); if (v) ++nxcd; if ((unsigned)x == bctx.xcc) nx = v; }
        bctx.nx = nx; bctx.nxcd = nxcd;
    }
#if defined(DBG_AMP_P0) || defined(DBG_AMP_FINAL)
    unsigned long long amp_k0 = __builtin_amdgcn_s_memrealtime();
#endif

    {
        const int tid_ = opaque_tid(); const int wid = tid_ >> 6, lane = tid_ & 63;
        bf16_t* hb = (bf16_t*)(ws + OFF_HB); float* rowpart = (float*)(ws + OFF_ROWPART);
        for (int row = c * 8 + wid; row < T; row += G * 8) {
            const float* src = row < TR ? p.in[0] + (size_t)row * DM : p.in[1] + (size_t)((row - TR) & 15) * DM;
            float ss = 0.f;
#pragma unroll
            for (int i = 0; i < 4; ++i) {
                const int col = (i * 64 + lane) * 4; const f32x4 v = *(const f32x4*)(src + col);
                u32x2 w; w.x = pk2(v[0], v[1]); w.y = pk2(v[2], v[3]); *(u32x2*)(hb + (size_t)row * DM + col) = w;
                ss += (v[0] * v[0] + v[1] * v[1]) + (v[2] * v[2] + v[3] * v[3]);
            }
#pragma unroll
            for (int o = 32; o >= 1; o >>= 1) ss += __shfl_xor(ss, o);
            if (lane < 16) rowpart[(size_t)row * 16 + lane] = lane == 0 ? ss : 0.f;
        }
    }

#ifdef DBG_AMP_P0
    if (c == 0) { const unsigned long long t1 = __builtin_amdgcn_s_memrealtime(); const unsigned long long dt = t1 - amp_k0; while (__builtin_amdgcn_s_memrealtime() - t1 < 4ull * dt) __builtin_amdgcn_s_sleep(8); __syncthreads(); }
#endif
    for (int step = 0; step < 24; ++step) {
        const int l = step / 12, s = step % 12;
#ifdef DBG_AMP_STEP
        const unsigned long long amp_t0 = __builtin_amdgcn_s_memrealtime();
#endif
        if (s == 0) {
            if (l == 1) continue;
            PH(0) {
                bf16_t* W = (bf16_t*)(ws + OFF_W);
                if (G > 64) {
                    if (c < 64) { const int g = c >> 1; s5_gen(lds, p, 0, g, W + W_S1 + (size_t)g * 256 * 256, W + W_S2 + (size_t)g * 256 * 512, (float*)(ws + OFF_LAM), c & 1); }
                    else { int rot = 0; for (int job = 0; job < 9; ++job) { const CvtJob j = make_job(p, 0, job); convert_wt(lds, j, G - 64, c - 64, rot); } }
                } else {
                    int rot = 0;
                    for (int job = 0; job < 9; ++job) { const CvtJob j = make_job(p, 0, job); convert_wt(lds, j, G, c, rot); }
                    for (int g = c; g < 32; g += G) s5_gen(lds, p, 0, g, W + W_S1 + (size_t)g * 256 * 256, W + W_S2 + (size_t)g * 256 * 512, (float*)(ws + OFF_LAM), 2);
                }
            }
        }
        int k0 = -1, k1 = -1;
#ifdef DBG_SKIP_LO
        if (s >= DBG_SKIP_LO && s <= DBG_SKIP_HI) { grid_barrier(bctx); continue; }
#endif
        switch (s) {
        case 1: k0 = GK_UP1; break;
        case 2: k0 = GK_DN1; break;
        case 3: k0 = GK_PROJ; break;
        case 4: k0 = GK_S5S; break;
        case 6: k0 = GK_S5Y; break;
        case 7: k0 = GK_GLU; k1 = GK_WO; break;
        case 8: k0 = GK_GATE; break;
        case 9: k0 = GK_OUTP; break;
        case 10: k0 = GK_UP2; break;
        case 11: k0 = GK_DN2; break;
        default: break;
        }
#ifdef DBG_NO_GLA
        if (k1 == GK_WO) k1 = -1;
#endif
#ifdef DBG_NO_S5
        if (k0 == GK_S5S || k0 == GK_S5Y) k0 = -1;
        if (k0 == GK_GLU) { k0 = k1; k1 = -1; }
#endif
#ifdef DBG_DUP_UP
        if (s == 1 || s == 10) k1 = k0;
#endif
#ifdef DBG_DUP_ALLGEMM
        PH(1) { if (k0 >= 0) { const pg8::Gemm g = make_gemm(k0, ws, l); const EpiSwitch E{k0 + 100, ws, out}; pg8::gemm_phase(lds, g, E, G, c); }
                if (k1 >= 0) { const pg8::Gemm g = make_gemm(k1, ws, l); const EpiSwitch E{k1 + 100, ws, out}; pg8::gemm_phase(lds, g, E, G, c); } }
#endif
        PH(1) {
            for (int sub = 0; sub < 2; ++sub) {
                const int kk = sub ? k1 : k0;
                if (kk >= 0) { const pg8::Gemm g = make_gemm(kk % 100, ws, l); const EpiSwitch E{kk, ws, out}; pg8::gemm_phase(lds, g, E, G, sub ? (c + 8) % G : c); }
            }
        }
#ifdef DBG_DUP_GLA
        if (s == 4) { gla_g1(lds, p, l, (const bf16_t*)(ws + OFF_K), (const bf16_t*)(ws + OFF_V), (const float*)(ws + OFF_Z), (bf16_t*)(ws + OFF_GS), (float*)(ws + OFF_DEC), G, (c + 32) % G); }
        if (s == 6) { gla_g3(lds, p, l, (const bf16_t*)(ws + OFF_Q), (const bf16_t*)(ws + OFF_K), (const bf16_t*)(ws + OFF_V), (const bf16_t*)(ws + OFF_R), (const float*)(ws + OFF_Z),
                             (const bf16_t*)(ws + OFF_GS), (bf16_t*)(ws + OFF_O), G, (c + 32) % G); }
#endif
#ifdef DBG_DUP_MISC
        if (s == 0) { int rot = 0; for (int job = 0; job < 9; ++job) { const CvtJob j = make_job(p, l, job); convert_wt(lds, j, G, c, rot); } }
        if (s == 5) { s5_scan(lds, (const float*)(ws + OFF_S5S), (bf16_t*)(ws + OFF_UBUF), (const float*)(ws + OFF_LAM), G, c); }
        grid_barrier(bctx);
#endif
        if (s == 3 && l == 0 && G >= 256 && c >= 128) {
            __syncthreads();
            int rot = 0; for (int job = 0; job < 9; ++job) { const CvtJob j = make_job(p, 1, job); convert_wt(lds, j, 128, c - 128, rot); }
        }
        if (s == 4) { PH(5) gla_g1(lds, p, l, (const bf16_t*)(ws + OFF_K), (const bf16_t*)(ws + OFF_V), (const float*)(ws + OFF_Z), (bf16_t*)(ws + OFF_GS), (float*)(ws + OFF_DEC), G, (c + 32) % G); }
        if (s == 5) {
            PH(6) s5_scan(lds, (const float*)(ws + OFF_S5S), (bf16_t*)(ws + OFF_UBUF), (const float*)(ws + OFF_LAM + (size_t)l * LAM_BYTES), G, c);
            PH(7) gla_g2(lds, (bf16_t*)(ws + OFF_GS), (const float*)(ws + OFF_DEC), G, c);
            if (l == 0) {
                bf16_t* W1 = (bf16_t*)(ws + OFF_W + W_BYTES); float* lam1 = (float*)(ws + OFF_LAM + LAM_BYTES);
                __syncthreads();
                if (G >= 256) {
                    if (c >= 128 && c < 192) { const int g = (c - 128) >> 1; s5_gen(lds, p, 1, g, W1 + W_S1 + (size_t)g * 256 * 256, W1 + W_S2 + (size_t)g * 256 * 512, lam1, c & 1); }
                } else {
                    int rot = 0;
                    for (int job = 0; job < 9; ++job) { const CvtJob j = make_job(p, 1, job); convert_wt(lds, j, G, c, rot); }
                    for (int g = c; g < 32; g += G) s5_gen(lds, p, 1, g, W1 + W_S1 + (size_t)g * 256 * 256, W1 + W_S2 + (size_t)g * 256 * 512, lam1, 2);
                }
            }
        }
        if (s == 6) { PH(9) gla_g3(lds, p, l, (const bf16_t*)(ws + OFF_Q), (const bf16_t*)(ws + OFF_K), (const bf16_t*)(ws + OFF_V), (const bf16_t*)(ws + OFF_R), (const float*)(ws + OFF_Z),
                                   (const bf16_t*)(ws + OFF_GS), (bf16_t*)(ws + OFF_O), G, (c + 32) % G); }
        grid_barrier(bctx);
#ifdef DBG_AMP_STEP
        if (c == 0 && s == DBG_AMP_STEP) {
            const unsigned long long t1 = __builtin_amdgcn_s_memrealtime(); const unsigned long long dt = t1 - amp_t0;
            while (__builtin_amdgcn_s_memrealtime() - t1 < 4ull * dt) __builtin_amdgcn_s_sleep(8);
            __syncthreads();
        }
#endif
    }
#ifdef DBG_AMP_FINAL
    amp_k0 = __builtin_amdgcn_s_memrealtime();
#endif
    {
        const int tid_ = opaque_tid(); const int wid = tid_ >> 6, lane = tid_ & 63;
        const float* gf = p.in[31]; const float* rowpart = (const float*)(ws + OFF_ROWPART); const bf16_t* hbf = (const bf16_t*)(ws + OFF_HB);
        for (int row = c * 8 + wid; row < TR; row += G * 8) {
            float s = lane < 16 ? rowpart[(size_t)row * 16 + lane] : 0.f;
#pragma unroll
            for (int o = 8; o >= 1; o >>= 1) s += __shfl_xor(s, o);
            s = __shfl(s, 0);
            const float rs = rsqrtf(s * (1.f / 1024.f) + 1e-6f);
#pragma unroll
            for (int i = 0; i < 4; ++i) { const int col = (i * 64 + lane) * 4; const u32x2 hv = *(const u32x2*)(hbf + (size_t)row * DM + col); const f32x4 gv = *(const f32x4*)(gf + col);
                f32x4 v; v[0] = lo16(hv.x) * rs * gv[0]; v[1] = hi16(hv.x) * rs * gv[1]; v[2] = lo16(hv.y) * rs * gv[2]; v[3] = hi16(hv.y) * rs * gv[3]; *(f32x4*)(out + (size_t)row * DM + col) = v; }
        }
    }
#ifdef DBG_AMP_FINAL
    { const unsigned long long t1 = __builtin_amdgcn_s_memrealtime(); const unsigned long long dt = t1 - amp_k0; while (__builtin_amdgcn_s_memrealtime() - t1 < 4ull * dt) __builtin_amdgcn_s_sleep(8); }
#endif
}

extern "C" void kernel_launch(void* const* d_in, const int* in_sizes, int n_in, void* d_out, int out_size, void* d_ws, size_t ws_size, hipStream_t stream) {
    static int grid_blocks = 0;
    if (grid_blocks == 0) {
        if (n_in != 32 || ws_size < WS_END || out_size != TR * DM) { fprintf(stderr, "kernel_launch: unexpected shapes / workspace (%d inputs, ws %zu < %zu)\n", n_in, ws_size, (size_t)WS_END); grid_blocks = -1; return; }
        int dev = 0, cus = 0, per_cu = 0;
        hipGetDevice(&dev); hipDeviceGetAttribute(&cus, hipDeviceAttributeMultiprocessorCount, dev);
        hipFuncSetAttribute((const void*)fwd_mega, hipFuncAttributeMaxDynamicSharedMemorySize, LDS_BYTES);
        hipOccupancyMaxActiveBlocksPerMultiprocessor(&per_cu, (const void*)fwd_mega, NTHR, LDS_BYTES);
        if (per_cu < 1) per_cu = 1;
        if (per_cu > 1) per_cu = 1;
        grid_blocks = cus * per_cu;
    }
    if (grid_blocks < 0) return;
    if (hipMemsetAsync((char*)d_ws + OFF_BAR, 0, 4096, stream) != hipSuccess) { fprintf(stderr, "memset failed\n"); return; }
    Params p{};
    for (int i = 0; i < 32; ++i) p.in[i] = (const float*)d_in[i];
    p.out = (float*)d_out; p.ws = (unsigned char*)d_ws;
    void* args[] = {&p};
    hipError_t e = hipLaunchCooperativeKernel((const void*)fwd_mega, dim3(grid_blocks), dim3(NTHR), args, LDS_BYTES, stream);
    if (e != hipSuccess) fprintf(stderr, "cooperative launch failed: %s (grid %d)\n", hipGetErrorString(e), grid_blocks);
}
```

```cpp
#include <hip/hip_runtime.h>
#include <hip/hip_cooperative_groups.h>
#include <cstdio>
namespace cg = cooperative_groups;

#define LAS __attribute__((address_space(3)))
typedef unsigned short bf16_t;
typedef short bf16x8 __attribute__((ext_vector_type(8)));
typedef float f32x4 __attribute__((ext_vector_type(4)));
typedef float f32x2 __attribute__((ext_vector_type(2)));
typedef unsigned u32x4 __attribute__((ext_vector_type(4)));
typedef unsigned u32x2 __attribute__((ext_vector_type(2)));

constexpr int T = 32800, TR = 32768, DM = 1024, DFF = 2816, DIN = 4128;
constexpr int NCH = 1025, MCH = 2050;
constexpr int GCH = 257;
constexpr int NTHR = 512;
constexpr int LDS_BYTES = 131072;

constexpr size_t AL(size_t x) { return (x + 255) & ~size_t(255); }
constexpr size_t SLACK = size_t(2) << 20;
constexpr size_t OFF_HB = 0;
constexpr size_t OFF_METAH = OFF_HB + AL((size_t)T * 1024 * 2) + SLACK;
constexpr size_t OFF_ROWPART = OFF_METAH + 32 * 1024 * 4;
constexpr size_t OFF_LAM = OFF_ROWPART + AL((size_t)T * 16 * 4);
constexpr size_t LAM_BYTES = 32 * 2 * 64 * 2 * 4;
constexpr size_t OFF_W = OFF_LAM + 2 * LAM_BYTES;
constexpr size_t W_UP1 = 0, W_DN1 = W_UP1 + (size_t)5632 * 1024, W_INP = W_DN1 + (size_t)1024 * 2816, W_ING = W_INP + (size_t)2304 * 1024,
                 W_GLU = W_ING + (size_t)2048 * 1024, W_O = W_GLU + (size_t)2048 * 512, W_OUT = W_O + (size_t)1024 * 512,
                 W_UP2 = W_OUT + (size_t)1024 * 1024, W_DN2 = W_UP2 + (size_t)5632 * 1024, W_S1 = W_DN2 + (size_t)1024 * 2816,
                 W_S2 = W_S1 + (size_t)32 * 256 * 256, W_END = W_S2 + (size_t)32 * 256 * 512;
constexpr size_t W_BYTES = AL(W_END * 2);
constexpr size_t OFF_R1 = OFF_W + 2 * W_BYTES;
constexpr size_t R1_SIZE = AL((size_t)T * 2816 * 2) + SLACK;
constexpr size_t OFF_HID = OFF_R1;
constexpr size_t OFF_UBUF = OFF_R1;
constexpr size_t OFF_Q = OFF_UBUF + AL((size_t)32 * MCH * 512 * 2) + SLACK;
constexpr size_t OFF_K = OFF_Q + AL((size_t)T * 256 * 2);
constexpr size_t OFF_V = OFF_K + AL((size_t)T * 256 * 2);
constexpr size_t OFF_R = OFF_V + AL((size_t)T * 512 * 2);
constexpr size_t OFF_Z = OFF_R + AL((size_t)T * 512 * 2);
constexpr size_t OFF_ZEND = OFF_Z + AL((size_t)T * 32 * 4);
static_assert(OFF_ZEND <= OFF_R1 + R1_SIZE, "R1 overflow");
constexpr size_t OFF_SB = OFF_R1;
constexpr size_t OFF_GB = OFF_SB + AL((size_t)T * 1024 * 2) + SLACK;
static_assert(OFF_GB + AL((size_t)T * 1024 * 2) + SLACK <= OFF_R1 + R1_SIZE, "R1 overflow 2");
constexpr size_t OFF_R2 = OFF_R1 + R1_SIZE;
constexpr size_t OFF_S5S = OFF_R2;
constexpr size_t OFF_Y = OFF_R2;
constexpr size_t OFF_O = OFF_Y + AL((size_t)T * 512 * 2) + SLACK;
constexpr size_t R2A_A = AL((size_t)32 * MCH * 256 * 4), R2A_B = 2 * (AL((size_t)T * 512 * 2) + SLACK);
constexpr size_t R2A_SIZE = R2A_A > R2A_B ? R2A_A : R2A_B;
constexpr size_t OFF_GS = OFF_R2 + R2A_SIZE;
constexpr size_t OFF_DEC = OFF_GS + AL((size_t)4112 * 8192 * 2);
constexpr size_t OFF_BAR = OFF_DEC + AL((size_t)4112 * 64 * 4);
#ifdef DBG_DUP_ALLGEMM
constexpr size_t OFF_DUMMY = OFF_BAR + 4096;
constexpr size_t WS_END = OFF_DUMMY + AL((size_t)T * 1024 * 2) + SLACK;
#else
constexpr size_t WS_END = OFF_BAR + 4096;
#endif

#ifndef PHMASK
#if defined(DBG_NO_GLA)
#define PHMASK 0xFFFD5F
#elif defined(DBG_NO_INTER)
#define PHMASK 0xFFFF1F
#elif defined(DBG_NO_S5)
#define PHMASK 0xFFFFBF
#else
#define PHMASK 0xFFFFFF
#endif
#endif
#define PH(n) if constexpr (((PHMASK) >> (n)) & 1)
struct Params { const float* in[32]; float* out; unsigned char* ws; };

__device__ __forceinline__ float bf2f(bf16_t b) { return __uint_as_float(((unsigned)b) << 16); }
typedef __bf16 bf16x2_t __attribute__((ext_vector_type(2)));
__device__ __forceinline__ unsigned pk2(float lo, float hi) { bf16x2_t v; v.x = (__bf16)lo; v.y = (__bf16)hi; return __builtin_bit_cast(unsigned, v); }
__device__ __forceinline__ bf16_t f2bf(float f) { return (bf16_t)(pk2(f, 0.f) & 0xffffu); }
__device__ __forceinline__ float sigm(float x) { return __builtin_amdgcn_rcpf(1.f + __expf(-x)); }
__device__ __forceinline__ float siluf_(float x) { return x * sigm(x); }
__device__ __forceinline__ float gelu_tanh(float x) { const float u = 0.7978845608028654f * (x + 0.044715f * x * x * x); return x * sigm(2.f * u); }
__device__ __forceinline__ float logsig(float x) { return fminf(x, 0.f) - __logf(1.f + __expf(-fabsf(x))); }
__device__ __forceinline__ float lo16(unsigned w) { return __uint_as_float(w << 16); }
__device__ __forceinline__ float hi16(unsigned w) { return __uint_as_float(w & 0xffff0000u); }
__device__ __forceinline__ float row_rstd(const float* rowpart, int rowc, int fq) {
    const f32x4 p = *(const f32x4*)(rowpart + (size_t)rowc * 16 + 4 * fq);
    float s = (p[0] + p[1]) + (p[2] + p[3]);
    s += __shfl_xor(s, 16); s += __shfl_xor(s, 32);
    return rsqrtf(s * (1.f / 1024.f) + 1e-6f);
}
__device__ __forceinline__ float rstd_finish(const f32x4 p) {
    float s = (p[0] + p[1]) + (p[2] + p[3]);
    s += __shfl_xor(s, 16); s += __shfl_xor(s, 32);
    return rsqrtf(s * (1.f / 1024.f) + 1e-6f);
}
#define LOAD_RS8(rs, rowpart, u, wr, fr, fq, Mv) float rs[2][4]; { f32x4 _p[2][4]; \
    _Pragma("unroll") for (int ai = 0; ai < 2; ++ai) _Pragma("unroll") for (int m = 0; m < 4; ++m) { const int _r = (u).pm * 256 + ai * 128 + (wr) * 64 + m * 16 + (fr); const int _rc = _r < (Mv) ? _r : (Mv) - 1; \
        _p[ai][m] = *(const f32x4*)((rowpart) + (size_t)_rc * 16 + 4 * (fq)); } \
    _Pragma("unroll") for (int ai = 0; ai < 2; ++ai) _Pragma("unroll") for (int m = 0; m < 4; ++m) rs[ai][m] = rstd_finish(_p[ai][m]); }
__device__ __forceinline__ int opaque_tid() { int t = threadIdx.x; asm volatile("" : "+v"(t)); return t; }
__device__ __forceinline__ void row_to_mt(int row, int& m, int& t) {
    if (row < TR) { const int b = row >> 14, s = row & 16383, p = s + 16; m = b * NCH + (p >> 4); t = p & 15; }
    else { const int rr = row - TR; m = (rr >> 4) * NCH; t = rr & 15; }
}

namespace pg8 {
constexpr int BM = 256, BK = 64, HALF = 128, HTB = HALF * BK * 2, NXCD = 8, WGM = 8;
__device__ __forceinline__ int lds_byte(int r, int c) { const int st = (r >> 4) * 2 + (c >> 5), rr = r & 15, cc = c & 31, ob = rr * 64 + cc * 2; return st * 1024 + (ob ^ (((ob >> 9) & 1) << 5)); }
__device__ __forceinline__ void stage_rc(int b, int& R, int& C) { const int st = b / 1024, sb = b % 1024, swz = sb ^ (((sb >> 9) & 1) << 5); R = (st >> 1) * 16 + swz / 64; C = (st & 1) * 32 + (swz % 64) / 2; }
struct Unit { int pm, pn, pg; };
struct Gemm { const bf16_t* A; const bf16_t* Bt; int lda, K, nM, nN, nG; size_t gsA, gsB; int tail; int blkA; int rev; };

__device__ __forceinline__ int next_unit(const Gemm& g, int i, int G, int c) {
    const int nwg = g.nM * g.nN, tot = nwg * g.nG;
    const int L = i * G + c; if (L >= tot) return -1;
    int pm, pn, pg;
    if (g.nG > 1) { pg = L / nwg; const int r = L - pg * nwg; pm = r / g.nN; pn = r - pm * g.nN; }
    else {
        int wgid = L; { const int q = nwg / NXCD, r = nwg % NXCD, xcd = wgid % NXCD, off = wgid / NXCD; wgid = (xcd < r ? xcd * (q + 1) : r * (q + 1) + (xcd - r) * q) + off; }
        const int nig = WGM * g.nN, gid = wgid / nig, fm = gid * WGM, gsz = (g.nM - fm) < WGM ? (g.nM - fm) : WGM;
        const int rem = wgid - gid * nig; pn = rem / gsz; pm = fm + (rem - pn * gsz); pg = 0;
        if (g.rev) pm = g.nM - 1 - pm;
    }
    return pm | (pn << 10) | (pg << 20);
}
__device__ __forceinline__ Unit unpack_unit(int v) { Unit u; u.pm = v & 1023; u.pn = (v >> 10) & 1023; u.pg = v >> 20; return u; }

template <class Epi>
__device__ __forceinline__ void gemm_phase(LAS unsigned char* lds, const Gemm g, const Epi& E, const int G, const int c) {
    const int tid = opaque_tid(), wid = __builtin_amdgcn_readfirstlane(tid >> 6), lane = tid & 63, wr = wid >> 2, wc = wid & 3, fr = lane & 15, fq = lane >> 4;
    const int K = g.K, nt = K / BK;
    unsigned voffA[2], voffB[2];
#pragma unroll
    for (int i = 0; i < 2; ++i) { int R, C; stage_rc(tid * 16 + i * 8192, R, C); voffA[i] = (unsigned)(R * (g.blkA ? 64 : g.lda) + C) * 2u; voffB[i] = (unsigned)(R * K + C) * 2u; }
    const size_t kstep = (size_t)(BK * 2);
    const size_t kstepA = g.blkA ? (size_t)32768 : kstep;
    const size_t hstepA = g.blkA ? (size_t)16384 : (size_t)HALF * g.lda * 2, hstepB = (size_t)HALF * K * 2;
    const size_t tstepA = g.blkA ? (size_t)nt * 32768 : 2 * hstepA, tstepB = 2 * hstepB;
    const unsigned ldsw = (unsigned)wid * 1024u;
    const int aoff = lds_byte(wr * 64 + fr, fq * 8), boff = lds_byte(wc * 32 + fr, fq * 8);
#define PG8_SA(b, h) (((b) * 2 + (h)) * HTB)
#define PG8_SB(b, h) ((4 + (b) * 2 + (h)) * HTB)
#define PG8_STAGE(bufoff, gbase, voff) do { _Pragma("unroll") for (int _i = 0; _i < 2; ++_i) \
        __builtin_amdgcn_global_load_lds((const unsigned*)((const char*)(gbase) + (voff)[_i]), (LAS unsigned*)(lds + (bufoff) + ldsw + _i * 8192), 16, 0, 0); } while (0)
#define PG8_LDA(dst, b, h) do { _Pragma("unroll") for (int m = 0; m < 4; ++m) _Pragma("unroll") for (int k = 0; k < 2; ++k) dst[m][k] = *(const LAS bf16x8*)(lds + PG8_SA(b, h) + aoff + m * 2048 + k * 1024); } while (0)
#define PG8_LDB(dst, b, h) do { _Pragma("unroll") for (int n = 0; n < 2; ++n) _Pragma("unroll") for (int k = 0; k < 2; ++k) dst[n][k] = *(const LAS bf16x8*)(lds + PG8_SB(b, h) + boff + n * 2048 + k * 1024); } while (0)
#define PG8_MMA(ai, bj, At, Bt) do { __builtin_amdgcn_s_setprio(1); _Pragma("unroll") for (int m = 0; m < 4; ++m) _Pragma("unroll") for (int n = 0; n < 2; ++n) _Pragma("unroll") for (int k = 0; k < 2; ++k) \
        acc[ai][bj][m][n] = __builtin_amdgcn_mfma_f32_16x16x32_bf16(Bt[n][k], At[m][k], acc[ai][bj][m][n], 0, 0, 0); __builtin_amdgcn_s_setprio(0); } while (0)
#define PG8_WAIT_V(n) asm volatile("s_waitcnt vmcnt(" #n ")" ::: "memory")
#define PG8_WAIT_L(n) asm volatile("s_waitcnt lgkmcnt(" #n ")" ::: "memory")
#define PG8_BAR __builtin_amdgcn_s_barrier()
#define PG8_SCHED __builtin_amdgcn_sched_barrier(0)
    int ui = 0;
    int curp = next_unit(g, 0, G, c);
    Unit cur = unpack_unit(curp < 0 ? 0 : curp);
    f32x4 acc[2][2][4][2];
#pragma unroll
    for (int a = 0; a < 2; ++a)
#pragma unroll
        for (int b = 0; b < 2; ++b)
#pragma unroll
            for (int m = 0; m < 4; ++m)
#pragma unroll
                for (int n = 0; n < 2; ++n) acc[a][b][m][n] = (f32x4){0.f, 0.f, 0.f, 0.f};
    if (curp >= 0) {
    bf16x8 At[4][2], B0[2][2], B1[2][2];
    const char* cA = (const char*)(g.A + (size_t)cur.pg * g.gsA) + (size_t)cur.pm * tstepA;
    const char* cB = (const char*)(g.Bt + (size_t)cur.pg * g.gsB) + (size_t)cur.pn * tstepB;
    PG8_STAGE(PG8_SB(0, 0), cB, voffB); PG8_STAGE(PG8_SA(0, 0), cA, voffA); PG8_STAGE(PG8_SB(0, 1), cB + hstepB, voffB); PG8_STAGE(PG8_SA(0, 1), cA + hstepA, voffA);
    if (wr == 1) PG8_BAR;
    PG8_WAIT_V(4); PG8_BAR;
    PG8_STAGE(PG8_SB(1, 0), cB + kstep, voffB); PG8_STAGE(PG8_SA(1, 0), cA + kstepA, voffA); PG8_STAGE(PG8_SB(1, 1), cB + hstepB + kstep, voffB);
    PG8_WAIT_V(6); PG8_BAR;
    for (;;) {
        const int nxtp = next_unit(g, ui + 1, G, c); const bool has_next = nxtp >= 0; const Unit nxt = unpack_unit(has_next ? nxtp : curp);
        const char* nA = has_next ? (const char*)(g.A + (size_t)nxt.pg * g.gsA) + (size_t)nxt.pm * tstepA : cA;
        const char* nB = has_next ? (const char*)(g.Bt + (size_t)nxt.pg * g.gsB) + (size_t)nxt.pn * tstepB : cB;
        for (int t = 0; t < nt; t += 2) {
            const bool last = (t == nt - 2);
            const char* a1 = cA + (size_t)(t + 1) * kstepA;
            const char* a2 = last ? nA : cA + (size_t)(t + 2) * kstepA; const char* b2 = last ? nB : cB + (size_t)(t + 2) * kstep;
            const char* a3 = a2 + kstepA; const char* b3 = b2 + kstep;
            PG8_LDB(B0, 0, 0); PG8_SCHED; PG8_LDA(At, 0, 0); PG8_STAGE(PG8_SA(1, 1), a1 + hstepA, voffA);
            PG8_WAIT_L(8); PG8_BAR; PG8_WAIT_L(0); PG8_MMA(0, 0, At, B0); PG8_BAR; PG8_SCHED;
            PG8_LDB(B1, 0, 1); PG8_STAGE(PG8_SB(0, 0), b2, voffB);
            PG8_BAR; PG8_WAIT_L(0); PG8_MMA(0, 1, At, B1); PG8_BAR;
            PG8_LDA(At, 0, 1); PG8_STAGE(PG8_SA(0, 0), a2, voffA);
            PG8_BAR; PG8_WAIT_L(0); PG8_MMA(1, 0, At, B0); PG8_BAR; PG8_SCHED;
            PG8_STAGE(PG8_SB(0, 1), b2 + hstepB, voffB);
            PG8_WAIT_V(6); PG8_BAR; PG8_MMA(1, 1, At, B1); PG8_BAR;
            PG8_LDB(B0, 1, 0); PG8_SCHED; PG8_LDA(At, 1, 0); PG8_STAGE(PG8_SA(0, 1), a2 + hstepA, voffA);
            PG8_WAIT_L(8); PG8_BAR; PG8_WAIT_L(0); PG8_MMA(0, 0, At, B0); PG8_BAR; PG8_SCHED;
            PG8_LDB(B1, 1, 1); PG8_STAGE(PG8_SB(1, 0), b3, voffB);
            PG8_BAR; PG8_WAIT_L(0); PG8_MMA(0, 1, At, B1); PG8_BAR;
            PG8_LDA(At, 1, 1); PG8_STAGE(PG8_SA(1, 0), a3, voffA);
            PG8_BAR; PG8_WAIT_L(0); PG8_MMA(1, 0, At, B0); PG8_BAR; PG8_SCHED;
            PG8_STAGE(PG8_SB(1, 1), b3 + hstepB, voffB);
            PG8_WAIT_V(6); PG8_BAR; PG8_MMA(1, 1, At, B1); PG8_BAR;
        }
        { int efr = fr, efq = fq; asm volatile("" : "+v"(efr), "+v"(efq)); E(acc, cur, wr, wc, efr, efq); }
        if (!has_next) break;
#pragma unroll
        for (int a = 0; a < 2; ++a)
#pragma unroll
            for (int b = 0; b < 2; ++b)
#pragma unroll
                for (int m = 0; m < 4; ++m)
#pragma unroll
                    for (int n = 0; n < 2; ++n) acc[a][b][m][n] = (f32x4){0.f, 0.f, 0.f, 0.f};
        cur = nxt; curp = nxtp; cA = nA; cB = nB; ++ui;
    }
    PG8_WAIT_V(0);
    if (wr == 0) PG8_BAR;
    PG8_BAR;
    }
    if (g.tail) {
        const int ks = K >> 3;
        for (int j = G - 1 - c; j < 4 * g.nN; j += G) {
            const int pn = j >> 2, q = j & 3;
#pragma unroll
            for (int a = 0; a < 2; ++a)
#pragma unroll
                for (int b = 0; b < 2; ++b)
#pragma unroll
                    for (int m = 0; m < 4; ++m)
#pragma unroll
                        for (int n = 0; n < 2; ++n) acc[a][b][m][n] = (f32x4){0.f, 0.f, 0.f, 0.f};
            const bf16_t* Ap = g.blkA ? g.A + (size_t)g.nM * nt * 16384 + fr * 64 + fq * 8 : g.A + (size_t)(g.nM * 256 + fr) * g.lda + fq * 8;
            const bf16_t* Bp = g.Bt + (size_t)(pn * 256 + q * 32 + fr) * K + wid * ks + fq * 8;
            const size_t a16 = g.blkA ? (size_t)16 * 64 : (size_t)16 * g.lda, b16 = (size_t)16 * K, b128 = (size_t)128 * K;
            for (int k0 = 0; k0 < ks; k0 += 64) {
                bf16x8 av[2][2], bv[2][4];
#pragma unroll
                for (int qq = 0; qq < 2; ++qq) if (k0 + qq * 32 < ks) {
                    const int kk = k0 + qq * 32, ka = wid * ks + kk; const size_t ao = g.blkA ? (size_t)(ka >> 6) * 16384 + (ka & 63) : (size_t)ka;
                    av[qq][0] = *(const bf16x8*)(Ap + ao); av[qq][1] = *(const bf16x8*)(Ap + a16 + ao);
                    bv[qq][0] = *(const bf16x8*)(Bp + kk); bv[qq][1] = *(const bf16x8*)(Bp + b16 + kk);
                    bv[qq][2] = *(const bf16x8*)(Bp + b128 + kk); bv[qq][3] = *(const bf16x8*)(Bp + b128 + b16 + kk);
                }
#pragma unroll
                for (int qq = 0; qq < 2; ++qq) if (k0 + qq * 32 < ks) {
                    acc[0][0][0][0] = __builtin_amdgcn_mfma_f32_16x16x32_bf16(bv[qq][0], av[qq][0], acc[0][0][0][0], 0, 0, 0);
                    acc[0][0][1][0] = __builtin_amdgcn_mfma_f32_16x16x32_bf16(bv[qq][0], av[qq][1], acc[0][0][1][0], 0, 0, 0);
                    acc[0][0][0][1] = __builtin_amdgcn_mfma_f32_16x16x32_bf16(bv[qq][1], av[qq][0], acc[0][0][0][1], 0, 0, 0);
                    acc[0][0][1][1] = __builtin_amdgcn_mfma_f32_16x16x32_bf16(bv[qq][1], av[qq][1], acc[0][0][1][1], 0, 0, 0);
                    acc[0][1][0][0] = __builtin_amdgcn_mfma_f32_16x16x32_bf16(bv[qq][2], av[qq][0], acc[0][1][0][0], 0, 0, 0);
                    acc[0][1][1][0] = __builtin_amdgcn_mfma_f32_16x16x32_bf16(bv[qq][2], av[qq][1], acc[0][1][1][0], 0, 0, 0);
                    acc[0][1][0][1] = __builtin_amdgcn_mfma_f32_16x16x32_bf16(bv[qq][3], av[qq][0], acc[0][1][0][1], 0, 0, 0);
                    acc[0][1][1][1] = __builtin_amdgcn_mfma_f32_16x16x32_bf16(bv[qq][3], av[qq][1], acc[0][1][1][1], 0, 0, 0);
                }
            }
            LAS f32x4* red = (LAS f32x4*)lds;
#pragma unroll
            for (int bj = 0; bj < 2; ++bj)
#pragma unroll
                for (int m = 0; m < 2; ++m)
#pragma unroll
                    for (int n = 0; n < 2; ++n) red[(wid * 8 + bj * 4 + m * 2 + n) * 64 + lane] = acc[0][bj][m][n];
            __syncthreads();
            if (wid == q) {
#pragma unroll
                for (int bj = 0; bj < 2; ++bj)
#pragma unroll
                    for (int m = 0; m < 2; ++m)
#pragma unroll
                        for (int n = 0; n < 2; ++n) {
                            f32x4 sum = (f32x4){0.f, 0.f, 0.f, 0.f};
#pragma unroll 2
                            for (int w = 0; w < 8; ++w) sum += red[(w * 8 + bj * 4 + m * 2 + n) * 64 + lane];
                            acc[0][bj][m][n] = sum;
                            asm volatile("" ::: "memory");
                        }
                Unit tu; tu.pm = g.nM; tu.pn = pn; tu.pg = 0; int efr = fr, efq = fq; asm volatile("" : "+v"(efr), "+v"(efq)); E(acc, tu, 0, q, efr, efq);
            }
            __syncthreads();
        }
    }
#undef PG8_SA
#undef PG8_SB
#undef PG8_STAGE
#undef PG8_LDA
#undef PG8_LDB
#undef PG8_MMA
#undef PG8_WAIT_V
#undef PG8_WAIT_L
#undef PG8_BAR
#undef PG8_SCHED
}
}
using pg8::Unit;
typedef f32x4 Acc[2][2][4][2];

struct EpiUp {
    const float* rowpart; bf16_t* hid; int Mv;
    __device__ __forceinline__ void operator()(const Acc& acc, const Unit& u, int wr, int wc, int fr, int fq) const {
        LOAD_RS8(rsv, rowpart, u, wr, fr, fq, Mv)
#pragma unroll
        for (int ai = 0; ai < 2; ++ai)
#pragma unroll
            for (int m = 0; m < 4; ++m) {
                const int row = u.pm * 256 + ai * 128 + wr * 64 + m * 16 + fr;
                const float rs = rsv[ai][m];
#pragma unroll
                for (int bj = 0; bj < 2; ++bj) {
                    const f32x4 gv = acc[ai][bj][m][0] * rs, uv = acc[ai][bj][m][1] * rs;
                    u32x2 w; w.x = pk2(siluf_(gv[0]) * uv[0], siluf_(gv[1]) * uv[1]); w.y = pk2(siluf_(gv[2]) * uv[2], siluf_(gv[3]) * uv[3]);
                    const int col = 128 * u.pn + 64 * bj + 16 * wc + 4 * fq;
                    if (row < Mv) *(u32x2*)(hid + ((size_t)((row >> 8) * 44 + (col >> 6)) * 256 + (row & 255)) * 64 + (col & 63)) = w;
                }
            }
    }
};
struct EpiRes {
    float* out; float* metah; bf16_t* hb; float* rowpart; float scale; int Mv;
    __device__ __forceinline__ void operator()(const Acc& acc, const Unit& u, int wr, int wc, int fr, int fq) const {
#pragma unroll
        for (int ai = 0; ai < 2; ++ai) {
            u32x2 old[4][2][2];
#pragma unroll
            for (int m = 0; m < 4; ++m) {
                const int row = u.pm * 256 + ai * 128 + wr * 64 + m * 16 + fr; const int rc = row < Mv ? row : Mv - 1;
                const bf16_t* hp = hb + (size_t)rc * DM + 256 * u.pn + 32 * wc + 4 * fq;
#pragma unroll
                for (int bj = 0; bj < 2; ++bj)
#pragma unroll
                    for (int n = 0; n < 2; ++n) old[m][bj][n] = *(const u32x2*)(hp + 128 * bj + 16 * n);
            }
#pragma unroll
            for (int m = 0; m < 4; ++m) {
                const int row = u.pm * 256 + ai * 128 + wr * 64 + m * 16 + fr; const bool valid = row < Mv; const int rc = valid ? row : Mv - 1;
                bf16_t* hp = hb + (size_t)rc * DM + 256 * u.pn + 32 * wc + 4 * fq;
                float ss = 0.f;
#pragma unroll
                for (int bj = 0; bj < 2; ++bj)
#pragma unroll
                    for (int n = 0; n < 2; ++n) {
                        const u32x2 o = old[m][bj][n]; const f32x4 a = acc[ai][bj][m][n];
                        f32x4 nv; nv[0] = lo16(o.x) + a[0] * scale; nv[1] = hi16(o.x) + a[1] * scale; nv[2] = lo16(o.y) + a[2] * scale; nv[3] = hi16(o.y) + a[3] * scale;
                        ss += (nv[0] * nv[0] + nv[1] * nv[1]) + (nv[2] * nv[2] + nv[3] * nv[3]);
                        if (valid) { u32x2 w; w.x = pk2(nv[0], nv[1]); w.y = pk2(nv[2], nv[3]); *(u32x2*)(hp + 128 * bj + 16 * n) = w; }
                    }
                ss += __shfl_xor(ss, 16); ss += __shfl_xor(ss, 32);
                if (valid && fq == 0) rowpart[(size_t)row * 16 + u.pn * 4 + wc] = ss;
            }
            asm volatile("" ::: "memory");
        }
    }
};
struct EpiProj {
    const float* rowpart; bf16_t* ubuf; bf16_t* q; bf16_t* k; bf16_t* v; bf16_t* r; float* z; int Mv;
    __device__ __forceinline__ void operator()(const Acc& acc, const Unit& u, int wr, int wc, int fr, int fq) const {
        const int pn = u.pn;
        LOAD_RS8(rsv, rowpart, u, wr, fr, fq, Mv)
#pragma unroll
        for (int ai = 0; ai < 2; ++ai)
#pragma unroll
            for (int m = 0; m < 4; ++m) {
                const int row = u.pm * 256 + ai * 128 + wr * 64 + m * 16 + fr; const bool valid = row < Mv; const int rc = valid ? row : Mv - 1;
                const float rs = rsv[ai][m];
                int mm, tt; row_to_mt(rc, mm, tt);
#pragma unroll
                for (int bj = 0; bj < 2; ++bj)
#pragma unroll
                    for (int n = 0; n < 2; ++n) {
                        const f32x4 val = acc[ai][bj][m][n] * rs;
                        const int cl = 128 * bj + 32 * wc + 16 * n + 4 * fq;
                        u32x2 w; w.x = pk2(val[0], val[1]); w.y = pk2(val[2], val[3]);
                        if (!valid) continue;
                        if (pn < 2) { const int cc = 256 * pn + cl; const int gg = cc >> 4, j = cc & 15; *(u32x2*)(ubuf + ((size_t)gg * MCH + mm) * 512 + tt * 16 + j) = w; }
                        else if (pn == 2) *(u32x2*)(q + (size_t)row * 256 + cl) = w;
                        else if (pn == 3) *(u32x2*)(k + (size_t)row * 256 + cl) = w;
                        else if (pn < 6) *(u32x2*)(v + (size_t)row * 512 + (pn - 4) * 256 + cl) = w;
                        else if (pn < 8) *(u32x2*)(r + (size_t)row * 512 + (pn - 6) * 256 + cl) = w;
                        else if (cl < 32) *(f32x4*)(z + (size_t)row * 32 + cl) = val;
                    }
            }
    }
};
struct EpiS5S {
    float* S;
    __device__ __forceinline__ void operator()(const Acc& acc, const Unit& u, int wr, int wc, int fr, int fq) const {
#pragma unroll
        for (int ai = 0; ai < 2; ++ai)
#pragma unroll
            for (int m = 0; m < 4; ++m) {
                const int row = u.pm * 256 + ai * 128 + wr * 64 + m * 16 + fr;
                if (row < MCH) {
#pragma unroll
                    for (int bj = 0; bj < 2; ++bj)
#pragma unroll
                        for (int n = 0; n < 2; ++n) *(f32x4*)(S + ((size_t)u.pg * MCH + row) * 256 + 128 * bj + 32 * wc + 16 * n + 4 * fq) = acc[ai][bj][m][n];
                }
            }
    }
};
struct EpiS5Y {
    bf16_t* y;
    __device__ __forceinline__ void operator()(const Acc& acc, const Unit& u, int wr, int wc, int fr, int fq) const {
#pragma unroll
        for (int ai = 0; ai < 2; ++ai)
#pragma unroll
            for (int m = 0; m < 4; ++m) {
                const int mrow = u.pm * 256 + ai * 128 + wr * 64 + m * 16 + fr;
                if (mrow < MCH) {
                    const int b = mrow >= NCH ? 1 : 0, cch = mrow - b * NCH;
                    const int rbase = cch == 0 ? TR + 16 * b : b * 16384 + 16 * (cch - 1);
#pragma unroll
                    for (int bj = 0; bj < 2; ++bj)
#pragma unroll
                        for (int n = 0; n < 2; ++n) {
                            const int tt = 8 * bj + 2 * wc + n; const f32x4 a = acc[ai][bj][m][n];
                            u32x2 w; w.x = pk2(gelu_tanh(a[0]), gelu_tanh(a[1])); w.y = pk2(gelu_tanh(a[2]), gelu_tanh(a[3]));
                            *(u32x2*)(y + (size_t)(rbase + tt) * 512 + u.pg * 16 + 4 * fq) = w;
                        }
                }
            }
    }
};
struct EpiGlu {
    bf16_t* S; int Mv;
    __device__ __forceinline__ void operator()(const Acc& acc, const Unit& u, int wr, int wc, int fr, int fq) const {
#pragma unroll
        for (int ai = 0; ai < 2; ++ai)
#pragma unroll
            for (int m = 0; m < 4; ++m) {
                const int row = u.pm * 256 + ai * 128 + wr * 64 + m * 16 + fr;
#pragma unroll
                for (int bj = 0; bj < 2; ++bj) {
                    const f32x4 a = acc[ai][bj][m][0], b = acc[ai][bj][m][1];
                    u32x2 w; w.x = pk2(a[0] * sigm(b[0]), a[1] * sigm(b[1])); w.y = pk2(a[2] * sigm(b[2]), a[3] * sigm(b[3]));
                    const int col = 128 * u.pn + 64 * bj + 16 * wc + 4 * fq;
                    if (row < Mv) *(u32x2*)(S + (size_t)row * DM + col) = w;
                }
            }
    }
};
struct EpiBf {
    bf16_t* O; int Mv;
    __device__ __forceinline__ void operator()(const Acc& acc, const Unit& u, int wr, int wc, int fr, int fq) const {
#pragma unroll
        for (int ai = 0; ai < 2; ++ai)
#pragma unroll
            for (int m = 0; m < 4; ++m) {
                const int row = u.pm * 256 + ai * 128 + wr * 64 + m * 16 + fr;
#pragma unroll
                for (int bj = 0; bj < 2; ++bj)
#pragma unroll
                    for (int n = 0; n < 2; ++n) {
                        const f32x4 a = acc[ai][bj][m][n]; u32x2 w; w.x = pk2(a[0], a[1]); w.y = pk2(a[2], a[3]);
                        const int col = 256 * u.pn + 128 * bj + 32 * wc + 16 * n + 4 * fq;
                        if (row < Mv) *(u32x2*)(O + (size_t)row * DM + col) = w;
                    }
            }
    }
};
struct EpiGate {
    const float* rowpart; bf16_t* S; const bf16_t* Gm; int Mv;
    __device__ __forceinline__ void operator()(const Acc& acc, const Unit& u, int wr, int wc, int fr, int fq) const {
        LOAD_RS8(rsv, rowpart, u, wr, fr, fq, Mv)
#pragma unroll
        for (int ai = 0; ai < 2; ++ai) {
            u32x2 sv[4][2], gv[4][2];
#pragma unroll
            for (int m = 0; m < 4; ++m)
#pragma unroll
                for (int bj = 0; bj < 2; ++bj) {
                    const int row = u.pm * 256 + ai * 128 + wr * 64 + m * 16 + fr; const int rc = row < Mv ? row : Mv - 1; const int col = 128 * u.pn + 64 * bj + 16 * wc + 4 * fq;
                    sv[m][bj] = *(const u32x2*)(S + (size_t)rc * DM + col); gv[m][bj] = *(const u32x2*)(Gm + (size_t)rc * DM + col);
                }
#pragma unroll
            for (int m = 0; m < 4; ++m) {
                const int row = u.pm * 256 + ai * 128 + wr * 64 + m * 16 + fr; const bool valid = row < Mv;
                const float rs = rsv[ai][m];
#pragma unroll
                for (int bj = 0; bj < 2; ++bj) {
                    const int col = 128 * u.pn + 64 * bj + 16 * wc + 4 * fq;
                    const f32x4 g0 = acc[ai][bj][m][0] * rs, g1 = acc[ai][bj][m][1] * rs;
                    const u32x2 s2 = sv[m][bj], g2 = gv[m][bj];
                    const float o0 = sigm(g0[0]) * lo16(s2.x) + sigm(g1[0]) * lo16(g2.x), o1 = sigm(g0[1]) * hi16(s2.x) + sigm(g1[1]) * hi16(g2.x);
                    const float o2 = sigm(g0[2]) * lo16(s2.y) + sigm(g1[2]) * lo16(g2.y), o3 = sigm(g0[3]) * hi16(s2.y) + sigm(g1[3]) * hi16(g2.y);
                    u32x2 w; w.x = pk2(o0, o1); w.y = pk2(o2, o3);
                    if (valid) *(u32x2*)(S + (size_t)row * DM + col) = w;
                }
            }
            asm volatile("" ::: "memory");
        }
    }
};

struct CvtJob { const float* s0; const float* s1; const float* scale; bf16_t* dst; int K, N, ld, pair, nvalid, q0, q1; };
__device__ __forceinline__ const float* cvt_map(const CvtJob& j, int c, float& mul) {
    mul = 1.f;
    if (j.pair) { const int col = (c >> 5) * 16 + (c & 15); return ((c >> 4) & 1) ? j.s1 + col : j.s0 + col; }
    if (c >= j.q0 && c < j.q1) mul = 0.125f;
    return c < j.nvalid ? j.s0 + c : nullptr;
}
__device__ __forceinline__ void cvt_load(const CvtJob& j, int ti, int nkt, int tid, f32x4 (&v)[2][4]) {
    const int k0 = (ti % nkt) * 64, c0 = (ti / nkt) * 256;
    const int cq = (tid & 15) * 4, kk0 = tid >> 4;
#pragma unroll
    for (int cb = 0; cb < 4; ++cb) {
        float mul; const float* sp = cvt_map(j, c0 + cb * 64 + cq, mul);
#pragma unroll
        for (int ps = 0; ps < 2; ++ps) {
            const int kk = kk0 + 32 * ps;
            v[ps][cb] = (f32x4){0.f, 0.f, 0.f, 0.f};
            if (sp) { v[ps][cb] = *(const f32x4*)(sp + (size_t)(k0 + kk) * j.ld); const float sc = (j.scale ? j.scale[k0 + kk] : 1.f) * mul; v[ps][cb] = v[ps][cb] * sc; }
        }
    }
}
__device__ __forceinline__ void convert_wt(LAS unsigned char* lds, const CvtJob& j, int G, int c, int& rot) {
    LAS float* tile = (LAS float*)lds;
    const int tid = opaque_tid();
    const int K = j.K;
    const int nkt = K / 64, nct = j.N / 256, ntile = nkt * nct;
    int ti = (c + G - (rot % G)) % G;
    f32x4 v[2][4];
    if (ti < ntile) cvt_load(j, ti, nkt, tid, v);
    for (; ti < ntile; ti += G) {
        const int k0 = (ti % nkt) * 64, c0 = (ti / nkt) * 256;
        {
            const int cq = (tid & 15) * 4, kk0 = tid >> 4;
#pragma unroll
            for (int cb = 0; cb < 4; ++cb)
#pragma unroll
                for (int ps = 0; ps < 2; ++ps) {
                    const int kk = kk0 + 32 * ps; LAS float* tp = tile + kk * 257 + cb * 64 + cq;
                    tp[0] = v[ps][cb][0]; tp[1] = v[ps][cb][1]; tp[2] = v[ps][cb][2]; tp[3] = v[ps][cb][3];
                }
        }
        __syncthreads();
        if (ti + G < ntile) cvt_load(j, ti + G, nkt, tid, v);
        {
            const int cc = tid >> 1, kq = (tid & 1) * 32;
#pragma unroll
            for (int q = 0; q < 4; ++q) {
                const int kb = kq + q * 8; u32x4 w;
                w.x = pk2(tile[(kb + 0) * 257 + cc], tile[(kb + 1) * 257 + cc]); w.y = pk2(tile[(kb + 2) * 257 + cc], tile[(kb + 3) * 257 + cc]);
                w.z = pk2(tile[(kb + 4) * 257 + cc], tile[(kb + 5) * 257 + cc]); w.w = pk2(tile[(kb + 6) * 257 + cc], tile[(kb + 7) * 257 + cc]);
                *(u32x4*)(j.dst + (size_t)(c0 + cc) * K + k0 + kb) = w;
            }
        }
        __syncthreads();
    }
    rot += ntile;
}
__device__ __forceinline__ CvtJob make_job(const Params& p, int l, int job) {
    bf16_t* W = (bf16_t*)(p.ws + OFF_W + (size_t)l * W_BYTES);
    const float* win = p.in[7] + (size_t)l * DM * DIN; const float* wglu = p.in[19] + (size_t)l * 512 * 2048;
    const float* n1 = p.in[2] + (size_t)l * DM; const float* nm = p.in[6] + (size_t)l * DM; const float* n2 = p.in[27] + (size_t)l * DM;
    switch (job) {
    case 0: return CvtJob{p.in[3] + (size_t)l * DM * DFF, p.in[4] + (size_t)l * DM * DFF, n1, W + W_UP1, 1024, 5632, DFF, 1, 0, 0, 0};
    case 1: return CvtJob{p.in[5] + (size_t)l * DFF * DM, nullptr, nullptr, W + W_DN1, 2816, 1024, DM, 0, 1024, 0, 0};
    case 2: return CvtJob{win, nullptr, nm, W + W_INP, 1024, 2304, DIN, 0, 2080, 512, 768};
    case 3: return CvtJob{win + 2080, win + 2080 + 1024, nm, W + W_ING, 1024, 2048, DIN, 1, 0, 0, 0};
    case 4: return CvtJob{wglu, wglu + 1024, nullptr, W + W_GLU, 512, 2048, 2048, 1, 0, 0, 0};
    case 5: return CvtJob{p.in[25] + (size_t)l * 512 * DM, nullptr, nullptr, W + W_O, 512, 1024, DM, 0, 1024, 0, 0};
    case 6: return CvtJob{p.in[26] + (size_t)l * DM * DM, nullptr, nullptr, W + W_OUT, 1024, 1024, DM, 0, 1024, 0, 0};
    case 7: return CvtJob{p.in[28] + (size_t)l * DM * DFF, p.in[29] + (size_t)l * DM * DFF, n2, W + W_UP2, 1024, 5632, DFF, 1, 0, 0, 0};
    default: return CvtJob{p.in[30] + (size_t)l * DFF * DM, nullptr, nullptr, W + W_DN2, 2816, 1024, DM, 0, 1024, 0, 0};
    }
}

__device__ __forceinline__ void s5_gen(LAS unsigned char* lds, const Params& p, int l, int g, bf16_t* B1, bf16_t* B2, float* lamtab, int part) {
    const int tid = opaque_tid();
    LAS f32x2* P = (LAS f32x2*)lds;
    LAS f32x2* BB = P + 2 * 17 * 64;
    LAS f32x2* CC = BB + 2 * 64 * 16;
    LAS f32x2* F = CC + 16 * 64;
    LAS float* KT = (LAS float*)(F + 128);
    const float* a_re0 = p.in[8] + (size_t)(l * 32 + g) * 64; const float* a_re1 = p.in[11] + (size_t)(l * 32 + g) * 64;
    const float* a_im0 = p.in[9] + (size_t)(l * 32 + g) * 64; const float* a_im1 = p.in[12] + (size_t)(l * 32 + g) * 64;
    const float ldt0 = p.in[10][l * 32 + g], ldt1 = p.in[13][l * 32 + g];
    const float* b_re = p.in[14] + (size_t)(l * 32 + g) * 1024; const float* b_im = p.in[15] + (size_t)(l * 32 + g) * 1024;
    const float* c_re = p.in[16] + (size_t)(l * 32 + g) * 1024; const float* c_im = p.in[17] + (size_t)(l * 32 + g) * 1024;
    const float* dd = p.in[18] + (size_t)l * 512 + g * 16;
    __syncthreads();
    for (int e = tid; e < 2 * 17 * 64; e += NTHR) {
        const int dir = e / (17 * 64), n = (e / 64) % 17, pp = e & 63;
        const float dt = expf(dir ? ldt1 : ldt0); const float ar = (dir ? a_re1 : a_re0)[pp], ai = (dir ? a_im1 : a_im0)[pp];
        const float mag = expf(ar * dt * (float)n), ang = ai * dt * (float)n;
        P[e] = (f32x2){mag * cosf(ang), mag * sinf(ang)};
    }
    if (tid < 128) {
        const int dir = tid >> 6, pp = tid & 63;
        const float dt = expf(dir ? ldt1 : ldt0); const float ar = (dir ? a_re1 : a_re0)[pp], ai = (dir ? a_im1 : a_im0)[pp];
        const float mag = expf(ar * dt); const float lr = mag * cosf(ai * dt), li = mag * sinf(ai * dt);
        const float den = ar * ar + ai * ai; const float ir = ar / den, ii = -ai / den;
        const float xr = lr - 1.f, xi = li;
        F[tid] = (f32x2){xr * ir - xi * ii, xr * ii + xi * ir};
        const float m16 = expf(ar * dt * 16.f), a16 = ai * dt * 16.f;
        if (part != 1) *(f32x2*)(lamtab + ((size_t)(g * 2 + dir) * 64 + pp) * 2) = (f32x2){m16 * cosf(a16), m16 * sinf(a16)};
    }
    for (int e = tid; e < 1024; e += NTHR) { const int i = e >> 6, pp = e & 63; CC[e] = (f32x2){c_re[i * 64 + pp], c_im[i * 64 + pp]}; }
    __syncthreads();
    for (int e = tid; e < 2048; e += NTHR) {
        const int dir = e >> 10, pj = e & 1023, pp = pj >> 4; const f32x2 f = F[dir * 64 + pp]; const float br = b_re[pj], bi = b_im[pj];
        BB[e] = (f32x2){f.x * br - f.y * bi, f.x * bi + f.y * br};
    }
    __syncthreads();
    if (part != 0) {
        const int dir = tid >> 8, n = (tid >> 4) & 15, i = tid & 15;
        float sj[16];
#pragma unroll
        for (int j = 0; j < 16; ++j) sj[j] = 0.f;
        for (int pp = 0; pp < 64; ++pp) {
            const f32x2 cv = CC[i * 64 + pp], pv = P[(dir * 17 + n) * 64 + pp];
            const float xr = cv.x * pv.x - cv.y * pv.y, xi = cv.x * pv.y + cv.y * pv.x;
#pragma unroll
            for (int j = 0; j < 16; ++j) { const f32x2 bv = BB[(dir * 64 + pp) * 16 + j]; sj[j] += xr * bv.x - xi * bv.y; }
        }
#pragma unroll
        for (int j = 0; j < 16; ++j) KT[(((dir * 16 + n) * 16 + i) << 4) + j] = sj[j];
    }
    __syncthreads();
    if (part != 1) for (int e = tid; e < 256 * 32; e += NTHR) {
        const int n = e >> 5, k0 = (e & 31) * 8; const int dir = n >> 7, reim = (n >> 6) & 1, pp = n & 63; const int s = k0 >> 4, j0 = k0 & 15;
        const f32x2 pv = P[(dir * 17 + (dir == 0 ? 15 - s : s)) * 64 + pp]; float o[8];
#pragma unroll
        for (int jj = 0; jj < 8; ++jj) { const f32x2 bv = BB[(dir * 64 + pp) * 16 + j0 + jj]; o[jj] = reim == 0 ? pv.x * bv.x - pv.y * bv.y : pv.x * bv.y + pv.y * bv.x; }
        u32x4 w; w.x = pk2(o[0], o[1]); w.y = pk2(o[2], o[3]); w.z = pk2(o[4], o[5]); w.w = pk2(o[6], o[7]);
        *(u32x4*)(B1 + (size_t)n * 256 + k0) = w;
    }
    for (int e = tid; e < 256 * 64; e += NTHR) {
        const int n = e >> 6, k0 = (e & 63) * 8; const int t = n >> 4, i = n & 15; float o[8];
        if (part == 0 && k0 < 256) continue;
        if (part == 1 && k0 >= 256) continue;
        if (k0 < 256) {
            const int s = k0 >> 4, j0 = k0 & 15;
#pragma unroll
            for (int jj = 0; jj < 8; ++jj) {
                const int j = j0 + jj; float v = 0.f;
                if (t >= s) v += KT[((0 * 16) + (t - s)) * 256 + i * 16 + j];
                if (s >= t) v += KT[((1 * 16) + (s - t)) * 256 + i * 16 + j];
                if (s == t && i == j) v += dd[i];
                o[jj] = v;
            }
        } else {
            const int kk = k0 - 256; const int dir = kk >> 7, reim = (kk >> 6) & 1, p0 = kk & 63; const int pw = dir == 0 ? t + 1 : 16 - t;
#pragma unroll
            for (int jj = 0; jj < 8; ++jj) {
                const f32x2 cv = CC[i * 64 + p0 + jj], pv = P[(dir * 17 + pw) * 64 + p0 + jj];
                o[jj] = reim == 0 ? (cv.x * pv.x - cv.y * pv.y) : -(cv.x * pv.y + cv.y * pv.x);
            }
        }
        u32x4 w; w.x = pk2(o[0], o[1]); w.y = pk2(o[2], o[3]); w.z = pk2(o[4], o[5]); w.w = pk2(o[6], o[7]);
        *(u32x4*)(B2 + (size_t)n * 512 + k0) = w;
    }
    __syncthreads();
}

constexpr int BST = 65;
constexpr int GL_BF = 0, GL_BB = 16640, GL_X = 33280;
__device__ __forceinline__ int gla_row0(int b, int n) { return n == 0 ? TR + 16 * b : b * 16384 + 64 * (n - 1); }
__device__ __forceinline__ void lds_barrier() { asm volatile("s_waitcnt lgkmcnt(0)" ::: "memory"); __builtin_amdgcn_s_barrier(); asm volatile("" ::: "memory"); }
struct GlaIn { f32x4 z; float w20, w21, w22, w23; float bi; u32x4 k; u32x4 v0, v1; };
struct GlaIn3 { u32x4 q; u32x4 h0, h1, h2, h3; };
__device__ __forceinline__ void gla_task(int task, int& bh, int& hh, int& n, int& row0, int& ntok) {
    n = task % GCH; bh = task / GCH; hh = bh & 3; const int b = bh >> 2; row0 = gla_row0(b, n); ntok = n == 0 ? 16 : 64;
}
template <bool G3>
__device__ __forceinline__ void gla_load(const Params& p, int l, int task, int tid, const float* zbuf, const bf16_t* qbuf, const bf16_t* kbuf, const bf16_t* vbuf, const bf16_t* gs, GlaIn& in, GlaIn3& in3) {
    int bh, hh, n, row0, ntok; gla_task(task, bh, hh, n, row0, ntok);
    const int t = tid >> 3; const bool tv = t < ntok; const u32x4 z4 = (u32x4){0u, 0u, 0u, 0u};
    in.z = tv ? *(const f32x4*)(zbuf + (size_t)(row0 + t) * 32 + (tid & 7) * 4) : (f32x4){0.f, 0.f, 0.f, 0.f};
    { float wv[4];
#pragma unroll
    for (int i = 0; i < 4; ++i) { const int e = tid + NTHR * i; const int dir = e >> 10, r = (e >> 6) & 15, d = e & 63; wv[i] = (dir ? p.in[22] : p.in[20])[(size_t)l * 16 * 256 + r * 256 + hh * 64 + d]; }
    in.w20 = wv[0]; in.w21 = wv[1]; in.w22 = wv[2]; in.w23 = wv[3]; }
    in.bi = 0.f; if (tid < 128) { const int dir = tid >> 6, d = tid & 63; in.bi = (dir ? p.in[23] : p.in[21])[l * 256 + hh * 64 + d]; }
    const int d0 = (tid & 7) * 8, v0 = (tid & 7) * 16;
    in.k = tv ? *(const u32x4*)(kbuf + (size_t)(row0 + t) * 256 + hh * 64 + d0) : z4;
    in.v0 = tv ? *(const u32x4*)(vbuf + (size_t)(row0 + t) * 512 + hh * 128 + v0) : z4;
    in.v1 = tv ? *(const u32x4*)(vbuf + (size_t)(row0 + t) * 512 + hh * 128 + v0 + 8) : z4;
    if (G3) {
        in3.q = tv ? *(const u32x4*)(qbuf + (size_t)(row0 + t) * 256 + hh * 64 + d0) : z4;
        const int vr = tid >> 2, dq = (tid & 3) * 16;
        const bf16_t* s0 = gs + ((size_t)(bh * 2 + 0) * GCH + n) * 8192 + vr * 64 + dq; const bf16_t* s1 = gs + ((size_t)(bh * 2 + 1) * GCH + n) * 8192 + vr * 64 + dq;
        in3.h0 = *(const u32x4*)s0; in3.h1 = *(const u32x4*)(s0 + 8); in3.h2 = *(const u32x4*)s1; in3.h3 = *(const u32x4*)(s1 + 8);
    }
}
__device__ __forceinline__ void gla_prep(LAS unsigned char* lds, const GlaIn& in, int tid, int ntok) {
    LAS float* BF = (LAS float*)(lds + GL_BF); LAS float* BBk = (LAS float*)(lds + GL_BB);
    LAS float* Z = (LAS float*)(lds + GL_X); LAS float* W2 = Z + 2048; LAS float* BI = W2 + 2048; LAS float* TOT = BI + 128;
    *(LAS f32x4*)(Z + (tid >> 3) * 32 + (tid & 7) * 4) = in.z;
    W2[tid] = in.w20; W2[tid + NTHR] = in.w21; W2[tid + 2 * NTHR] = in.w22; W2[tid + 3 * NTHR] = in.w23;
    if (tid < 128) BI[tid] = in.bi;
    lds_barrier();
    const int dir = tid >> 8, tb = (tid >> 6) & 3, d = tid & 63;
    LAS float* BX = dir ? BBk : BF;
    {
        float w[16];
#pragma unroll
        for (int r = 0; r < 16; ++r) w[r] = W2[(dir * 16 + r) * 64 + d];
        const float bias = BI[dir * 64 + d];
        float pre = 0.f;
#pragma unroll
        for (int j = 0; j < 16; ++j) {
            const int t = dir ? 16 * tb + 15 - j : 16 * tb + j;
            float x = bias;
#pragma unroll
            for (int r4 = 0; r4 < 4; ++r4) { const f32x4 zv = *(const LAS f32x4*)(Z + t * 32 + dir * 16 + r4 * 4); x += zv[0] * w[r4 * 4] + zv[1] * w[r4 * 4 + 1] + zv[2] * w[r4 * 4 + 2] + zv[3] * w[r4 * 4 + 3]; }
            const float gg = t < ntok ? logsig(x) * (1.f / 16.f) : 0.f;
            pre += gg; BX[t * BST + d] = pre;
        }
        TOT[(dir * 4 + tb) * 64 + d] = pre;
    }
    lds_barrier();
    {
        float off = 0.f;
#pragma unroll
        for (int t2 = 0; t2 < 4; ++t2) { const float tv = TOT[(dir * 4 + t2) * 64 + d]; if (dir ? (t2 > tb) : (t2 < tb)) off += tv; }
#pragma unroll
        for (int j = 0; j < 16; ++j) BX[(16 * tb + j) * BST + d] += off;
    }
    lds_barrier();
}

__device__ __forceinline__ void gla_g1(LAS unsigned char* lds, const Params& p, int l, const bf16_t* kbuf, const bf16_t* vbuf, const float* zbuf, bf16_t* gs, float* dec, int G, int c) {
    const int tid = opaque_tid(), wid = tid >> 6, lane = tid & 63, fr = lane & 15, fq = lane >> 4;
    LAS float* BF = (LAS float*)(lds + GL_BF); LAS float* BBk = (LAS float*)(lds + GL_BB);
    LAS bf16_t* KF = (LAS bf16_t*)(lds + GL_X); LAS bf16_t* KB = KF + 64 * 72; LAS bf16_t* VT = KB + 64 * 72;
    GlaIn cur{}; GlaIn3 dum{};
    if (c < 8 * GCH) gla_load<false>(p, l, c, tid, zbuf, nullptr, kbuf, vbuf, nullptr, cur, dum);
    for (int task = c; task < 8 * GCH; task += G) {
        int bh, hh, n, row0, ntok; gla_task(task, bh, hh, n, row0, ntok);
        GlaIn nxt{};
        if (task + G < 8 * GCH) gla_load<false>(p, l, task + G, tid, zbuf, nullptr, kbuf, vbuf, nullptr, nxt, dum);
        gla_prep(lds, cur, tid, ntok);
        {
            const int t = tid >> 3, d0 = (tid & 7) * 8;
            const unsigned kw[4] = {cur.k.x, cur.k.y, cur.k.z, cur.k.w};
#pragma unroll
            for (int i = 0; i < 8; ++i) {
                const int d = d0 + i; const float kk = (i & 1) ? hi16(kw[i >> 1]) : lo16(kw[i >> 1]);
                const int tc = t ^ (((d >> 3) & 7) << 3);
                KF[d * 72 + tc] = f2bf(kk * __expf(BF[63 * BST + d] - BF[t * BST + d]));
                KB[d * 72 + tc] = f2bf(kk * __expf(BBk[0 * BST + d] - BBk[t * BST + d]));
            }
            const int v0 = (tid & 7) * 16;
#pragma unroll
            for (int hv = 0; hv < 2; ++hv) {
                const u32x4 vv = hv ? cur.v1 : cur.v0;
                const unsigned vw[4] = {vv.x, vv.y, vv.z, vv.w};
#pragma unroll
                for (int i = 0; i < 8; ++i) { const int vr_ = v0 + hv * 8 + i; VT[vr_ * 72 + (t ^ (((vr_ >> 4) & 7) << 3))] = (bf16_t)((i & 1) ? (vw[i >> 1] >> 16) : (vw[i >> 1] & 0xffffu)); }
            }
        }
        if (tid < 128) { const int dir = tid >> 6, d = tid & 63; dec[((size_t)(bh * 2 + dir) * GCH + n) * 64 + d] = __expf(dir ? BBk[d] : BF[63 * BST + d]); }
        lds_barrier();
        {
            const int dir = wid >> 2, dt = wid & 3; LAS bf16_t* KS = dir ? KB : KF;
            const int sa = (dt * 2 + (fr >> 3)) & 7;
            const bf16x8 a0 = *(const LAS bf16x8*)(KS + (dt * 16 + fr) * 72 + ((fq ^ sa) << 3)), a1 = *(const LAS bf16x8*)(KS + (dt * 16 + fr) * 72 + (((4 + fq) ^ sa) << 3));
            bf16_t* dst = gs + ((size_t)(bh * 2 + dir) * GCH + n) * 8192;
#pragma unroll
            for (int vt = 0; vt < 8; ++vt) {
                const bf16x8 b0 = *(const LAS bf16x8*)(VT + (vt * 16 + fr) * 72 + ((fq ^ vt) << 3)), b1 = *(const LAS bf16x8*)(VT + (vt * 16 + fr) * 72 + (((4 + fq) ^ vt) << 3));
                f32x4 a = (f32x4){0.f, 0.f, 0.f, 0.f};
                a = __builtin_amdgcn_mfma_f32_16x16x32_bf16(a0, b0, a, 0, 0, 0);
                a = __builtin_amdgcn_mfma_f32_16x16x32_bf16(a1, b1, a, 0, 0, 0);
                u32x2 w; w.x = pk2(a[0], a[1]); w.y = pk2(a[2], a[3]);
                *(u32x2*)(dst + (size_t)(vt * 16 + fr) * 64 + dt * 16 + fq * 4) = w;
            }
        }
        lds_barrier();
        cur = nxt;
    }
    __syncthreads();
}

__device__ __forceinline__ void gla_g2(LAS unsigned char* lds, bf16_t* gs, const float* dec, int G, int c) {
    constexpr int CB = 56;
    const int tid = opaque_tid();
    LAS float* DL = (LAS float*)lds;
    LAS bf16_t* SL = (LAS bf16_t*)(lds + 66048);
    static_assert(66048 + CB * 1024 <= LDS_BYTES, "G2 LDS");
    for (int g0 = c * NTHR; g0 < 16 * 8192; g0 += G * NTHR) {
        const int seq = g0 >> 13, e0 = g0 & 8191, d = (e0 + tid) & 63, dir = seq & 1;
        __syncthreads();
        {
            f32x4 dv[9]; const float* dsrc = dec + (size_t)seq * GCH * 64;
#pragma unroll
            for (int k = 0; k < 9; ++k) { const int idx = tid + k * NTHR; dv[k] = idx < GCH * 16 ? *(const f32x4*)(dsrc + idx * 4) : (f32x4){0.f, 0.f, 0.f, 0.f}; }
#pragma unroll
            for (int k = 0; k < 9; ++k) { const int idx = tid + k * NTHR; if (idx < GCH * 16) *(LAS f32x4*)(DL + idx * 4) = dv[k]; }
        }
        bf16_t* base = gs + (size_t)seq * GCH * 8192 + e0;
        float st = 0.f;
        for (int n0 = 0; n0 < GCH; n0 += CB) {
            const int nb = (GCH - n0) < CB ? (GCH - n0) : CB;
            __syncthreads();
            {
                u32x4 sv[7];
#pragma unroll
                for (int k = 0; k < 7; ++k) { const int i = tid + k * NTHR; const int r = i >> 6, pc = i & 63; const int n = n0 + r; const int nn = dir ? GCH - 1 - n : n;
                    sv[k] = i < nb * 64 ? *(const u32x4*)(base + (size_t)nn * 8192 + pc * 8) : (u32x4){0u, 0u, 0u, 0u}; }
#pragma unroll
                for (int k = 0; k < 7; ++k) { const int i = tid + k * NTHR; const int r = i >> 6, pc = i & 63; if (i < nb * 64) *(LAS u32x4*)(SL + r * 512 + pc * 8) = sv[k]; }
            }
            __syncthreads();
            for (int r = 0; r < nb; ++r) { const int n = n0 + r; const int nn = dir ? GCH - 1 - n : n;
                const float sv = bf2f(SL[r * 512 + tid]); SL[r * 512 + tid] = f2bf(st); st = DL[nn * 64 + d] * st + sv; }
            __syncthreads();
            for (int i = tid; i < nb * 64; i += NTHR) { const int r = i >> 6, pc = i & 63; const int n = n0 + r; const int nn = dir ? GCH - 1 - n : n;
                *(u32x4*)(base + (size_t)nn * 8192 + pc * 8) = *(const LAS u32x4*)(SL + r * 512 + pc * 8); }
        }
    }
    __syncthreads();
}

constexpr int GL_A1 = GL_X + 18432, GL_B1 = GL_A1 + 25600, GL_RS = GL_B1 + 51200;
static_assert(GL_RS + 512 <= LDS_BYTES, "G3 LDS");
__device__ __forceinline__ void gla_g3(LAS unsigned char* lds, const Params& p, int l, const bf16_t* qbuf, const bf16_t* kbuf, const bf16_t* vbuf, const bf16_t* rbuf, const float* zbuf,
                       const bf16_t* gs, bf16_t* obuf, int G, int c) {
    const int tid = opaque_tid(), wid = tid >> 6, lane = tid & 63, fr = lane & 15, fq = lane >> 4;
    LAS float* BF = (LAS float*)(lds + GL_BF); LAS float* BBk = (LAS float*)(lds + GL_BB);
    LAS bf16_t* KDF = (LAS bf16_t*)(lds + GL_X); LAS bf16_t* KDB = KDF + 64 * 72;
    LAS bf16_t* A1 = (LAS bf16_t*)(lds + GL_A1); LAS bf16_t* B1 = (LAS bf16_t*)(lds + GL_B1); LAS float* RS = (LAS float*)(lds + GL_RS);
    const float* gnorm = p.in[24] + (size_t)l * 512;
    GlaIn cur{}; GlaIn3 cur3{};
    if (c < 8 * GCH) gla_load<true>(p, l, c, tid, zbuf, qbuf, kbuf, vbuf, gs, cur, cur3);
    for (int task = c; task < 8 * GCH; task += G) {
        int bh, hh, n, row0, ntok; gla_task(task, bh, hh, n, row0, ntok);
        GlaIn nxt{}; GlaIn3 nxt3{};
        if (task + G < 8 * GCH) gla_load<true>(p, l, task + G, tid, zbuf, qbuf, kbuf, vbuf, gs, nxt, nxt3);
        gla_prep(lds, cur, tid, ntok);
        {
            const int t = tid >> 3, d0 = (tid & 7) * 8;
            const unsigned qw[4] = {cur3.q.x, cur3.q.y, cur3.q.z, cur3.q.w}, kw[4] = {cur.k.x, cur.k.y, cur.k.z, cur.k.w};
            unsigned oqf[4], oqb[4], okf[4], okb[4];
#pragma unroll
            for (int i = 0; i < 4; ++i) {
                const int d = d0 + 2 * i; const float bf0 = BF[t * BST + d], bf1 = BF[t * BST + d + 1], bb0 = BBk[t * BST + d], bb1 = BBk[t * BST + d + 1];
                const float q0 = lo16(qw[i]), q1 = hi16(qw[i]), k0 = lo16(kw[i]), k1 = hi16(kw[i]);
                oqf[i] = pk2(q0 * __expf(bf0), q1 * __expf(bf1)); oqb[i] = pk2(q0 * __expf(bb0), q1 * __expf(bb1));
                okf[i] = pk2(k0 * __expf(-bf0), k1 * __expf(-bf1)); okb[i] = pk2(k0 * __expf(-bb0), k1 * __expf(-bb1));
            }
            *(LAS u32x4*)(A1 + t * 200 + 64 + d0) = (u32x4){oqf[0], oqf[1], oqf[2], oqf[3]};
            *(LAS u32x4*)(A1 + t * 200 + 128 + d0) = (u32x4){oqb[0], oqb[1], oqb[2], oqb[3]};
            *(LAS u32x4*)(KDF + t * 72 + d0) = (u32x4){okf[0], okf[1], okf[2], okf[3]};
            *(LAS u32x4*)(KDB + t * 72 + d0) = (u32x4){okb[0], okb[1], okb[2], okb[3]};
            const int v0 = (tid & 7) * 16;
#pragma unroll
            for (int hv = 0; hv < 2; ++hv) {
                const u32x4 vv = hv ? cur.v1 : cur.v0;
                const unsigned vw[4] = {vv.x, vv.y, vv.z, vv.w};
#pragma unroll
                for (int i = 0; i < 8; ++i) { const int vr_ = v0 + hv * 8 + i; B1[vr_ * 200 + (t ^ (((vr_ >> 4) & 7) << 3))] = (bf16_t)((i & 1) ? (vw[i >> 1] >> 16) : (vw[i >> 1] & 0xffffu)); }
            }
            const int vr = tid >> 2, dq = (tid & 3) * 16;
#pragma unroll
            for (int dir = 0; dir < 2; ++dir) {
#ifdef DBG_NO_INTER
                const u32x4 h0 = (u32x4){0u,0u,0u,0u}, h1 = h0;
#else
                const u32x4 h0 = dir ? cur3.h2 : cur3.h0, h1 = dir ? cur3.h3 : cur3.h1;
#endif
                *(LAS u32x4*)(B1 + vr * 200 + 64 + dir * 64 + dq) = h0; *(LAS u32x4*)(B1 + vr * 200 + 64 + dir * 64 + dq + 8) = h1;
            }
        }
        lds_barrier();
        {
            const int ti = wid >> 1;
            const bf16x8 qf0 = *(const LAS bf16x8*)(A1 + (ti * 16 + fr) * 200 + 64 + fq * 8), qf1 = *(const LAS bf16x8*)(A1 + (ti * 16 + fr) * 200 + 96 + fq * 8);
            const bf16x8 qb0 = *(const LAS bf16x8*)(A1 + (ti * 16 + fr) * 200 + 128 + fq * 8), qb1 = *(const LAS bf16x8*)(A1 + (ti * 16 + fr) * 200 + 160 + fq * 8);
#pragma unroll
            for (int tj2 = 0; tj2 < 2; ++tj2) {
                const int tj = (wid & 1) * 2 + tj2;
                const bf16x8 kf0 = *(const LAS bf16x8*)(KDF + (tj * 16 + fr) * 72 + fq * 8), kf1 = *(const LAS bf16x8*)(KDF + (tj * 16 + fr) * 72 + 32 + fq * 8);
                const bf16x8 kb0 = *(const LAS bf16x8*)(KDB + (tj * 16 + fr) * 72 + fq * 8), kb1 = *(const LAS bf16x8*)(KDB + (tj * 16 + fr) * 72 + 32 + fq * 8);
                f32x4 sf = (f32x4){0.f, 0.f, 0.f, 0.f}, sb = sf;
                sf = __builtin_amdgcn_mfma_f32_16x16x32_bf16(kf0, qf0, sf, 0, 0, 0); sf = __builtin_amdgcn_mfma_f32_16x16x32_bf16(kf1, qf1, sf, 0, 0, 0);
                sb = __builtin_amdgcn_mfma_f32_16x16x32_bf16(kb0, qb0, sb, 0, 0, 0); sb = __builtin_amdgcn_mfma_f32_16x16x32_bf16(kb1, qb1, sb, 0, 0, 0);
                const int i = ti * 16 + fr, j0 = tj * 16 + fq * 4; float pv[4];
#pragma unroll
                for (int jj = 0; jj < 4; ++jj) pv[jj] = (j0 + jj <= i) ? sf[jj] : sb[jj];
                *(LAS u32x2*)(A1 + i * 200 + j0) = (u32x2){pk2(pv[0], pv[1]), pk2(pv[2], pv[3])};
            }
        }
        lds_barrier();
        {
            const int it = wid & 3, vh = wid >> 2;
            bf16x8 bfr[6];
#pragma unroll
            for (int ks = 0; ks < 6; ++ks) bfr[ks] = *(const LAS bf16x8*)(A1 + (it * 16 + fr) * 200 + ks * 32 + fq * 8);
            f32x4 o[4]; float ss = 0.f;
#pragma unroll
            for (int vt = 0; vt < 4; ++vt) {
                f32x4 a = (f32x4){0.f, 0.f, 0.f, 0.f};
#pragma unroll
                for (int ks = 0; ks < 6; ++ks) { const int cb = ks < 2 ? (((ks * 4 + fq) ^ ((vh * 4 + vt) & 7)) << 3) : ks * 32 + fq * 8;
                    const bf16x8 af = *(const LAS bf16x8*)(B1 + (vh * 64 + vt * 16 + fr) * 200 + cb); a = __builtin_amdgcn_mfma_f32_16x16x32_bf16(af, bfr[ks], a, 0, 0, 0); }
                o[vt] = a; ss += (a[0] * a[0] + a[1] * a[1]) + (a[2] * a[2] + a[3] * a[3]);
            }
            ss += __shfl_xor(ss, 16); ss += __shfl_xor(ss, 32);
            if (fq == 0) RS[vh * 64 + it * 16 + fr] = ss;
            lds_barrier();
            const int i = it * 16 + fr; const float tot = RS[i] + RS[64 + i]; const float rn = rsqrtf(tot * (1.f / 128.f) + 1e-6f);
            if (i < ntok) {
                const int row = row0 + i;
#pragma unroll
                for (int vt = 0; vt < 4; ++vt) {
                    const int vcol = hh * 128 + vh * 64 + vt * 16 + fq * 4;
                    const f32x4 gn = *(const f32x4*)(gnorm + vcol); const u32x2 rv = *(const u32x2*)(rbuf + (size_t)row * 512 + vcol);
                    const float r0 = lo16(rv.x), r1 = hi16(rv.x), r2 = lo16(rv.y), r3 = hi16(rv.y);
                    u32x2 w; w.x = pk2(o[vt][0] * rn * gn[0] * siluf_(r0), o[vt][1] * rn * gn[1] * siluf_(r1)); w.y = pk2(o[vt][2] * rn * gn[2] * siluf_(r2), o[vt][3] * rn * gn[3] * siluf_(r3));
                    *(u32x2*)(obuf + (size_t)row * 512 + vcol) = w;
                }
            }
        }
        lds_barrier();
        cur = nxt; cur3 = nxt3;
    }
    __syncthreads();
}

__device__ __forceinline__ void s5_scan(LAS unsigned char* lds, const float* S, bf16_t* ubuf, const float* lamtab, int G, int c) {
    const int tid = opaque_tid(); const int pl = tid & 31, sg = tid >> 5;
    LAS f32x2* E = (LAS f32x2*)lds; LAS f32x2* PW = E + 512;
    for (int task = c; task < 256; task += G) {
        const int combo = task >> 1, pp = (task & 1) * 32 + pl;
        const int dir = combo & 1, g = (combo >> 1) & 31, b = combo >> 6;
        const f32x2 lam = *(const f32x2*)(lamtab + ((size_t)(g * 2 + dir) * 64 + pp) * 2);
        const float* sb = S + ((size_t)g * MCH + b * NCH) * 256 + dir * 128 + pp;
        bf16_t* hb = ubuf + ((size_t)g * MCH + b * NCH) * 512 + 256 + dir * 128 + pp;
        const int c_lo = sg * 64, c_hi = sg == 15 ? NCH : c_lo + 64;
        float lr = 0.f, li = 0.f, pr = 1.f, pi = 0.f;
        for (int c0 = c_lo; c0 < c_hi; c0 += 16) {
            float sr[16], si[16];
#pragma unroll
            for (int i = 0; i < 16; ++i) { const int cc = c0 + i; const int ch = dir ? NCH - 1 - cc : cc; if (cc < c_hi) { sr[i] = sb[(size_t)ch * 256]; si[i] = sb[(size_t)ch * 256 + 64]; } else { sr[i] = 0.f; si[i] = 0.f; } }
#pragma unroll
            for (int i = 0; i < 16; ++i) { const int cc = c0 + i;
                if (cc < c_hi) { const float nr = lam.x * lr - lam.y * li + sr[i], ni = lam.x * li + lam.y * lr + si[i]; lr = nr; li = ni;
                                 const float tr = lam.x * pr - lam.y * pi; pi = lam.x * pi + lam.y * pr; pr = tr; } }
        }
        E[sg * 32 + pl] = (f32x2){lr, li}; PW[sg * 32 + pl] = (f32x2){pr, pi};
        __syncthreads();
        float hr = 0.f, hi = 0.f;
        for (int s2 = 0; s2 < sg; ++s2) { const f32x2 e = E[s2 * 32 + pl], w = PW[s2 * 32 + pl]; const float nr = w.x * hr - w.y * hi + e.x, ni = w.x * hi + w.y * hr + e.y; hr = nr; hi = ni; }
        for (int c0 = c_lo; c0 < c_hi; c0 += 16) {
            float sr[16], si[16];
#pragma unroll
            for (int i = 0; i < 16; ++i) { const int cc = c0 + i; const int ch = dir ? NCH - 1 - cc : cc; if (cc < c_hi) { sr[i] = sb[(size_t)ch * 256]; si[i] = sb[(size_t)ch * 256 + 64]; } else { sr[i] = 0.f; si[i] = 0.f; } }
#pragma unroll
            for (int i = 0; i < 16; ++i) { const int cc = c0 + i; const int ch = dir ? NCH - 1 - cc : cc;
                if (cc < c_hi) { hb[(size_t)ch * 512] = f2bf(hr); hb[(size_t)ch * 512 + 64] = f2bf(hi); const float nr = lam.x * hr - lam.y * hi + sr[i], ni = lam.x * hi + lam.y * hr + si[i]; hr = nr; hi = ni; } }
        }
        __syncthreads();
    }
}

enum { GK_UP1 = 0, GK_DN1, GK_PROJ, GK_S5S, GK_S5Y, GK_GLU, GK_WO, GK_GATE, GK_OUTP, GK_UP2, GK_DN2 };
__device__ __forceinline__ pg8::Gemm make_gemm(int kind, unsigned char* ws, int l) {
    bf16_t* W = (bf16_t*)(ws + OFF_W + (size_t)l * W_BYTES); const bf16_t* hb = (const bf16_t*)(ws + OFF_HB); const bf16_t* hid = (const bf16_t*)(ws + OFF_HID); const bf16_t* ubuf = (const bf16_t*)(ws + OFF_UBUF);
    switch (kind) {
    case GK_UP1:  return pg8::Gemm{hb, W + W_UP1, 1024, 1024, 128, 22, 1, 0, 0, 1, 0, 0};
    case GK_DN1:  return pg8::Gemm{hid, W + W_DN1, DFF, DFF, 128, 4, 1, 0, 0, 1, 1, 1};
    case GK_PROJ: return pg8::Gemm{hb, W + W_INP, 1024, 1024, 128, 9, 1, 0, 0, 1, 0, 0};
    case GK_S5S:  return pg8::Gemm{ubuf, W + W_S1, 512, 256, 9, 1, 32, (size_t)MCH * 512, (size_t)256 * 256, 0, 0, 0};
    case GK_S5Y:  return pg8::Gemm{ubuf, W + W_S2, 512, 512, 9, 1, 32, (size_t)MCH * 512, (size_t)256 * 512, 0, 0, 0};
    case GK_GLU:  return pg8::Gemm{(const bf16_t*)(ws + OFF_Y), W + W_GLU, 512, 512, 128, 8, 1, 0, 0, 1, 0, 0};
    case GK_WO:   return pg8::Gemm{(const bf16_t*)(ws + OFF_O), W + W_O, 512, 512, 128, 4, 1, 0, 0, 1, 0, 0};
    case GK_GATE: return pg8::Gemm{hb, W + W_ING, 1024, 1024, 128, 8, 1, 0, 0, 1, 0, 0};
    case GK_OUTP: return pg8::Gemm{(const bf16_t*)(ws + OFF_SB), W + W_OUT, 1024, 1024, 128, 4, 1, 0, 0, 1, 0, 0};
    case GK_UP2:  return pg8::Gemm{hb, W + W_UP2, 1024, 1024, 128, 22, 1, 0, 0, 1, 0, 0};
    default:      return pg8::Gemm{hid, W + W_DN2, DFF, DFF, 128, 4, 1, 0, 0, 1, 1, 1};
    }
}
struct EpiSwitch {
    int kind; unsigned char* ws; float* out;
    __device__ __forceinline__ void operator()(const Acc& acc, const Unit& u, int wr, int wc, int fr, int fq) const {
        float* rowpart = (float*)(ws + OFF_ROWPART); bf16_t* hb = (bf16_t*)(ws + OFF_HB); float* metah = (float*)(ws + OFF_METAH);
#ifdef DBG_DUP_ALLGEMM
        if (kind >= 100) { if (u.pg == 0 && u.pn < 4) { EpiBf E{(bf16_t*)(ws + OFF_DUMMY), T}; E(acc, u, wr, wc, fr, fq); } return; }
#endif
        switch (kind) {
        case GK_UP1: case GK_UP2: { EpiUp E{rowpart, (bf16_t*)(ws + OFF_HID), T}; E(acc, u, wr, wc, fr, fq); } break;
        case GK_DN1: case GK_DN2: case GK_OUTP: { EpiRes E{out, metah, hb, rowpart, kind == GK_OUTP ? 1.0f : 0.5f, T}; E(acc, u, wr, wc, fr, fq); } break;
        case GK_PROJ: { EpiProj E{rowpart, (bf16_t*)(ws + OFF_UBUF), (bf16_t*)(ws + OFF_Q), (bf16_t*)(ws + OFF_K), (bf16_t*)(ws + OFF_V), (bf16_t*)(ws + OFF_R), (float*)(ws + OFF_Z), T}; E(acc, u, wr, wc, fr, fq); } break;
        case GK_S5S: { EpiS5S E{(float*)(ws + OFF_S5S)}; E(acc, u, wr, wc, fr, fq); } break;
        case GK_S5Y: { EpiS5Y E{(bf16_t*)(ws + OFF_Y)}; E(acc, u, wr, wc, fr, fq); } break;
        case GK_GLU: { EpiGlu E{(bf16_t*)(ws + OFF_SB), T}; E(acc, u, wr, wc, fr, fq); } break;
        case GK_WO: { EpiBf E{(bf16_t*)(ws + OFF_GB), T}; E(acc, u, wr, wc, fr, fq); } break;
        default: { EpiGate E{rowpart, (bf16_t*)(ws + OFF_SB), (const bf16_t*)(ws + OFF_GB), T}; E(acc, u, wr, wc, fr, fq); } break;
        }
    }
};

struct BarCtx { unsigned* bar; unsigned epoch, xcc, nx, nxcd; };
__device__ __forceinline__ void grid_barrier(BarCtx& b) {
    asm volatile("s_waitcnt vmcnt(0) lgkmcnt(0)" ::: "memory");
    __syncthreads();
    b.epoch += 1u;
    if (threadIdx.x < 64) {
        unsigned old = 0u;
        if (threadIdx.x == 0) old = __hip_atomic_fetch_add(b.bar + 64 + 16 * b.xcc, 1u, __ATOMIC_RELAXED, __HIP_MEMORY_SCOPE_AGENT);
        old = (unsigned)__builtin_amdgcn_readfirstlane((int)old);
        if (old + 1u == b.epoch * b.nx) {
            __builtin_amdgcn_fence(__ATOMIC_RELEASE, "agent");
            asm volatile("s_waitcnt vmcnt(0)" ::: "memory");
            if (threadIdx.x == 0) __hip_atomic_fetch_add(b.bar, 1u, __ATOMIC_RELAXED, __HIP_MEMORY_SCOPE_AGENT);
        }
        const unsigned target = b.epoch * b.nxcd;
        while ((unsigned)__builtin_amdgcn_readfirstlane((int)__hip_atomic_load(b.bar, __ATOMIC_RELAXED, __HIP_MEMORY_SCOPE_AGENT)) < target) __builtin_amdgcn_s_sleep(1);
        __builtin_amdgcn_fence(__ATOMIC_ACQUIRE, "agent");
        asm volatile("s_waitcnt vmcnt(0)" ::: "memory");
    }
    __syncthreads();
}

__global__ void __launch_bounds__(NTHR, 2) fwd_mega(Params p) {
    extern __shared__ __attribute__((aligned(16))) unsigned char lds_raw[];
    LAS unsigned char* lds = (LAS unsigned char*)lds_raw;
    cg::grid_group grid = cg::this_grid();
    const int G = gridDim.x, c = blockIdx.x;
    unsigned char* ws = p.ws;
    float* out = p.out;
    BarCtx bctx; bctx.bar = (unsigned*)(ws + OFF_BAR); bctx.epoch = 0u;
    bctx.xcc = (unsigned)__builtin_amdgcn_s_getreg((3 << 11) | 20) & 0xFu;
    if (threadIdx.x == 0) __hip_atomic_fetch_add(bctx.bar + 512 + bctx.xcc, 1u, __ATOMIC_RELAXED, __HIP_MEMORY_SCOPE_AGENT);
    grid.sync();
    {
        unsigned nx = 0u, nxcd = 0u;
        for (int x = 0; x < 16; ++x) { const unsigned v = (unsigned)__builtin_amdgcn_readfirstlane((int)__hip_atomic_load(bctx.bar + 512 + x, __ATOMIC_RELAXED, __HIP_MEMORY_SCOPE_AGENT)); if (v) ++nxcd; if ((unsigned)x == bctx.xcc) nx = v; }
        bctx.nx = nx; bctx.nxcd = nxcd;
    }
#if defined(DBG_AMP_P0) || defined(DBG_AMP_FINAL)
    unsigned long long amp_k0 = __builtin_amdgcn_s_memrealtime();
#endif

    {
        const int tid_ = opaque_tid(); const int wid = tid_ >> 6, lane = tid_ & 63;
        bf16_t* hb = (bf16_t*)(ws + OFF_HB); float* rowpart = (float*)(ws + OFF_ROWPART);
        for (int row = c * 8 + wid; row < T; row += G * 8) {
            const float* src = row < TR ? p.in[0] + (size_t)row * DM : p.in[1] + (size_t)((row - TR) & 15) * DM;
            float ss = 0.f;
#pragma unroll
            for (int i = 0; i < 4; ++i) {
                const int col = (i * 64 + lane) * 4; const f32x4 v = *(const f32x4*)(src + col);
                u32x2 w; w.x = pk2(v[0], v[1]); w.y = pk2(v[2], v[3]); *(u32x2*)(hb + (size_t)row * DM + col) = w;
                ss += (v[0] * v[0] + v[1] * v[1]) + (v[2] * v[2] + v[3] * v[3]);
            }
#pragma unroll
            for (int o = 32; o >= 1; o >>= 1) ss += __shfl_xor(ss, o);
            if (lane < 16) rowpart[(size_t)row * 16 + lane] = lane == 0 ? ss : 0.f;
        }
    }

#ifdef DBG_AMP_P0
    if (c == 0) { const unsigned long long t1 = __builtin_amdgcn_s_memrealtime(); const unsigned long long dt = t1 - amp_k0; while (__builtin_amdgcn_s_memrealtime() - t1 < 4ull * dt) __builtin_amdgcn_s_sleep(8); __syncthreads(); }
#endif
    for (int step = 0; step < 24; ++step) {
        const int l = step / 12, s = step % 12;
#ifdef DBG_AMP_STEP
        const unsigned long long amp_t0 = __builtin_amdgcn_s_memrealtime();
#endif
        if (s == 0) {
            if (l == 1) continue;
            PH(0) {
                bf16_t* W = (bf16_t*)(ws + OFF_W);
                if (G > 64) {
                    if (c < 64) { const int g = c >> 1; s5_gen(lds, p, 0, g, W + W_S1 + (size_t)g * 256 * 256, W + W_S2 + (size_t)g * 256 * 512, (float*)(ws + OFF_LAM), c & 1); }
                    else { int rot = 0; for (int job = 0; job < 9; ++job) { const CvtJob j = make_job(p, 0, job); convert_wt(lds, j, G - 64, c - 64, rot); } }
                } else {
                    int rot = 0;
                    for (int job = 0; job < 9; ++job) { const CvtJob j = make_job(p, 0, job); convert_wt(lds, j, G, c, rot); }
                    for (int g = c; g < 32; g += G) s5_gen(lds, p, 0, g, W + W_S1 + (size_t)g * 256 * 256, W + W_S2 + (size_t)g * 256 * 512, (float*)(ws + OFF_LAM), 2);
                }
            }
        }
        int k0 = -1, k1 = -1;
#ifdef DBG_SKIP_LO
        if (s >= DBG_SKIP_LO && s <= DBG_SKIP_HI) { grid_barrier(bctx); continue; }
#endif
        switch (s) {
        case 1: k0 = GK_UP1; break;
        case 2: k0 = GK_DN1; break;
        case 3: k0 = GK_PROJ; break;
        case 4: k0 = GK_S5S; break;
        case 6: k0 = GK_S5Y; break;
        case 7: k0 = GK_GLU; k1 = GK_WO; break;
        case 8: k0 = GK_GATE; break;
        case 9: k0 = GK_OUTP; break;
        case 10: k0 = GK_UP2; break;
        case 11: k0 = GK_DN2; break;
        default: break;
        }
#ifdef DBG_NO_GLA
        if (k1 == GK_WO) k1 = -1;
#endif
#ifdef DBG_NO_S5
        if (k0 == GK_S5S || k0 == GK_S5Y) k0 = -1;
        if (k0 == GK_GLU) { k0 = k1; k1 = -1; }
#endif
#ifdef DBG_DUP_UP
        if (s == 1 || s == 10) k1 = k0;
#endif
#ifdef DBG_DUP_ALLGEMM
        PH(1) { if (k0 >= 0) { const pg8::Gemm g = make_gemm(k0, ws, l); const EpiSwitch E{k0 + 100, ws, out}; pg8::gemm_phase(lds, g, E, G, c); }
                if (k1 >= 0) { const pg8::Gemm g = make_gemm(k1, ws, l); const EpiSwitch E{k1 + 100, ws, out}; pg8::gemm_phase(lds, g, E, G, c); } }
#endif
        PH(1) {
            for (int sub = 0; sub < 2; ++sub) {
                const int kk = sub ? k1 : k0;
                if (kk >= 0) { const pg8::Gemm g = make_gemm(kk % 100, ws, l); const EpiSwitch E{kk, ws, out}; pg8::gemm_phase(lds, g, E, G, sub ? (c + 8) % G : c); }
            }
        }
#ifdef DBG_DUP_GLA
        if (s == 4) { gla_g1(lds, p, l, (const bf16_t*)(ws + OFF_K), (const bf16_t*)(ws + OFF_V), (const float*)(ws + OFF_Z), (bf16_t*)(ws + OFF_GS), (float*)(ws + OFF_DEC), G, (c + 32) % G); }
        if (s == 6) { gla_g3(lds, p, l, (const bf16_t*)(ws + OFF_Q), (const bf16_t*)(ws + OFF_K), (const bf16_t*)(ws + OFF_V), (const bf16_t*)(ws + OFF_R), (const float*)(ws + OFF_Z),
                             (const bf16_t*)(ws + OFF_GS), (bf16_t*)(ws + OFF_O), G, (c + 32) % G); }
#endif
#ifdef DBG_DUP_MISC
        if (s == 0) { int rot = 0; for (int job = 0; job < 9; ++job) { const CvtJob j = make_job(p, l, job); convert_wt(lds, j, G, c, rot); } }
        if (s == 5) { s5_scan(lds, (const float*)(ws + OFF_S5S), (bf16_t*)(ws + OFF_UBUF), (const float*)(ws + OFF_LAM), G, c); }
        grid_barrier(bctx);
#endif
        if (s == 3 && l == 0 && G >= 256 && c >= 128) {
            __syncthreads();
            int rot = 0; for (int job = 0; job < 9; ++job) { const CvtJob j = make_job(p, 1, job); convert_wt(lds, j, 128, c - 128, rot); }
        }
        if (s == 4) { PH(5) gla_g1(lds, p, l, (const bf16_t*)(ws + OFF_K), (const bf16_t*)(ws + OFF_V), (const float*)(ws + OFF_Z), (bf16_t*)(ws + OFF_GS), (float*)(ws + OFF_DEC), G, (c + 32) % G); }
        if (s == 5) {
            PH(6) s5_scan(lds, (const float*)(ws + OFF_S5S), (bf16_t*)(ws + OFF_UBUF), (const float*)(ws + OFF_LAM + (size_t)l * LAM_BYTES), G, c);
            PH(7) gla_g2(lds, (bf16_t*)(ws + OFF_GS), (const float*)(ws + OFF_DEC), G, c);
            if (l == 0) {
                bf16_t* W1 = (bf16_t*)(ws + OFF_W + W_BYTES); float* lam1 = (float*)(ws + OFF_LAM + LAM_BYTES);
                __syncthreads();
                if (G >= 256) {
                    if (c >= 128 && c < 192) { const int g = (c - 128) >> 1; s5_gen(lds, p, 1, g, W1 + W_S1 + (size_t)g * 256 * 256, W1 + W_S2 + (size_t)g * 256 * 512, lam1, c & 1); }
                } else {
                    int rot = 0;
                    for (int job = 0; job < 9; ++job) { const CvtJob j = make_job(p, 1, job); convert_wt(lds, j, G, c, rot); }
                    for (int g = c; g < 32; g += G) s5_gen(lds, p, 1, g, W1 + W_S1 + (size_t)g * 256 * 256, W1 + W_S2 + (size_t)g * 256 * 512, lam1, 2);
                }
            }
        }
        if (s == 6) { PH(9) gla_g3(lds, p, l, (const bf16_t*)(ws + OFF_Q), (const bf16_t*)(ws + OFF_K), (const bf16_t*)(ws + OFF_V), (const bf16_t*)(ws + OFF_R), (const float*)(ws + OFF_Z),
                                   (const bf16_t*)(ws + OFF_GS), (bf16_t*)(ws + OFF_O), G, (c + 32) % G); }
        grid_barrier(bctx);
#ifdef DBG_AMP_STEP
        if (c == 0 && s == DBG_AMP_STEP) {
            const unsigned long long t1 = __builtin_amdgcn_s_memrealtime(); const unsigned long long dt = t1 - amp_t0;
            while (__builtin_amdgcn_s_memrealtime() - t1 < 4ull * dt) __builtin_amdgcn_s_sleep(8);
            __syncthreads();
        }
#endif
    }
#ifdef DBG_AMP_FINAL
    amp_k0 = __builtin_amdgcn_s_memrealtime();
#endif
    {
        const int tid_ = opaque_tid(); const int wid = tid_ >> 6, lane = tid_ & 63;
        const float* gf = p.in[31]; const float* rowpart = (const float*)(ws + OFF_ROWPART); const bf16_t* hbf = (const bf16_t*)(ws + OFF_HB);
        for (int row = c * 8 + wid; row < TR; row += G * 8) {
            float s = lane < 16 ? rowpart[(size_t)row * 16 + lane] : 0.f;
#pragma unroll
            for (int o = 8; o >= 1; o >>= 1) s += __shfl_xor(s, o);
            s = __shfl(s, 0);
            const float rs = rsqrtf(s * (1.f / 1024.f) + 1e-6f);
#pragma unroll
            for (int i = 0; i < 4; ++i) { const int col = (i * 64 + lane) * 4; const u32x2 hv = *(const u32x2*)(hbf + (size_t)row * DM + col); const f32x4 gv = *(const f32x4*)(gf + col);
                f32x4 v; v[0] = lo16(hv.x) * rs * gv[0]; v[1] = hi16(hv.x) * rs * gv[1]; v[2] = lo16(hv.y) * rs * gv[2]; v[3] = hi16(hv.y) * rs * gv[3]; *(f32x4*)(out + (size_t)row * DM + col) = v; }
        }
    }
#ifdef DBG_AMP_FINAL
    { const unsigned long long t1 = __builtin_amdgcn_s_memrealtime(); const unsigned long long dt = t1 - amp_k0; while (__builtin_amdgcn_s_memrealtime() - t1 < 4ull * dt) __builtin_amdgcn_s_sleep(8); }
#endif
}

extern "C" void kernel_launch(void* const* d_in, const int* in_sizes, int n_in, void* d_out, int out_size, void* d_ws, size_t ws_size, hipStream_t stream) {
    static int grid_blocks = 0;
    if (grid_blocks == 0) {
        if (n_in != 32 || ws_size < WS_END || out_size != TR * DM) { fprintf(stderr, "kernel_launch: unexpected shapes / workspace (%d inputs, ws %zu < %zu)\n", n_in, ws_size, (size_t)WS_END); grid_blocks = -1; return; }
        int dev = 0, cus = 0, per_cu = 0;
        hipGetDevice(&dev); hipDeviceGetAttribute(&cus, hipDeviceAttributeMultiprocessorCount, dev);
        hipFuncSetAttribute((const void*)fwd_mega, hipFuncAttributeMaxDynamicSharedMemorySize, LDS_BYTES);
        hipOccupancyMaxActiveBlocksPerMultiprocessor(&per_cu, (const void*)fwd_mega, NTHR, LDS_BYTES);
        if (per_cu < 1) per_cu = 1;
        if (per_cu > 1) per_cu = 1;
        grid_blocks = cus * per_cu;
    }
    if (grid_blocks < 0) return;
    if (hipMemsetAsync((char*)d_ws + OFF_BAR, 0, 4096, stream) != hipSuccess) { fprintf(stderr, "memset failed\n"); return; }
    Params p{};
    for (int i = 0; i < 32; ++i) p.in[i] = (const float*)d_in[i];
    p.out = (float*)d_out; p.ws = (unsigned char*)d_ws;
    void* args[] = {&p};
    hipError_t e = hipLaunchCooperativeKernel((const void*)fwd_mega, dim3(grid_blocks), dim3(NTHR), args, LDS_BYTES, stream);
    if (e != hipSuccess) fprintf(stderr, "cooperative launch failed: %s (grid %d)\n", hipGetErrorString(e), grid_blocks);
}
```

```cpp
#include <hip/hip_runtime.h>
#include <hip/hip_cooperative_groups.h>
#include <cstdio>
namespace cg = cooperative_groups;

#define LAS __attribute__((address_space(3)))
typedef unsigned short bf16_t;
typedef short bf16x8 __attribute__((ext_vector_type(8)));
typedef float f32x4 __attribute__((ext_vector_type(4)));
typedef float f32x2 __attribute__((ext_vector_type(2)));
typedef unsigned u32x4 __attribute__((ext_vector_type(4)));
typedef unsigned u32x2 __attribute__((ext_vector_type(2)));

constexpr int T = 32800, TR = 32768, DM = 1024, DFF = 2816, DIN = 4128;
constexpr int NCH = 1025, MCH = 2050;
constexpr int GCH = 257;
constexpr int NTHR = 512;
constexpr int LDS_BYTES = 131072;

constexpr size_t AL(size_t x) { return (x + 255) & ~size_t(255); }
constexpr size_t SLACK = size_t(2) << 20;
constexpr size_t OFF_HB = 0;
constexpr size_t OFF_METAH = OFF_HB + AL((size_t)T * 1024 * 2) + SLACK;
constexpr size_t OFF_ROWPART = OFF_METAH + 32 * 1024 * 4;
constexpr size_t OFF_LAM = OFF_ROWPART + AL((size_t)T * 16 * 4);
constexpr size_t LAM_BYTES = 32 * 2 * 64 * 2 * 4;
constexpr size_t OFF_W = OFF_LAM + 2 * LAM_BYTES;
constexpr size_t W_UP1 = 0, W_DN1 = W_UP1 + (size_t)5632 * 1024, W_INP = W_DN1 + (size_t)1024 * 2816, W_ING = W_INP + (size_t)2304 * 1024,
                 W_GLU = W_ING + (size_t)2048 * 1024, W_O = W_GLU + (size_t)2048 * 512, W_OUT = W_O + (size_t)1024 * 512,
                 W_UP2 = W_OUT + (size_t)1024 * 1024, W_DN2 = W_UP2 + (size_t)5632 * 1024, W_S1 = W_DN2 + (size_t)1024 * 2816,
                 W_S2 = W_S1 + (size_t)32 * 256 * 256, W_END = W_S2 + (size_t)32 * 256 * 512;
constexpr size_t W_BYTES = AL(W_END * 2);
constexpr size_t OFF_R1 = OFF_W + 2 * W_BYTES;
constexpr size_t R1_SIZE = AL((size_t)T * 2816 * 2) + SLACK;
constexpr size_t OFF_HID = OFF_R1;
constexpr size_t OFF_UBUF = OFF_R1;
constexpr size_t OFF_Q = OFF_UBUF + AL((size_t)32 * MCH * 512 * 2) + SLACK;
constexpr size_t OFF_K = OFF_Q + AL((size_t)T * 256 * 2);
constexpr size_t OFF_V = OFF_K + AL((size_t)T * 256 * 2);
constexpr size_t OFF_R = OFF_V + AL((size_t)T * 512 * 2);
constexpr size_t OFF_Z = OFF_R + AL((size_t)T * 512 * 2);
constexpr size_t OFF_ZEND = OFF_Z + AL((size_t)T * 32 * 4);
static_assert(OFF_ZEND <= OFF_R1 + R1_SIZE, "R1 overflow");
constexpr size_t OFF_SB = OFF_R1;
constexpr size_t OFF_GB = OFF_SB + AL((size_t)T * 1024 * 2) + SLACK;
static_assert(OFF_GB + AL((size_t)T * 1024 * 2) + SLACK <= OFF_R1 + R1_SIZE, "R1 overflow 2");
constexpr size_t OFF_R2 = OFF_R1 + R1_SIZE;
constexpr size_t OFF_S5S = OFF_R2;
constexpr size_t OFF_Y = OFF_R2;
constexpr size_t OFF_O = OFF_Y + AL((size_t)T * 512 * 2) + SLACK;
constexpr size_t R2A_A = AL((size_t)32 * MCH * 256 * 4), R2A_B = 2 * (AL((size_t)T * 512 * 2) + SLACK);
constexpr size_t R2A_SIZE = R2A_A > R2A_B ? R2A_A : R2A_B;
constexpr size_t OFF_GS = OFF_R2 + R2A_SIZE;
constexpr size_t OFF_DEC = OFF_GS + AL((size_t)4112 * 8192 * 2);
constexpr size_t OFF_BAR = OFF_DEC + AL((size_t)4112 * 64 * 4);
#ifdef DBG_DUP_ALLGEMM
constexpr size_t OFF_DUMMY = OFF_BAR + 4096;
constexpr size_t WS_END = OFF_DUMMY + AL((size_t)T * 1024 * 2) + SLACK;
#else
constexpr size_t WS_END = OFF_BAR + 4096;
#endif

#ifndef PHMASK
#if defined(DBG_NO_GLA)
#define PHMASK 0xFFFD5F
#elif defined(DBG_NO_INTER)
#define PHMASK 0xFFFF1F
#elif defined(DBG_NO_S5)
#define PHMASK 0xFFFFBF
#else
#define PHMASK 0xFFFFFF
#endif
#endif
#define PH(n) if constexpr (((PHMASK) >> (n)) & 1)
struct Params { const float* in[32]; float* out; unsigned char* ws; };

__device__ __forceinline__ float bf2f(bf16_t b) { return __uint_as_float(((unsigned)b) << 16); }
typedef __bf16 bf16x2_t __attribute__((ext_vector_type(2)));
__device__ __forceinline__ unsigned pk2(float lo, float hi) { bf16x2_t v; v.x = (__bf16)lo; v.y = (__bf16)hi; return __builtin_bit_cast(unsigned, v); }
__device__ __forceinline__ bf16_t f2bf(float f) { return (bf16_t)(pk2(f, 0.f) & 0xffffu); }
__device__ __forceinline__ float sigm(float x) { return __builtin_amdgcn_rcpf(1.f + __expf(-x)); }
__device__ __forceinline__ float siluf_(float x) { return x * sigm(x); }
__device__ __forceinline__ float gelu_tanh(float x) { const float u = 0.7978845608028654f * (x + 0.044715f * x * x * x); return x * sigm(2.f * u); }
__device__ __forceinline__ float logsig(float x) { return fminf(x, 0.f) - __logf(1.f + __expf(-fabsf(x))); }
__device__ __forceinline__ float lo16(unsigned w) { return __uint_as_float(w << 16); }
__device__ __forceinline__ float hi16(unsigned w) { return __uint_as_float(w & 0xffff0000u); }
__device__ __forceinline__ float row_rstd(const float* rowpart, int rowc, int fq) {
    const f32x4 p = *(const f32x4*)(rowpart + (size_t)rowc * 16 + 4 * fq);
    float s = (p[0] + p[1]) + (p[2] + p[3]);
    s += __shfl_xor(s, 16); s += __shfl_xor(s, 32);
    return rsqrtf(s * (1.f / 1024.f) + 1e-6f);
}
__device__ __forceinline__ float rstd_finish(const f32x4 p) {
    float s = (p[0] + p[1]) + (p[2] + p[3]);
    s += __shfl_xor(s, 16); s += __shfl_xor(s, 32);
    return rsqrtf(s * (1.f / 1024.f) + 1e-6f);
}
#define LOAD_RS8(rs, rowpart, u, wr, fr, fq, Mv) float rs[2][4]; { f32x4 _p[2][4]; \
    _Pragma("unroll") for (int ai = 0; ai < 2; ++ai) _Pragma("unroll") for (int m = 0; m < 4; ++m) { const int _r = (u).pm * 256 + ai * 128 + (wr) * 64 + m * 16 + (fr); const int _rc = _r < (Mv) ? _r : (Mv) - 1; \
        _p[ai][m] = *(const f32x4*)((rowpart) + (size_t)_rc * 16 + 4 * (fq)); } \
    _Pragma("unroll") for (int ai = 0; ai < 2; ++ai) _Pragma("unroll") for (int m = 0; m < 4; ++m) rs[ai][m] = rstd_finish(_p[ai][m]); }
__device__ __forceinline__ int opaque_tid() { int t = threadIdx.x; asm volatile("" : "+v"(t)); return t; }
__device__ __forceinline__ void row_to_mt(int row, int& m, int& t) {
    if (row < TR) { const int b = row >> 14, s = row & 16383, p = s + 16; m = b * NCH + (p >> 4); t = p & 15; }
    else { const int rr = row - TR; m = (rr >> 4) * NCH; t = rr & 15; }
}

namespace pg8 {
constexpr int BM = 256, BK = 64, HALF = 128, HTB = HALF * BK * 2, NXCD = 8, WGM = 8;
__device__ __forceinline__ int lds_byte(int r, int c) { const int st = (r >> 4) * 2 + (c >> 5), rr = r & 15, cc = c & 31, ob = rr * 64 + cc * 2; return st * 1024 + (ob ^ (((ob >> 9) & 1) << 5)); }
__device__ __forceinline__ void stage_rc(int b, int& R, int& C) { const int st = b / 1024, sb = b % 1024, swz = sb ^ (((sb >> 9) & 1) << 5); R = (st >> 1) * 16 + swz / 64; C = (st & 1) * 32 + (swz % 64) / 2; }
struct Unit { int pm, pn, pg; };
struct Gemm { const bf16_t* A; const bf16_t* Bt; int lda, K, nM, nN, nG; size_t gsA, gsB; int tail; int blkA; int rev; };

__device__ __forceinline__ int next_unit(const Gemm& g, int i, int G, int c) {
    const int nwg = g.nM * g.nN, tot = nwg * g.nG;
    const int L = i * G + c; if (L >= tot) return -1;
    int pm, pn, pg;
    if (g.nG > 1) { pg = L / nwg; const int r = L - pg * nwg; pm = r / g.nN; pn = r - pm * g.nN; }
    else {
        int wgid = L; { const int q = nwg / NXCD, r = nwg % NXCD, xcd = wgid % NXCD, off = wgid / NXCD; wgid = (xcd < r ? xcd * (q + 1) : r * (q + 1) + (xcd - r) * q) + off; }
        const int nig = WGM * g.nN, gid = wgid / nig, fm = gid * WGM, gsz = (g.nM - fm) < WGM ? (g.nM - fm) : WGM;
        const int rem = wgid - gid * nig; pn = rem / gsz; pm = fm + (rem - pn * gsz); pg = 0;
        if (g.rev) pm = g.nM - 1 - pm;
    }
    return pm | (pn << 10) | (pg << 20);
}
__device__ __forceinline__ Unit unpack_unit(int v) { Unit u; u.pm = v & 1023; u.pn = (v >> 10) & 1023; u.pg = v >> 20; return u; }

template <class Epi>
__device__ __forceinline__ void gemm_phase(LAS unsigned char* lds, const Gemm g, const Epi& E, const int G, const int c) {
    const int tid = opaque_tid(), wid = __builtin_amdgcn_readfirstlane(tid >> 6), lane = tid & 63, wr = wid >> 2, wc = wid & 3, fr = lane & 15, fq = lane >> 4;
    const int K = g.K, nt = K / BK;
    unsigned voffA[2], voffB[2];
#pragma unroll
    for (int i = 0; i < 2; ++i) { int R, C; stage_rc(tid * 16 + i * 8192, R, C); voffA[i] = (unsigned)(R * (g.blkA ? 64 : g.lda) + C) * 2u; voffB[i] = (unsigned)(R * K + C) * 2u; }
    const size_t kstep = (size_t)(BK * 2);
    const size_t kstepA = g.blkA ? (size_t)32768 : kstep;
    const size_t hstepA = g.blkA ? (size_t)16384 : (size_t)HALF * g.lda * 2, hstepB = (size_t)HALF * K * 2;
    const size_t tstepA = g.blkA ? (size_t)nt * 32768 : 2 * hstepA, tstepB = 2 * hstepB;
    const unsigned ldsw = (unsigned)wid * 1024u;
    const int aoff = lds_byte(wr * 64 + fr, fq * 8), boff = lds_byte(wc * 32 + fr, fq * 8);
#define PG8_SA(b, h) (((b) * 2 + (h)) * HTB)
#define PG8_SB(b, h) ((4 + (b) * 2 + (h)) * HTB)
#define PG8_STAGE(bufoff, gbase, voff) do { _Pragma("unroll") for (int _i = 0; _i < 2; ++_i) \
        __builtin_amdgcn_global_load_lds((const unsigned*)((const char*)(gbase) + (voff)[_i]), (LAS unsigned*)(lds + (bufoff) + ldsw + _i * 8192), 16, 0, 0); } while (0)
#define PG8_LDA(dst, b, h) do { _Pragma("unroll") for (int m = 0; m < 4; ++m) _Pragma("unroll") for (int k = 0; k < 2; ++k) dst[m][k] = *(const LAS bf16x8*)(lds + PG8_SA(b, h) + aoff + m * 2048 + k * 1024); } while (0)
#define PG8_LDB(dst, b, h) do { _Pragma("unroll") for (int n = 0; n < 2; ++n) _Pragma("unroll") for (int k = 0; k < 2; ++k) dst[n][k] = *(const LAS bf16x8*)(lds + PG8_SB(b, h) + boff + n * 2048 + k * 1024); } while (0)
#define PG8_MMA(ai, bj, At, Bt) do { __builtin_amdgcn_s_setprio(1); _Pragma("unroll") for (int m = 0; m < 4; ++m) _Pragma("unroll") for (int n = 0; n < 2; ++n) _Pragma("unroll") for (int k = 0; k < 2; ++k) \
        acc[ai][bj][m][n] = __builtin_amdgcn_mfma_f32_16x16x32_bf16(Bt[n][k], At[m][k], acc[ai][bj][m][n], 0, 0, 0); __builtin_amdgcn_s_setprio(0); } while (0)
#define PG8_WAIT_V(n) asm volatile("s_waitcnt vmcnt(" #n ")" ::: "memory")
#define PG8_WAIT_L(n) asm volatile("s_waitcnt lgkmcnt(" #n ")" ::: "memory")
#define PG8_BAR __builtin_amdgcn_s_barrier()
#define PG8_SCHED __builtin_amdgcn_sched_barrier(0)
    int ui = 0;
    int curp = next_unit(g, 0, G, c);
    Unit cur = unpack_unit(curp < 0 ? 0 : curp);
    f32x4 acc[2][2][4][2];
#pragma unroll
    for (int a = 0; a < 2; ++a)
#pragma unroll
        for (int b = 0; b < 2; ++b)
#pragma unroll
            for (int m = 0; m < 4; ++m)
#pragma unroll
                for (int n = 0; n < 2; ++n) acc[a][b][m][n] = (f32x4){0.f, 0.f, 0.f, 0.f};
    if (curp >= 0) {
    bf16x8 At[4][2], B0[2][2], B1[2][2];
    const char* cA = (const char*)(g.A + (size_t)cur.pg * g.gsA) + (size_t)cur.pm * tstepA;
    const char* cB = (const char*)(g.Bt + (size_t)cur.pg * g.gsB) + (size_t)cur.pn * tstepB;
    PG8_STAGE(PG8_SB(0, 0), cB, voffB); PG8_STAGE(PG8_SA(0, 0), cA, voffA); PG8_STAGE(PG8_SB(0, 1), cB + hstepB, voffB); PG8_STAGE(PG8_SA(0, 1), cA + hstepA, voffA);
    if (wr == 1) PG8_BAR;
    PG8_WAIT_V(4); PG8_BAR;
    PG8_STAGE(PG8_SB(1, 0), cB + kstep, voffB); PG8_STAGE(PG8_SA(1, 0), cA + kstepA, voffA); PG8_STAGE(PG8_SB(1, 1), cB + hstepB + kstep, voffB);
    PG8_WAIT_V(6); PG8_BAR;
    for (;;) {
        const int nxtp = next_unit(g, ui + 1, G, c); const bool has_next = nxtp >= 0; const Unit nxt = unpack_unit(has_next ? nxtp : curp);
        const char* nA = has_next ? (const char*)(g.A + (size_t)nxt.pg * g.gsA) + (size_t)nxt.pm * tstepA : cA;
        const char* nB = has_next ? (const char*)(g.Bt + (size_t)nxt.pg * g.gsB) + (size_t)nxt.pn * tstepB : cB;
        for (int t = 0; t < nt; t += 2) {
            const bool last = (t == nt - 2);
            const char* a1 = cA + (size_t)(t + 1) * kstepA;
            const char* a2 = last ? nA : cA + (size_t)(t + 2) * kstepA; const char* b2 = last ? nB : cB + (size_t)(t + 2) * kstep;
            const char* a3 = a2 + kstepA; const char* b3 = b2 + kstep;
            PG8_LDB(B0, 0, 0); PG8_SCHED; PG8_LDA(At, 0, 0); PG8_STAGE(PG8_SA(1, 1), a1 + hstepA, voffA);
            PG8_WAIT_L(8); PG8_BAR; PG8_WAIT_L(0); PG8_MMA(0, 0, At, B0); PG8_BAR; PG8_SCHED;
            PG8_LDB(B1, 0, 1); PG8_STAGE(PG8_SB(0, 0), b2, voffB);
            PG8_BAR; PG8_WAIT_L(0); PG8_MMA(0, 1, At, B1); PG8_BAR;
            PG8_LDA(At, 0, 1); PG8_STAGE(PG8_SA(0, 0), a2, voffA);
            PG8_BAR; PG8_WAIT_L(0); PG8_MMA(1, 0, At, B0); PG8_BAR; PG8_SCHED;
            PG8_STAGE(PG8_SB(0, 1), b2 + hstepB, voffB);
            PG8_WAIT_V(6); PG8_BAR; PG8_MMA(1, 1, At, B1); PG8_BAR;
            PG8_LDB(B0, 1, 0); PG8_SCHED; PG8_LDA(At, 1, 0); PG8_STAGE(PG8_SA(0, 1), a2 + hstepA, voffA);
            PG8_WAIT_L(8); PG8_BAR; PG8_WAIT_L(0); PG8_MMA(0, 0, At, B0); PG8_BAR; PG8_SCHED;
            PG8_LDB(B1, 1, 1); PG8_STAGE(PG8_SB(1, 0), b3, voffB);
            PG8_BAR; PG8_WAIT_L(0); PG8_MMA(0, 1, At, B1); PG8_BAR;
            PG8_LDA(At, 1, 1); PG8_STAGE(PG8_SA(1, 0), a3, voffA);
            PG8_BAR; PG8_WAIT_L(0); PG8_MMA(1, 0, At, B0); PG8_BAR; PG8_SCHED;
            PG8_STAGE(PG8_SB(1, 1), b3 + hstepB, voffB);
            PG8_WAIT_V(6); PG8_BAR; PG8_MMA(1, 1, At, B1); PG8_BAR;
        }
        { int efr = fr, efq = fq; asm volatile("" : "+v"(efr), "+v"(efq)); E(acc, cur, wr, wc, efr, efq); }
        if (!has_next) break;
#pragma unroll
        for (int a = 0; a < 2; ++a)
#pragma unroll
            for (int b = 0; b < 2; ++b)
#pragma unroll
                for (int m = 0; m < 4; ++m)
#pragma unroll
                    for (int n = 0; n < 2; ++n) acc[a][b][m][n] = (f32x4){0.f, 0.f, 0.f, 0.f};
        cur = nxt; curp = nxtp; cA = nA; cB = nB; ++ui;
    }
    PG8_WAIT_V(0);
    if (wr == 0) PG8_BAR;
    PG8_BAR;
    }
    if (g.tail) {
        const int ks = K >> 3;
        for (int j = G - 1 - c; j < 4 * g.nN; j += G) {
            const int pn = j >> 2, q = j & 3;
#pragma unroll
            for (int a = 0; a < 2; ++a)
#pragma unroll
                for (int b = 0; b < 2; ++b)
#pragma unroll
                    for (int m = 0; m < 4; ++m)
#pragma unroll
                        for (int n = 0; n < 2; ++n) acc[a][b][m][n] = (f32x4){0.f, 0.f, 0.f, 0.f};
            const bf16_t* Ap = g.blkA ? g.A + (size_t)g.nM * nt * 16384 + fr * 64 + fq * 8 : g.A + (size_t)(g.nM * 256 + fr) * g.lda + fq * 8;
            const bf16_t* Bp = g.Bt + (size_t)(pn * 256 + q * 32 + fr) * K + wid * ks + fq * 8;
            const size_t a16 = g.blkA ? (size_t)16 * 64 : (size_t)16 * g.lda, b16 = (size_t)16 * K, b128 = (size_t)128 * K;
            for (int k0 = 0; k0 < ks; k0 += 64) {
                bf16x8 av[2][2], bv[2][4];
#pragma unroll
                for (int qq = 0; qq < 2; ++qq) if (k0 + qq * 32 < ks) {
                    const int kk = k0 + qq * 32, ka = wid * ks + kk; const size_t ao = g.blkA ? (size_t)(ka >> 6) * 16384 + (ka & 63) : (size_t)ka;
                    av[qq][0] = *(const bf16x8*)(Ap + ao); av[qq][1] = *(const bf16x8*)(Ap + a16 + ao);
                    bv[qq][0] = *(const bf16x8*)(Bp + kk); bv[qq][1] = *(const bf16x8*)(Bp + b16 + kk);
                    bv[qq][2] = *(const bf16x8*)(Bp + b128 + kk); bv[qq][3] = *(const bf16x8*)(Bp + b128 + b16 + kk);
                }
#pragma unroll
                for (int qq = 0; qq < 2; ++qq) if (k0 + qq * 32 < ks) {
                    acc[0][0][0][0] = __builtin_amdgcn_mfma_f32_16x16x32_bf16(bv[qq][0], av[qq][0], acc[0][0][0][0], 0, 0, 0);
                    acc[0][0][1][0] = __builtin_amdgcn_mfma_f32_16x16x32_bf16(bv[qq][0], av[qq][1], acc[0][0][1][0], 0, 0, 0);
                    acc[0][0][0][1] = __builtin_amdgcn_mfma_f32_16x16x32_bf16(bv[qq][1], av[qq][0], acc[0][0][0][1], 0, 0, 0);
                    acc[0][0][1][1] = __builtin_amdgcn_mfma_f32_16x16x32_bf16(bv[qq][1], av[qq][1], acc[0][0][1][1], 0, 0, 0);
                    acc[0][1][0][0] = __builtin_amdgcn_mfma_f32_16x16x32_bf16(bv[qq][2], av[qq][0], acc[0][1][0][0], 0, 0, 0);
                    acc[0][1][1][0] = __builtin_amdgcn_mfma_f32_16x16x32_bf16(bv[qq][2], av[qq][1], acc[0][1][1][0], 0, 0, 0);
                    acc[0][1][0][1] = __builtin_amdgcn_mfma_f32_16x16x32_bf16(bv[qq][3], av[qq][0], acc[0][1][0][1], 0, 0, 0);
                    acc[0][1][1][1] = __builtin_amdgcn_mfma_f32_16x16x32_bf16(bv[qq][3], av[qq][1], acc[0][1][1][1], 0, 0, 0);
                }
            }
            LAS f32x4* red = (LAS f32x4*)lds;
#pragma unroll
            for (int bj = 0; bj < 2; ++bj)
#pragma unroll
                for (int m = 0; m < 2; ++m)
#pragma unroll
                    for (int n = 0; n < 2; ++n) red[(wid * 8 + bj * 4 + m * 2 + n) * 64 + lane] = acc[0][bj][m][n];
            __syncthreads();
            if (wid == q) {
#pragma unroll
                for (int bj = 0; bj < 2; ++bj)
#pragma unroll
                    for (int m = 0; m < 2; ++m)
#pragma unroll
                        for (int n = 0; n < 2; ++n) {
                            f32x4 sum = (f32x4){0.f, 0.f, 0.f, 0.f};
#pragma unroll 2
                            for (int w = 0; w < 8; ++w) sum += red[(w * 8 + bj * 4 + m * 2 + n) * 64 + lane];
                            acc[0][bj][m][n] = sum;
                            asm volatile("" ::: "memory");
                        }
                Unit tu; tu.pm = g.nM; tu.pn = pn; tu.pg = 0; int efr = fr, efq = fq; asm volatile("" : "+v"(efr), "+v"(efq)); E(acc, tu, 0, q, efr, efq);
            }
            __syncthreads();
        }
    }
#undef PG8_SA
#undef PG8_SB
#undef PG8_STAGE
#undef PG8_LDA
#undef PG8_LDB
#undef PG8_MMA
#undef PG8_WAIT_V
#undef PG8_WAIT_L
#undef PG8_BAR
#undef PG8_SCHED
}
}
using pg8::Unit;
typedef f32x4 Acc[2][2][4][2];

struct EpiUp {
    const float* rowpart; bf16_t* hid; int Mv;
    __device__ __forceinline__ void operator()(const Acc& acc, const Unit& u, int wr, int wc, int fr, int fq) const {
        LOAD_RS8(rsv, rowpart, u, wr, fr, fq, Mv)
#pragma unroll
        for (int ai = 0; ai < 2; ++ai)
#pragma unroll
            for (int m = 0; m < 4; ++m) {
                const int row = u.pm * 256 + ai * 128 + wr * 64 + m * 16 + fr;
                const float rs = rsv[ai][m];
#pragma unroll
                for (int bj = 0; bj < 2; ++bj) {
                    const f32x4 gv = acc[ai][bj][m][0] * rs, uv = acc[ai][bj][m][1] * rs;
                    u32x2 w; w.x = pk2(siluf_(gv[0]) * uv[0], siluf_(gv[1]) * uv[1]); w.y = pk2(siluf_(gv[2]) * uv[2], siluf_(gv[3]) * uv[3]);
                    const int col = 128 * u.pn + 64 * bj + 16 * wc + 4 * fq;
                    if (row < Mv) *(u32x2*)(hid + ((size_t)((row >> 8) * 44 + (col >> 6)) * 256 + (row & 255)) * 64 + (col & 63)) = w;
                }
            }
    }
};
struct EpiRes {
    float* out; float* metah; bf16_t* hb; float* rowpart; float scale; int Mv;
    __device__ __forceinline__ void operator()(const Acc& acc, const Unit& u, int wr, int wc, int fr, int fq) const {
#pragma unroll
        for (int ai = 0; ai < 2; ++ai) {
            u32x2 old[4][2][2];
#pragma unroll
            for (int m = 0; m < 4; ++m) {
                const int row = u.pm * 256 + ai * 128 + wr * 64 + m * 16 + fr; const int rc = row < Mv ? row : Mv - 1;
                const bf16_t* hp = hb + (size_t)rc * DM + 256 * u.pn + 32 * wc + 4 * fq;
#pragma unroll
                for (int bj = 0; bj < 2; ++bj)
#pragma unroll
                    for (int n = 0; n < 2; ++n) old[m][bj][n] = *(const u32x2*)(hp + 128 * bj + 16 * n);
            }
#pragma unroll
            for (int m = 0; m < 4; ++m) {
                const int row = u.pm * 256 + ai * 128 + wr * 64 + m * 16 + fr; const bool valid = row < Mv; const int rc = valid ? row : Mv - 1;
                bf16_t* hp = hb + (size_t)rc * DM + 256 * u.pn + 32 * wc + 4 * fq;
                float ss = 0.f;
#pragma unroll
                for (int bj = 0; bj < 2; ++bj)
#pragma unroll
                    for (int n = 0; n < 2; ++n) {
                        const u32x2 o = old[m][bj][n]; const f32x4 a = acc[ai][bj][m][n];
                        f32x4 nv; nv[0] = lo16(o.x) + a[0] * scale; nv[1] = hi16(o.x) + a[1] * scale; nv[2] = lo16(o.y) + a[2] * scale; nv[3] = hi16(o.y) + a[3] * scale;
                        ss += (nv[0] * nv[0] + nv[1] * nv[1]) + (nv[2] * nv[2] + nv[3] * nv[3]);
                        if (valid) { u32x2 w; w.x = pk2(nv[0], nv[1]); w.y = pk2(nv[2], nv[3]); *(u32x2*)(hp + 128 * bj + 16 * n) = w; }
                    }
                ss += __shfl_xor(ss, 16); ss += __shfl_xor(ss, 32);
                if (valid && fq == 0) rowpart[(size_t)row * 16 + u.pn * 4 + wc] = ss;
            }
            asm volatile("" ::: "memory");
        }
    }
};
struct EpiProj {
    const float* rowpart; bf16_t* ubuf; bf16_t* q; bf16_t* k; bf16_t* v; bf16_t* r; float* z; int Mv;
    __device__ __forceinline__ void operator()(const Acc& acc, const Unit& u, int wr, int wc, int fr, int fq) const {
        const int pn = u.pn;
        LOAD_RS8(rsv, rowpart, u, wr, fr, fq, Mv)
#pragma unroll
        for (int ai = 0; ai < 2; ++ai)
#pragma unroll
            for (int m = 0; m < 4; ++m) {
                const int row = u.pm * 256 + ai * 128 + wr * 64 + m * 16 + fr; const bool valid = row < Mv; const int rc = valid ? row : Mv - 1;
                const float rs = rsv[ai][m];
                int mm, tt; row_to_mt(rc, mm, tt);
#pragma unroll
                for (int bj = 0; bj < 2; ++bj)
#pragma unroll
                    for (int n = 0; n < 2; ++n) {
                        const f32x4 val = acc[ai][bj][m][n] * rs;
                        const int cl = 128 * bj + 32 * wc + 16 * n + 4 * fq;
                        u32x2 w; w.x = pk2(val[0], val[1]); w.y = pk2(val[2], val[3]);
                        if (!valid) continue;
                        if (pn < 2) { const int cc = 256 * pn + cl; const int gg = cc >> 4, j = cc & 15; *(u32x2*)(ubuf + ((size_t)gg * MCH + mm) * 512 + tt * 16 + j) = w; }
                        else if (pn == 2) *(u32x2*)(q + (size_t)row * 256 + cl) = w;
                        else if (pn == 3) *(u32x2*)(k + (size_t)row * 256 + cl) = w;
                        else if (pn < 6) *(u32x2*)(v + (size_t)row * 512 + (pn - 4) * 256 + cl) = w;
                        else if (pn < 8) *(u32x2*)(r + (size_t)row * 512 + (pn - 6) * 256 + cl) = w;
                        else if (cl < 32) *(f32x4*)(z + (size_t)row * 32 + cl) = val;
                    }
            }
    }
};
struct EpiS5S {
    float* S;
    __device__ __forceinline__ void operator()(const Acc& acc, const Unit& u, int wr, int wc, int fr, int fq) const {
#pragma unroll
        for (int ai = 0; ai < 2; ++ai)
#pragma unroll
            for (int m = 0; m < 4; ++m) {
                const int row = u.pm * 256 + ai * 128 + wr * 64 + m * 16 + fr;
                if (row < MCH) {
#pragma unroll
                    for (int bj = 0; bj < 2; ++bj)
#pragma unroll
                        for (int n = 0; n < 2; ++n) *(f32x4*)(S + ((size_t)u.pg * MCH + row) * 256 + 128 * bj + 32 * wc + 16 * n + 4 * fq) = acc[ai][bj][m][n];
                }
            }
    }
};
struct EpiS5Y {
    bf16_t* y;
    __device__ __forceinline__ void operator()(const Acc& acc, const Unit& u, int wr, int wc, int fr, int fq) const {
#pragma unroll
        for (int ai = 0; ai < 2; ++ai)
#pragma unroll
            for (int m = 0; m < 4; ++m) {
                const int mrow = u.pm * 256 + ai * 128 + wr * 64 + m * 16 + fr;
                if (mrow < MCH) {
                    const int b = mrow >= NCH ? 1 : 0, cch = mrow - b * NCH;
                    const int rbase = cch == 0 ? TR + 16 * b : b * 16384 + 16 * (cch - 1);
#pragma unroll
                    for (int bj = 0; bj < 2; ++bj)
#pragma unroll
                        for (int n = 0; n < 2; ++n) {
                            const int tt = 8 * bj + 2 * wc + n; const f32x4 a = acc[ai][bj][m][n];
                            u32x2 w; w.x = pk2(gelu_tanh(a[0]), gelu_tanh(a[1])); w.y = pk2(gelu_tanh(a[2]), gelu_tanh(a[3]));
                            *(u32x2*)(y + (size_t)(rbase + tt) * 512 + u.pg * 16 + 4 * fq) = w;
                        }
                }
            }
    }
};
struct EpiGlu {
    bf16_t* S; int Mv;
    __device__ __forceinline__ void operator()(const Acc& acc, const Unit& u, int wr, int wc, int fr, int fq) const {
#pragma unroll
        for (int ai = 0; ai < 2; ++ai)
#pragma unroll
            for (int m = 0; m < 4; ++m) {
                const int row = u.pm * 256 + ai * 128 + wr * 64 + m * 16 + fr;
#pragma unroll
                for (int bj = 0; bj < 2; ++bj) {
                    const f32x4 a = acc[ai][bj][m][0], b = acc[ai][bj][m][1];
                    u32x2 w; w.x = pk2(a[0] * sigm(b[0]), a[1] * sigm(b[1])); w.y = pk2(a[2] * sigm(b[2]), a[3] * sigm(b[3]));
                    const int col = 128 * u.pn + 64 * bj + 16 * wc + 4 * fq;
                    if (row < Mv) *(u32x2*)(S + (size_t)row * DM + col) = w;
                }
            }
    }
};
struct EpiBf {
    bf16_t* O; int Mv;
    __device__ __forceinline__ void operator()(const Acc& acc, const Unit& u, int wr, int wc, int fr, int fq) const {
#pragma unroll
        for (int ai = 0; ai < 2; ++ai)
#pragma unroll
            for (int m = 0; m < 4; ++m) {
                const int row = u.pm * 256 + ai * 128 + wr * 64 + m * 16 + fr;
#pragma unroll
                for (int bj = 0; bj < 2; ++bj)
#pragma unroll
                    for (int n = 0; n < 2; ++n) {
                        const f32x4 a = acc[ai][bj][m][n]; u32x2 w; w.x = pk2(a[0], a[1]); w.y = pk2(a[2], a[3]);
                        const int col = 256 * u.pn + 128 * bj + 32 * wc + 16 * n + 4 * fq;
                        if (row < Mv) *(u32x2*)(O + (size_t)row * DM + col) = w;
                    }
            }
    }
};
struct EpiGate {
    const float* rowpart; bf16_t* S; const bf16_t* Gm; int Mv;
    __device__ __forceinline__ void operator()(const Acc& acc, const Unit& u, int wr, int wc, int fr, int fq) const {
        LOAD_RS8(rsv, rowpart, u, wr, fr, fq, Mv)
#pragma unroll
        for (int ai = 0; ai < 2; ++ai) {
            u32x2 sv[4][2], gv[4][2];
#pragma unroll
            for (int m = 0; m < 4; ++m)
#pragma unroll
                for (int bj = 0; bj < 2; ++bj) {
                    const int row = u.pm * 256 + ai * 128 + wr * 64 + m * 16 + fr; const int rc = row < Mv ? row : Mv - 1; const int col = 128 * u.pn + 64 * bj + 16 * wc + 4 * fq;
                    sv[m][bj] = *(const u32x2*)(S + (size_t)rc * DM + col); gv[m][bj] = *(const u32x2*)(Gm + (size_t)rc * DM + col);
                }
#pragma unroll
            for (int m = 0; m < 4; ++m) {
                const int row = u.pm * 256 + ai * 128 + wr * 64 + m * 16 + fr; const bool valid = row < Mv;
                const float rs = rsv[ai][m];
#pragma unroll
                for (int bj = 0; bj < 2; ++bj) {
                    const int col = 128 * u.pn + 64 * bj + 16 * wc + 4 * fq;
                    const f32x4 g0 = acc[ai][bj][m][0] * rs, g1 = acc[ai][bj][m][1] * rs;
                    const u32x2 s2 = sv[m][bj], g2 = gv[m][bj];
                    const float o0 = sigm(g0[0]) * lo16(s2.x) + sigm(g1[0]) * lo16(g2.x), o1 = sigm(g0[1]) * hi16(s2.x) + sigm(g1[1]) * hi16(g2.x);
                    const float o2 = sigm(g0[2]) * lo16(s2.y) + sigm(g1[2]) * lo16(g2.y), o3 = sigm(g0[3]) * hi16(s2.y) + sigm(g1[3]) * hi16(g2.y);
                    u32x2 w; w.x = pk2(o0, o1); w.y = pk2(o2, o3);
                    if (valid) *(u32x2*)(S + (size_t)row * DM + col) = w;
                }
            }
            asm volatile("" ::: "memory");
        }
    }
};

struct CvtJob { const float* s0; const float* s1; const float* scale; bf16_t* dst; int K, N, ld, pair, nvalid, q0, q1; };
__device__ __forceinline__ const float* cvt_map(const CvtJob& j, int c, float& mul) {
    mul = 1.f;
    if (j.pair) { const int col = (c >> 5) * 16 + (c & 15); return ((c >> 4) & 1) ? j.s1 + col : j.s0 + col; }
    if (c >= j.q0 && c < j.q1) mul = 0.125f;
    return c < j.nvalid ? j.s0 + c : nullptr;
}
__device__ __forceinline__ void cvt_load(const CvtJob& j, int ti, int nkt, int tid, f32x4 (&v)[2][4]) {
    const int k0 = (ti % nkt) * 64, c0 = (ti / nkt) * 256;
    const int cq = (tid & 15) * 4, kk0 = tid >> 4;
#pragma unroll
    for (int cb = 0; cb < 4; ++cb) {
        float mul; const float* sp = cvt_map(j, c0 + cb * 64 + cq, mul);
#pragma unroll
        for (int ps = 0; ps < 2; ++ps) {
            const int kk = kk0 + 32 * ps;
            v[ps][cb] = (f32x4){0.f, 0.f, 0.f, 0.f};
            if (sp) { v[ps][cb] = *(const f32x4*)(sp + (size_t)(k0 + kk) * j.ld); const float sc = (j.scale ? j.scale[k0 + kk] : 1.f) * mul; v[ps][cb] = v[ps][cb] * sc; }
        }
    }
}
__device__ __forceinline__ void convert_wt(LAS unsigned char* lds, const CvtJob& j, int G, int c, int& rot) {
    LAS float* tile = (LAS float*)lds;
    const int tid = opaque_tid();
    const int K = j.K;
    const int nkt = K / 64, nct = j.N / 256, ntile = nkt * nct;
    int ti = (c + G - (rot % G)) % G;
    f32x4 v[2][4];
    if (ti < ntile) cvt_load(j, ti, nkt, tid, v);
    for (; ti < ntile; ti += G) {
        const int k0 = (ti % nkt) * 64, c0 = (ti / nkt) * 256;
        {
            const int cq = (tid & 15) * 4, kk0 = tid >> 4;
#pragma unroll
            for (int cb = 0; cb < 4; ++cb)
#pragma unroll
                for (int ps = 0; ps < 2; ++ps) {
                    const int kk = kk0 + 32 * ps; LAS float* tp = tile + kk * 257 + cb * 64 + cq;
                    tp[0] = v[ps][cb][0]; tp[1] = v[ps][cb][1]; tp[2] = v[ps][cb][2]; tp[3] = v[ps][cb][3];
                }
        }
        __syncthreads();
        if (ti + G < ntile) cvt_load(j, ti + G, nkt, tid, v);
        {
            const int cc = tid >> 1, kq = (tid & 1) * 32;
#pragma unroll
            for (int q = 0; q < 4; ++q) {
                const int kb = kq + q * 8; u32x4 w;
                w.x = pk2(tile[(kb + 0) * 257 + cc], tile[(kb + 1) * 257 + cc]); w.y = pk2(tile[(kb + 2) * 257 + cc], tile[(kb + 3) * 257 + cc]);
                w.z = pk2(tile[(kb + 4) * 257 + cc], tile[(kb + 5) * 257 + cc]); w.w = pk2(tile[(kb + 6) * 257 + cc], tile[(kb + 7) * 257 + cc]);
                *(u32x4*)(j.dst + (size_t)(c0 + cc) * K + k0 + kb) = w;
            }
        }
        __syncthreads();
    }
    rot += ntile;
}
__device__ __forceinline__ CvtJob make_job(const Params& p, int l, int job) {
    bf16_t* W = (bf16_t*)(p.ws + OFF_W + (size_t)l * W_BYTES);
    const float* win = p.in[7] + (size_t)l * DM * DIN; const float* wglu = p.in[19] + (size_t)l * 512 * 2048;
    const float* n1 = p.in[2] + (size_t)l * DM; const float* nm = p.in[6] + (size_t)l * DM; const float* n2 = p.in[27] + (size_t)l * DM;
    switch (job) {
    case 0: return CvtJob{p.in[3] + (size_t)l * DM * DFF, p.in[4] + (size_t)l * DM * DFF, n1, W + W_UP1, 1024, 5632, DFF, 1, 0, 0, 0};
    case 1: return CvtJob{p.in[5] + (size_t)l * DFF * DM, nullptr, nullptr, W + W_DN1, 2816, 1024, DM, 0, 1024, 0, 0};
    case 2: return CvtJob{win, nullptr, nm, W + W_INP, 1024, 2304, DIN, 0, 2080, 512, 768};
    case 3: return CvtJob{win + 2080, win + 2080 + 1024, nm, W + W_ING, 1024, 2048, DIN, 1, 0, 0, 0};
    case 4: return CvtJob{wglu, wglu + 1024, nullptr, W + W_GLU, 512, 2048, 2048, 1, 0, 0, 0};
    case 5: return CvtJob{p.in[25] + (size_t)l * 512 * DM, nullptr, nullptr, W + W_O, 512, 1024, DM, 0, 1024, 0, 0};
    case 6: return CvtJob{p.in[26] + (size_t)l * DM * DM, nullptr, nullptr, W + W_OUT, 1024, 1024, DM, 0, 1024, 0, 0};
    case 7: return CvtJob{p.in[28] + (size_t)l * DM * DFF, p.in[29] + (size_t)l * DM * DFF, n2, W + W_UP2, 1024, 5632, DFF, 1, 0, 0, 0};
    default: return CvtJob{p.in[30] + (size_t)l * DFF * DM, nullptr, nullptr, W + W_DN2, 2816, 1024, DM, 0, 1024, 0, 0};
    }
}

__device__ __forceinline__ void s5_gen(LAS unsigned char* lds, const Params& p, int l, int g, bf16_t* B1, bf16_t* B2, float* lamtab, int part) {
    const int tid = opaque_tid();
    LAS f32x2* P = (LAS f32x2*)lds;
    LAS f32x2* BB = P + 2 * 17 * 64;
    LAS f32x2* CC = BB + 2 * 64 * 16;
    LAS f32x2* F = CC + 16 * 64;
    LAS float* KT = (LAS float*)(F + 128);
    const float* a_re0 = p.in[8] + (size_t)(l * 32 + g) * 64; const float* a_re1 = p.in[11] + (size_t)(l * 32 + g) * 64;
    const float* a_im0 = p.in[9] + (size_t)(l * 32 + g) * 64; const float* a_im1 = p.in[12] + (size_t)(l * 32 + g) * 64;
    const float ldt0 = p.in[10][l * 32 + g], ldt1 = p.in[13][l * 32 + g];
    const float* b_re = p.in[14] + (size_t)(l * 32 + g) * 1024; const float* b_im = p.in[15] + (size_t)(l * 32 + g) * 1024;
    const float* c_re = p.in[16] + (size_t)(l * 32 + g) * 1024; const float* c_im = p.in[17] + (size_t)(l * 32 + g) * 1024;
    const float* dd = p.in[18] + (size_t)l * 512 + g * 16;
    __syncthreads();
    for (int e = tid; e < 2 * 17 * 64; e += NTHR) {
        const int dir = e / (17 * 64), n = (e / 64) % 17, pp = e & 63;
        const float dt = expf(dir ? ldt1 : ldt0); const float ar = (dir ? a_re1 : a_re0)[pp], ai = (dir ? a_im1 : a_im0)[pp];
        const float mag = expf(ar * dt * (float)n), ang = ai * dt * (float)n;
        P[e] = (f32x2){mag * cosf(ang), mag * sinf(ang)};
    }
    if (tid < 128) {
        const int dir = tid >> 6, pp = tid & 63;
        const float dt = expf(dir ? ldt1 : ldt0); const float ar = (dir ? a_re1 : a_re0)[pp], ai = (dir ? a_im1 : a_im0)[pp];
        const float mag = expf(ar * dt); const float lr = mag * cosf(ai * dt), li = mag * sinf(ai * dt);
        const float den = ar * ar + ai * ai; const float ir = ar / den, ii = -ai / den;
        const float xr = lr - 1.f, xi = li;
        F[tid] = (f32x2){xr * ir - xi * ii, xr * ii + xi * ir};
        const float m16 = expf(ar * dt * 16.f), a16 = ai * dt * 16.f;
        if (part != 1) *(f32x2*)(lamtab + ((size_t)(g * 2 + dir) * 64 + pp) * 2) = (f32x2){m16 * cosf(a16), m16 * sinf(a16)};
    }
    for (int e = tid; e < 1024; e += NTHR) { const int i = e >> 6, pp = e & 63; CC[e] = (f32x2){c_re[i * 64 + pp], c_im[i * 64 + pp]}; }
    __syncthreads();
    for (int e = tid; e < 2048; e += NTHR) {
        const int dir = e >> 10, pj = e & 1023, pp = pj >> 4; const f32x2 f = F[dir * 64 + pp]; const float br = b_re[pj], bi = b_im[pj];
        BB[e] = (f32x2){f.x * br - f.y * bi, f.x * bi + f.y * br};
    }
    __syncthreads();
    if (part != 0) {
        const int dir = tid >> 8, n = (tid >> 4) & 15, i = tid & 15;
        float sj[16];
#pragma unroll
        for (int j = 0; j < 16; ++j) sj[j] = 0.f;
        for (int pp = 0; pp < 64; ++pp) {
            const f32x2 cv = CC[i * 64 + pp], pv = P[(dir * 17 + n) * 64 + pp];
            const float xr = cv.x * pv.x - cv.y * pv.y, xi = cv.x * pv.y + cv.y * pv.x;
#pragma unroll
            for (int j = 0; j < 16; ++j) { const f32x2 bv = BB[(dir * 64 + pp) * 16 + j]; sj[j] += xr * bv.x - xi * bv.y; }
        }
#pragma unroll
        for (int j = 0; j < 16; ++j) KT[(((dir * 16 + n) * 16 + i) << 4) + j] = sj[j];
    }
    __syncthreads();
    if (part != 1) for (int e = tid; e < 256 * 32; e += NTHR) {
        const int n = e >> 5, k0 = (e & 31) * 8; const int dir = n >> 7, reim = (n >> 6) & 1, pp = n & 63; const int s = k0 >> 4, j0 = k0 & 15;
        const f32x2 pv = P[(dir * 17 + (dir == 0 ? 15 - s : s)) * 64 + pp]; float o[8];
#pragma unroll
        for (int jj = 0; jj < 8; ++jj) { const f32x2 bv = BB[(dir * 64 + pp) * 16 + j0 + jj]; o[jj] = reim == 0 ? pv.x * bv.x - pv.y * bv.y : pv.x * bv.y + pv.y * bv.x; }
        u32x4 w; w.x = pk2(o[0], o[1]); w.y = pk2(o[2], o[3]); w.z = pk2(o[4], o[5]); w.w = pk2(o[6], o[7]);
        *(u32x4*)(B1 + (size_t)n * 256 + k0) = w;
    }
    for (int e = tid; e < 256 * 64; e += NTHR) {
        const int n = e >> 6, k0 = (e & 63) * 8; const int t = n >> 4, i = n & 15; float o[8];
        if (part == 0 && k0 < 256) continue;
        if (part == 1 && k0 >= 256) continue;
        if (k0 < 256) {
            const int s = k0 >> 4, j0 = k0 & 15;
#pragma unroll
            for (int jj = 0; jj < 8; ++jj) {
                const int j = j0 + jj; float v = 0.f;
                if (t >= s) v += KT[((0 * 16) + (t - s)) * 256 + i * 16 + j];
                if (s >= t) v += KT[((1 * 16) + (s - t)) * 256 + i * 16 + j];
                if (s == t && i == j) v += dd[i];
                o[jj] = v;
            }
        } else {
            const int kk = k0 - 256; const int dir = kk >> 7, reim = (kk >> 6) & 1, p0 = kk & 63; const int pw = dir == 0 ? t + 1 : 16 - t;
#pragma unroll
            for (int jj = 0; jj < 8; ++jj) {
                const f32x2 cv = CC[i * 64 + p0 + jj], pv = P[(dir * 17 + pw) * 64 + p0 + jj];
                o[jj] = reim == 0 ? (cv.x * pv.x - cv.y * pv.y) : -(cv.x * pv.y + cv.y * pv.x);
            }
        }
        u32x4 w; w.x = pk2(o[0], o[1]); w.y = pk2(o[2], o[3]); w.z = pk2(o[4], o[5]); w.w = pk2(o[6], o[7]);
        *(u32x4*)(B2 + (size_t)n * 512 + k0) = w;
    }
    __syncthreads();
}

constexpr int BST = 65;
constexpr int GL_BF = 0, GL_BB = 16640, GL_X = 33280;
__device__ __forceinline__ int gla_row0(int b, int n) { return n == 0 ? TR + 16 * b : b * 16384 + 64 * (n - 1); }
__device__ __forceinline__ void lds_barrier() { asm volatile("s_waitcnt lgkmcnt(0)" ::: "memory"); __builtin_amdgcn_s_barrier(); asm volatile("" ::: "memory"); }
struct GlaIn { f32x4 z; float w20, w21, w22, w23; float bi; u32x4 k; u32x4 v0, v1; };
struct GlaIn3 { u32x4 q; u32x4 h0, h1, h2, h3; };
__device__ __forceinline__ void gla_task(int task, int& bh, int& hh, int& n, int& row0, int& ntok) {
    n = task % GCH; bh = task / GCH; hh = bh & 3; const int b = bh >> 2; row0 = gla_row0(b, n); ntok = n == 0 ? 16 : 64;
}
template <bool G3>
__device__ __forceinline__ void gla_load(const Params& p, int l, int task, int tid, const float* zbuf, const bf16_t* qbuf, const bf16_t* kbuf, const bf16_t* vbuf, const bf16_t* gs, GlaIn& in, GlaIn3& in3) {
    int bh, hh, n, row0, ntok; gla_task(task, bh, hh, n, row0, ntok);
    const int t = tid >> 3; const bool tv = t < ntok; const u32x4 z4 = (u32x4){0u, 0u, 0u, 0u};
    in.z = tv ? *(const f32x4*)(zbuf + (size_t)(row0 + t) * 32 + (tid & 7) * 4) : (f32x4){0.f, 0.f, 0.f, 0.f};
    { float wv[4];
#pragma unroll
    for (int i = 0; i < 4; ++i) { const int e = tid + NTHR * i; const int dir = e >> 10, r = (e >> 6) & 15, d = e & 63; wv[i] = (dir ? p.in[22] : p.in[20])[(size_t)l * 16 * 256 + r * 256 + hh * 64 + d]; }
    in.w20 = wv[0]; in.w21 = wv[1]; in.w22 = wv[2]; in.w23 = wv[3]; }
    in.bi = 0.f; if (tid < 128) { const int dir = tid >> 6, d = tid & 63; in.bi = (dir ? p.in[23] : p.in[21])[l * 256 + hh * 64 + d]; }
    const int d0 = (tid & 7) * 8, v0 = (tid & 7) * 16;
    in.k = tv ? *(const u32x4*)(kbuf + (size_t)(row0 + t) * 256 + hh * 64 + d0) : z4;
    in.v0 = tv ? *(const u32x4*)(vbuf + (size_t)(row0 + t) * 512 + hh * 128 + v0) : z4;
    in.v1 = tv ? *(const u32x4*)(vbuf + (size_t)(row0 + t) * 512 + hh * 128 + v0 + 8) : z4;
    if (G3) {
        in3.q = tv ? *(const u32x4*)(qbuf + (size_t)(row0 + t) * 256 + hh * 64 + d0) : z4;
        const int vr = tid >> 2, dq = (tid & 3) * 16;
        const bf16_t* s0 = gs + ((size_t)(bh * 2 + 0) * GCH + n) * 8192 + vr * 64 + dq; const bf16_t* s1 = gs + ((size_t)(bh * 2 + 1) * GCH + n) * 8192 + vr * 64 + dq;
        in3.h0 = *(const u32x4*)s0; in3.h1 = *(const u32x4*)(s0 + 8); in3.h2 = *(const u32x4*)s1; in3.h3 = *(const u32x4*)(s1 + 8);
    }
}
__device__ __forceinline__ void gla_prep(LAS unsigned char* lds, const GlaIn& in, int tid, int ntok) {
    LAS float* BF = (LAS float*)(lds + GL_BF); LAS float* BBk = (LAS float*)(lds + GL_BB);
    LAS float* Z = (LAS float*)(lds + GL_X); LAS float* W2 = Z + 2048; LAS float* BI = W2 + 2048; LAS float* TOT = BI + 128;
    *(LAS f32x4*)(Z + (tid >> 3) * 32 + (tid & 7) * 4) = in.z;
    W2[tid] = in.w20; W2[tid + NTHR] = in.w21; W2[tid + 2 * NTHR] = in.w22; W2[tid + 3 * NTHR] = in.w23;
    if (tid < 128) BI[tid] = in.bi;
    lds_barrier();
    const int dir = tid >> 8, tb = (tid >> 6) & 3, d = tid & 63;
    LAS float* BX = dir ? BBk : BF;
    {
        float w[16];
#pragma unroll
        for (int r = 0; r < 16; ++r) w[r] = W2[(dir * 16 + r) * 64 + d];
        const float bias = BI[dir * 64 + d];
        float pre = 0.f;
#pragma unroll
        for (int j = 0; j < 16; ++j) {
            const int t = dir ? 16 * tb + 15 - j : 16 * tb + j;
            float x = bias;
#pragma unroll
            for (int r4 = 0; r4 < 4; ++r4) { const f32x4 zv = *(const LAS f32x4*)(Z + t * 32 + dir * 16 + r4 * 4); x += zv[0] * w[r4 * 4] + zv[1] * w[r4 * 4 + 1] + zv[2] * w[r4 * 4 + 2] + zv[3] * w[r4 * 4 + 3]; }
            const float gg = t < ntok ? logsig(x) * (1.f / 16.f) : 0.f;
            pre += gg; BX[t * BST + d] = pre;
        }
        TOT[(dir * 4 + tb) * 64 + d] = pre;
    }
    lds_barrier();
    {
        float off = 0.f;
#pragma unroll
        for (int t2 = 0; t2 < 4; ++t2) { const float tv = TOT[(dir * 4 + t2) * 64 + d]; if (dir ? (t2 > tb) : (t2 < tb)) off += tv; }
#pragma unroll
        for (int j = 0; j < 16; ++j) BX[(16 * tb + j) * BST + d] += off;
    }
    lds_barrier();
}

__device__ __forceinline__ void gla_g1(LAS unsigned char* lds, const Params& p, int l, const bf16_t* kbuf, const bf16_t* vbuf, const float* zbuf, bf16_t* gs, float* dec, int G, int c) {
    const int tid = opaque_tid(), wid = tid >> 6, lane = tid & 63, fr = lane & 15, fq = lane >> 4;
    LAS float* BF = (LAS float*)(lds + GL_BF); LAS float* BBk = (LAS float*)(lds + GL_BB);
    LAS bf16_t* KF = (LAS bf16_t*)(lds + GL_X); LAS bf16_t* KB = KF + 64 * 72; LAS bf16_t* VT = KB + 64 * 72;
    GlaIn cur{}; GlaIn3 dum{};
    if (c < 8 * GCH) gla_load<false>(p, l, c, tid, zbuf, nullptr, kbuf, vbuf, nullptr, cur, dum);
    for (int task = c; task < 8 * GCH; task += G) {
        int bh, hh, n, row0, ntok; gla_task(task, bh, hh, n, row0, ntok);
        GlaIn nxt{};
        if (task + G < 8 * GCH) gla_load<false>(p, l, task + G, tid, zbuf, nullptr, kbuf, vbuf, nullptr, nxt, dum);
        gla_prep(lds, cur, tid, ntok);
        {
            const int t = tid >> 3, d0 = (tid & 7) * 8;
            const unsigned kw[4] = {cur.k.x, cur.k.y, cur.k.z, cur.k.w};
#pragma unroll
            for (int i = 0; i < 8; ++i) {
                const int d = d0 + i; const float kk = (i & 1) ? hi16(kw[i >> 1]) : lo16(kw[i >> 1]);
                const int tc = t ^ (((d >> 3) & 7) << 3);
                KF[d * 72 + tc] = f2bf(kk * __expf(BF[63 * BST + d] - BF[t * BST + d]));
                KB[d * 72 + tc] = f2bf(kk * __expf(BBk[0 * BST + d] - BBk[t * BST + d]));
            }
            const int v0 = (tid & 7) * 16;
#pragma unroll
            for (int hv = 0; hv < 2; ++hv) {
                const u32x4 vv = hv ? cur.v1 : cur.v0;
                const unsigned vw[4] = {vv.x, vv.y, vv.z, vv.w};
#pragma unroll
                for (int i = 0; i < 8; ++i) { const int vr_ = v0 + hv * 8 + i; VT[vr_ * 72 + (t ^ (((vr_ >> 4) & 7) << 3))] = (bf16_t)((i & 1) ? (vw[i >> 1] >> 16) : (vw[i >> 1] & 0xffffu)); }
            }
        }
        if (tid < 128) { const int dir = tid >> 6, d = tid & 63; dec[((size_t)(bh * 2 + dir) * GCH + n) * 64 + d] = __expf(dir ? BBk[d] : BF[63 * BST + d]); }
        lds_barrier();
        {
            const int dir = wid >> 2, dt = wid & 3; LAS bf16_t* KS = dir ? KB : KF;
            const int sa = (dt * 2 + (fr >> 3)) & 7;
            const bf16x8 a0 = *(const LAS bf16x8*)(KS + (dt * 16 + fr) * 72 + ((fq ^ sa) << 3)), a1 = *(const LAS bf16x8*)(KS + (dt * 16 + fr) * 72 + (((4 + fq) ^ sa) << 3));
            bf16_t* dst = gs + ((size_t)(bh * 2 + dir) * GCH + n) * 8192;
#pragma unroll
            for (int vt = 0; vt < 8; ++vt) {
                const bf16x8 b0 = *(const LAS bf16x8*)(VT + (vt * 16 + fr) * 72 + ((fq ^ vt) << 3)), b1 = *(const LAS bf16x8*)(VT + (vt * 16 + fr) * 72 + (((4 + fq) ^ vt) << 3));
                f32x4 a = (f32x4){0.f, 0.f, 0.f, 0.f};
                a = __builtin_amdgcn_mfma_f32_16x16x32_bf16(a0, b0, a, 0, 0, 0);
                a = __builtin_amdgcn_mfma_f32_16x16x32_bf16(a1, b1, a, 0, 0, 0);
                u32x2 w; w.x = pk2(a[0], a[1]); w.y = pk2(a[2], a[3]);
                *(u32x2*)(dst + (size_t)(vt * 16 + fr) * 64 + dt * 16 + fq * 4) = w;
            }
        }
        lds_barrier();
        cur = nxt;
    }
    __syncthreads();
}

__device__ __forceinline__ void gla_g2(LAS unsigned char* lds, bf16_t* gs, const float* dec, int G, int c) {
    constexpr int CB = 56;
    const int tid = opaque_tid();
    LAS float* DL = (LAS float*)lds;
    LAS bf16_t* SL = (LAS bf16_t*)(lds + 66048);
    static_assert(66048 + CB * 1024 <= LDS_BYTES, "G2 LDS");
    for (int g0 = c * NTHR; g0 < 16 * 8192; g0 += G * NTHR) {
        const int seq = g0 >> 13, e0 = g0 & 8191, d = (e0 + tid) & 63, dir = seq & 1;
        __syncthreads();
        {
            f32x4 dv[9]; const float* dsrc = dec + (size_t)seq * GCH * 64;
#pragma unroll
            for (int k = 0; k < 9; ++k) { const int idx = tid + k * NTHR; dv[k] = idx < GCH * 16 ? *(const f32x4*)(dsrc + idx * 4) : (f32x4){0.f, 0.f, 0.f, 0.f}; }
#pragma unroll
            for (int k = 0; k < 9; ++k) { const int idx = tid + k * NTHR; if (idx < GCH * 16) *(LAS f32x4*)(DL + idx * 4) = dv[k]; }
        }
        bf16_t* base = gs + (size_t)seq * GCH * 8192 + e0;
        float st = 0.f;
        for (int n0 = 0; n0 < GCH; n0 += CB) {
            const int nb = (GCH - n0) < CB ? (GCH - n0) : CB;
            __syncthreads();
            {
                u32x4 sv[7];
#pragma unroll
                for (int k = 0; k < 7; ++k) { const int i = tid + k * NTHR; const int r = i >> 6, pc = i & 63; const int n = n0 + r; const int nn = dir ? GCH - 1 - n : n;
                    sv[k] = i < nb * 64 ? *(const u32x4*)(base + (size_t)nn * 8192 + pc * 8) : (u32x4){0u, 0u, 0u, 0u}; }
#pragma unroll
                for (int k = 0; k < 7; ++k) { const int i = tid + k * NTHR; const int r = i >> 6, pc = i & 63; if (i < nb * 64) *(LAS u32x4*)(SL + r * 512 + pc * 8) = sv[k]; }
            }
            __syncthreads();
            for (int r = 0; r < nb; ++r) { const int n = n0 + r; const int nn = dir ? GCH - 1 - n : n;
                const float sv = bf2f(SL[r * 512 + tid]); SL[r * 512 + tid] = f2bf(st); st = DL[nn * 64 + d] * st + sv; }
            __syncthreads();
            for (int i = tid; i < nb * 64; i += NTHR) { const int r = i >> 6, pc = i & 63; const int n = n0 + r; const int nn = dir ? GCH - 1 - n : n;
                *(u32x4*)(base + (size_t)nn * 8192 + pc * 8) = *(const LAS u32x4*)(SL + r * 512 + pc * 8); }
        }
    }
    __syncthreads();
}

constexpr int GL_A1 = GL_X + 18432, GL_B1 = GL_A1 + 25600, GL_RS = GL_B1 + 51200;
static_assert(GL_RS + 512 <= LDS_BYTES, "G3 LDS");
__device__ __forceinline__ void gla_g3(LAS unsigned char* lds, const Params& p, int l, const bf16_t* qbuf, const bf16_t* kbuf, const bf16_t* vbuf, const bf16_t* rbuf, const float* zbuf,
                       const bf16_t* gs, bf16_t* obuf, int G, int c) {
    const int tid = opaque_tid(), wid = tid >> 6, lane = tid & 63, fr = lane & 15, fq = lane >> 4;
    LAS float* BF = (LAS float*)(lds + GL_BF); LAS float* BBk = (LAS float*)(lds + GL_BB);
    LAS bf16_t* KDF = (LAS bf16_t*)(lds + GL_X); LAS bf16_t* KDB = KDF + 64 * 72;
    LAS bf16_t* A1 = (LAS bf16_t*)(lds + GL_A1); LAS bf16_t* B1 = (LAS bf16_t*)(lds + GL_B1); LAS float* RS = (LAS float*)(lds + GL_RS);
    const float* gnorm = p.in[24] + (size_t)l * 512;
    GlaIn cur{}; GlaIn3 cur3{};
    if (c < 8 * GCH) gla_load<true>(p, l, c, tid, zbuf, qbuf, kbuf, vbuf, gs, cur, cur3);
    for (int task = c; task < 8 * GCH; task += G) {
        int bh, hh, n, row0, ntok; gla_task(task, bh, hh, n, row0, ntok);
        GlaIn nxt{}; GlaIn3 nxt3{};
        if (task + G < 8 * GCH) gla_load<true>(p, l, task + G, tid, zbuf, qbuf, kbuf, vbuf, gs, nxt, nxt3);
        gla_prep(lds, cur, tid, ntok);
        {
            const int t = tid >> 3, d0 = (tid & 7) * 8;
            const unsigned qw[4] = {cur3.q.x, cur3.q.y, cur3.q.z, cur3.q.w}, kw[4] = {cur.k.x, cur.k.y, cur.k.z, cur.k.w};
            unsigned oqf[4], oqb[4], okf[4], okb[4];
#pragma unroll
            for (int i = 0; i < 4; ++i) {
                const int d = d0 + 2 * i; const float bf0 = BF[t * BST + d], bf1 = BF[t * BST + d + 1], bb0 = BBk[t * BST + d], bb1 = BBk[t * BST + d + 1];
                const float q0 = lo16(qw[i]), q1 = hi16(qw[i]), k0 = lo16(kw[i]), k1 = hi16(kw[i]);
                oqf[i] = pk2(q0 * __expf(bf0), q1 * __expf(bf1)); oqb[i] = pk2(q0 * __expf(bb0), q1 * __expf(bb1));
                okf[i] = pk2(k0 * __expf(-bf0), k1 * __expf(-bf1)); okb[i] = pk2(k0 * __expf(-bb0), k1 * __expf(-bb1));
            }
            *(LAS u32x4*)(A1 + t * 200 + 64 + d0) = (u32x4){oqf[0], oqf[1], oqf[2], oqf[3]};
            *(LAS u32x4*)(A1 + t * 200 + 128 + d0) = (u32x4){oqb[0], oqb[1], oqb[2], oqb[3]};
            *(LAS u32x4*)(KDF + t * 72 + d0) = (u32x4){okf[0], okf[1], okf[2], okf[3]};
            *(LAS u32x4*)(KDB + t * 72 + d0) = (u32x4){okb[0], okb[1], okb[2], okb[3]};
            const int v0 = (tid & 7) * 16;
#pragma unroll
            for (int hv = 0; hv < 2; ++hv) {
                const u32x4 vv = hv ? cur.v1 : cur.v0;
                const unsigned vw[4] = {vv.x, vv.y, vv.z, vv.w};
#pragma unroll
                for (int i = 0; i < 8; ++i) { const int vr_ = v0 + hv * 8 + i; B1[vr_ * 200 + (t ^ (((vr_ >> 4) & 7) << 3))] = (bf16_t)((i & 1) ? (vw[i >> 1] >> 16) : (vw[i >> 1] & 0xffffu)); }
            }
            const int vr = tid >> 2, dq = (tid & 3) * 16;
#pragma unroll
            for (int dir = 0; dir < 2; ++dir) {
#ifdef DBG_NO_INTER
                const u32x4 h0 = (u32x4){0u,0u,0u,0u}, h1 = h0;
#else
                const u32x4 h0 = dir ? cur3.h2 : cur3.h0, h1 = dir ? cur3.h3 : cur3.h1;
#endif
                *(LAS u32x4*)(B1 + vr * 200 + 64 + dir * 64 + dq) = h0; *(LAS u32x4*)(B1 + vr * 200 + 64 + dir * 64 + dq + 8) = h1;
            }
        }
        lds_barrier();
        {
            const int ti = wid >> 1;
            const bf16x8 qf0 = *(const LAS bf16x8*)(A1 + (ti * 16 + fr) * 200 + 64 + fq * 8), qf1 = *(const LAS bf16x8*)(A1 + (ti * 16 + fr) * 200 + 96 + fq * 8);
            const bf16x8 qb0 = *(const LAS bf16x8*)(A1 + (ti * 16 + fr) * 200 + 128 + fq * 8), qb1 = *(const LAS bf16x8*)(A1 + (ti * 16 + fr) * 200 + 160 + fq * 8);
#pragma unroll
            for (int tj2 = 0; tj2 < 2; ++tj2) {
                const int tj = (wid & 1) * 2 + tj2;
                const bf16x8 kf0 = *(const LAS bf16x8*)(KDF + (tj * 16 + fr) * 72 + fq * 8), kf1 = *(const LAS bf16x8*)(KDF + (tj * 16 + fr) * 72 + 32 + fq * 8);
                const bf16x8 kb0 = *(const LAS bf16x8*)(KDB + (tj * 16 + fr) * 72 + fq * 8), kb1 = *(const LAS bf16x8*)(KDB + (tj * 16 + fr) * 72 + 32 + fq * 8);
                f32x4 sf = (f32x4){0.f, 0.f, 0.f, 0.f}, sb = sf;
                sf = __builtin_amdgcn_mfma_f32_16x16x32_bf16(kf0, qf0, sf, 0, 0, 0); sf = __builtin_amdgcn_mfma_f32_16x16x32_bf16(kf1, qf1, sf, 0, 0, 0);
                sb = __builtin_amdgcn_mfma_f32_16x16x32_bf16(kb0, qb0, sb, 0, 0, 0); sb = __builtin_amdgcn_mfma_f32_16x16x32_bf16(kb1, qb1, sb, 0, 0, 0);
                const int i = ti * 16 + fr, j0 = tj * 16 + fq * 4; float pv[4];
#pragma unroll
                for (int jj = 0; jj < 4; ++jj) pv[jj] = (j0 + jj <= i) ? sf[jj] : sb[jj];
                *(LAS u32x2*)(A1 + i * 200 + j0) = (u32x2){pk2(pv[0], pv[1]), pk2(pv[2], pv[3])};
            }
        }
        lds_barrier();
        {
            const int it = wid & 3, vh = wid >> 2;
            bf16x8 bfr[6];
#pragma unroll
            for (int ks = 0; ks < 6; ++ks) bfr[ks] = *(const LAS bf16x8*)(A1 + (it * 16 + fr) * 200 + ks * 32 + fq * 8);
            f32x4 o[4]; float ss = 0.f;
#pragma unroll
            for (int vt = 0; vt < 4; ++vt) {
                f32x4 a = (f32x4){0.f, 0.f, 0.f, 0.f};
#pragma unroll
                for (int ks = 0; ks < 6; ++ks) { const int cb = ks < 2 ? (((ks * 4 + fq) ^ ((vh * 4 + vt) & 7)) << 3) : ks * 32 + fq * 8;
                    const bf16x8 af = *(const LAS bf16x8*)(B1 + (vh * 64 + vt * 16 + fr) * 200 + cb); a = __builtin_amdgcn_mfma_f32_16x16x32_bf16(af, bfr[ks], a, 0, 0, 0); }
                o[vt] = a; ss += (a[0] * a[0] + a[1] * a[1]) + (a[2] * a[2] + a[3] * a[3]);
            }
            ss += __shfl_xor(ss, 16); ss += __shfl_xor(ss, 32);
            if (fq == 0) RS[vh * 64 + it * 16 + fr] = ss;
            lds_barrier();
            const int i = it * 16 + fr; const float tot = RS[i] + RS[64 + i]; const float rn = rsqrtf(tot * (1.f / 128.f) + 1e-6f);
            if (i < ntok) {
                const int row = row0 + i;
#pragma unroll
                for (int vt = 0; vt < 4; ++vt) {
                    const int vcol = hh * 128 + vh * 64 + vt * 16 + fq * 4;
                    const f32x4 gn = *(const f32x4*)(gnorm + vcol); const u32x2 rv = *(const u32x2*)(rbuf + (size_t)row * 512 + vcol);
                    const float r0 = lo16(rv.x), r1 = hi16(rv.x), r2 = lo16(rv.y), r3 = hi16(rv.y);
                    u32x2 w; w.x = pk2(o[vt][0] * rn * gn[0] * siluf_(r0), o[vt][1] * rn * gn[1] * siluf_(r1)); w.y = pk2(o[vt][2] * rn * gn[2] * siluf_(r2), o[vt][3] * rn * gn[3] * siluf_(r3));
                    *(u32x2*)(obuf + (size_t)row * 512 + vcol) = w;
                }
            }
        }
        lds_barrier();
        cur = nxt; cur3 = nxt3;
    }
    __syncthreads();
}

__device__ __forceinline__ void s5_scan(LAS unsigned char* lds, const float* S, bf16_t* ubuf, const float* lamtab, int G, int c) {
    const int tid = opaque_tid(); const int pl = tid & 31, sg = tid >> 5;
    LAS f32x2* E = (LAS f32x2*)lds; LAS f32x2* PW = E + 512;
    for (int task = c; task < 256; task += G) {
        const int combo = task >> 1, pp = (task & 1) * 32 + pl;
        const int dir = combo & 1, g = (combo >> 1) & 31, b = combo >> 6;
        const f32x2 lam = *(const f32x2*)(lamtab + ((size_t)(g * 2 + dir) * 64 + pp) * 2);
        const float* sb = S + ((size_t)g * MCH + b * NCH) * 256 + dir * 128 + pp;
        bf16_t* hb = ubuf + ((size_t)g * MCH + b * NCH) * 512 + 256 + dir * 128 + pp;
        const int c_lo = sg * 64, c_hi = sg == 15 ? NCH : c_lo + 64;
        float lr = 0.f, li = 0.f, pr = 1.f, pi = 0.f;
        for (int c0 = c_lo; c0 < c_hi; c0 += 16) {
            float sr[16], si[16];
#pragma unroll
            for (int i = 0; i < 16; ++i) { const int cc = c0 + i; const int ch = dir ? NCH - 1 - cc : cc; if (cc < c_hi) { sr[i] = sb[(size_t)ch * 256]; si[i] = sb[(size_t)ch * 256 + 64]; } else { sr[i] = 0.f; si[i] = 0.f; } }
#pragma unroll
            for (int i = 0; i < 16; ++i) { const int cc = c0 + i;
                if (cc < c_hi) { const float nr = lam.x * lr - lam.y * li + sr[i], ni = lam.x * li + lam.y * lr + si[i]; lr = nr; li = ni;
                                 const float tr = lam.x * pr - lam.y * pi; pi = lam.x * pi + lam.y * pr; pr = tr; } }
        }
        E[sg * 32 + pl] = (f32x2){lr, li}; PW[sg * 32 + pl] = (f32x2){pr, pi};
        __syncthreads();
        float hr = 0.f, hi = 0.f;
        for (int s2 = 0; s2 < sg; ++s2) { const f32x2 e = E[s2 * 32 + pl], w = PW[s2 * 32 + pl]; const float nr = w.x * hr - w.y * hi + e.x, ni = w.x * hi + w.y * hr + e.y; hr = nr; hi = ni; }
        for (int c0 = c_lo; c0 < c_hi; c0 += 16) {
            float sr[16], si[16];
#pragma unroll
            for (int i = 0; i < 16; ++i) { const int cc = c0 + i; const int ch = dir ? NCH - 1 - cc : cc; if (cc < c_hi) { sr[i] = sb[(size_t)ch * 256]; si[i] = sb[(size_t)ch * 256 + 64]; } else { sr[i] = 0.f; si[i] = 0.f; } }
#pragma unroll
            for (int i = 0; i < 16; ++i) { const int cc = c0 + i; const int ch = dir ? NCH - 1 - cc : cc;
                if (cc < c_hi) { hb[(size_t)ch * 512] = f2bf(hr); hb[(size_t)ch * 512 + 64] = f2bf(hi); const float nr = lam.x * hr - lam.y * hi + sr[i], ni = lam.x * hi + lam.y * hr + si[i]; hr = nr; hi = ni; } }
        }
        __syncthreads();
    }
}

enum { GK_UP1 = 0, GK_DN1, GK_PROJ, GK_S5S, GK_S5Y, GK_GLU, GK_WO, GK_GATE, GK_OUTP, GK_UP2, GK_DN2 };
__device__ __forceinline__ pg8::Gemm make_gemm(int kind, unsigned char* ws, int l) {
    bf16_t* W = (bf16_t*)(ws + OFF_W + (size_t)l * W_BYTES); const bf16_t* hb = (const bf16_t*)(ws + OFF_HB); const bf16_t* hid = (const bf16_t*)(ws + OFF_HID); const bf16_t* ubuf = (const bf16_t*)(ws + OFF_UBUF);
    switch (kind) {
    case GK_UP1:  return pg8::Gemm{hb, W + W_UP1, 1024, 1024, 128, 22, 1, 0, 0, 1, 0, 0};
    case GK_DN1:  return pg8::Gemm{hid, W + W_DN1, DFF, DFF, 128, 4, 1, 0, 0, 1, 1, 1};
    case GK_PROJ: return pg8::Gemm{hb, W + W_INP, 1024, 1024, 128, 9, 1, 0, 0, 1, 0, 0};
    case GK_S5S:  return pg8::Gemm{ubuf, W + W_S1, 512, 256, 9, 1, 32, (size_t)MCH * 512, (size_t)256 * 256, 0, 0, 0};
    case GK_S5Y:  return pg8::Gemm{ubuf, W + W_S2, 512, 512, 9, 1, 32, (size_t)MCH * 512, (size_t)256 * 512, 0, 0, 0};
    case GK_GLU:  return pg8::Gemm{(const bf16_t*)(ws + OFF_Y), W + W_GLU, 512, 512, 128, 8, 1, 0, 0, 1, 0, 0};
    case GK_WO:   return pg8::Gemm{(const bf16_t*)(ws + OFF_O), W + W_O, 512, 512, 128, 4, 1, 0, 0, 1, 0, 0};
    case GK_GATE: return pg8::Gemm{hb, W + W_ING, 1024, 1024, 128, 8, 1, 0, 0, 1, 0, 0};
    case GK_OUTP: return pg8::Gemm{(const bf16_t*)(ws + OFF_SB), W + W_OUT, 1024, 1024, 128, 4, 1, 0, 0, 1, 0, 0};
    case GK_UP2:  return pg8::Gemm{hb, W + W_UP2, 1024, 1024, 128, 22, 1, 0, 0, 1, 0, 0};
    default:      return pg8::Gemm{hid, W + W_DN2, DFF, DFF, 128, 4, 1, 0, 0, 1, 1, 1};
    }
}
struct EpiSwitch {
    int kind; unsigned char* ws; float* out;
    __device__ __forceinline__ void operator()(const Acc& acc, const Unit& u, int wr, int wc, int fr, int fq) const {
        float* rowpart = (float*)(ws + OFF_ROWPART); bf16_t* hb = (bf16_t*)(ws + OFF_HB); float* metah = (float*)(ws + OFF_METAH);
#ifdef DBG_DUP_ALLGEMM
        if (kind >= 100) { if (u.pg == 0 && u.pn < 4) { EpiBf E{(bf16_t*)(ws + OFF_DUMMY), T}; E(acc, u, wr, wc, fr, fq); } return; }
#endif
        switch (kind) {
        case GK_UP1: case GK_UP2: { EpiUp E{rowpart, (bf16_t*)(ws + OFF_HID), T}; E(acc, u, wr, wc, fr, fq); } break;
        case GK_DN1: case GK_DN2: case GK_OUTP: { EpiRes E{out, metah, hb, rowpart, kind == GK_OUTP ? 1.0f : 0.5f, T}; E(acc, u, wr, wc, fr, fq); } break;
        case GK_PROJ: { EpiProj E{rowpart, (bf16_t*)(ws + OFF_UBUF), (bf16_t*)(ws + OFF_Q), (bf16_t*)(ws + OFF_K), (bf16_t*)(ws + OFF_V), (bf16_t*)(ws + OFF_R), (float*)(ws + OFF_Z), T}; E(acc, u, wr, wc, fr, fq); } break;
        case GK_S5S: { EpiS5S E{(float*)(ws + OFF_S5S)}; E(acc, u, wr, wc, fr, fq); } break;
        case GK_S5Y: { EpiS5Y E{(bf16_t*)(ws + OFF_Y)}; E(acc, u, wr, wc, fr, fq); } break;
        case GK_GLU: { EpiGlu E{(bf16_t*)(ws + OFF_SB), T}; E(acc, u, wr, wc, fr, fq); } break;
        case GK_WO: { EpiBf E{(bf16_t*)(ws + OFF_GB), T}; E(acc, u, wr, wc, fr, fq); } break;
        default: { EpiGate E{rowpart, (bf16_t*)(ws + OFF_SB), (const bf16_t*)(ws + OFF_GB), T}; E(acc, u, wr, wc, fr, fq); } break;
        }
    }
};

struct BarCtx { unsigned* bar; unsigned epoch, xcc, nx, nxcd; };
__device__ __forceinline__ void grid_barrier(BarCtx& b) {
    asm volatile("s_waitcnt vmcnt(0) lgkmcnt(0)" ::: "memory");
    __syncthreads();
    b.epoch += 1u;
    if (threadIdx.x < 64) {
        unsigned old = 0u;
        if (threadIdx.x == 0) old = __hip_atomic_fetch_add(b.bar + 64 + 16 * b.xcc, 1u, __ATOMIC_RELAXED, __HIP_MEMORY_SCOPE_AGENT);
        old = (unsigned)__builtin_amdgcn_readfirstlane((int)old);
        if (old + 1u == b.epoch * b.nx) {
            __builtin_amdgcn_fence(__ATOMIC_RELEASE, "agent");
            asm volatile("s_waitcnt vmcnt(0)" ::: "memory");
            if (threadIdx.x == 0) __hip_atomic_fetch_add(b.bar, 1u, __ATOMIC_RELAXED, __HIP_MEMORY_SCOPE_AGENT);
        }
        const unsigned target = b.epoch * b.nxcd;
        while ((unsigned)__builtin_amdgcn_readfirstlane((int)__hip_atomic_load(b.bar, __ATOMIC_RELAXED, __HIP_MEMORY_SCOPE_AGENT)) < target) __builtin_amdgcn_s_sleep(1);
        __builtin_amdgcn_fence(__ATOMIC_ACQUIRE, "agent");
        asm volatile("s_waitcnt vmcnt(0)" ::: "memory");
    }
    __syncthreads();
}

__global__ void __launch_bounds__(NTHR, 2) fwd_mega(Params p) {
    extern __shared__ __attribute__((aligned(16))) unsigned char lds_raw[];
    LAS unsigned char* lds = (LAS unsigned char*)lds_raw;
    cg::grid_group grid = cg::this_grid();
    const int G = gridDim.x, c = blockIdx.x;
    unsigned char* ws = p.ws;
    float* out = p.out;
    BarCtx bctx; bctx.bar = (unsigned*)(ws + OFF_BAR); bctx.epoch = 0u;
    bctx.xcc = (unsigned)__builtin_amdgcn_s_getreg((3 << 11) | 20) & 0xFu;
    if (threadIdx.x == 0) __hip_atomic_fetch_add(bctx.bar + 512 + bctx.xcc, 1u, __ATOMIC_RELAXED, __HIP_MEMORY_SCOPE_AGENT);
    grid.sync();
    {
        unsigned nx = 0u, nxcd = 0u;
        for (int x = 0; x < 16; ++x) { const unsigned v = (unsigned)__builtin_amdgcn_readfirstlane((int)__hip_atomic_load(bctx.bar + 512 + x, __ATOMIC_RELAXED, __HIP_MEMORY_SCOPE_AGENT)); if (v) ++nxcd; if ((unsigned)x == bctx.xcc) nx = v; }
        bctx.nx = nx; bctx.nxcd = nxcd;
    }
#if defined(DBG_AMP_P0) || defined(DBG_AMP_FINAL)
    unsigned long long amp_k0 = __builtin_amdgcn_s_memrealtime();
#endif

    {
        const int tid_ = opaque_tid(); const int wid = tid_ >> 6, lane = tid_ & 63;
        bf16_t* hb = (bf16_t*)(ws + OFF_HB); float* rowpart = (float*)(ws + OFF_ROWPART);
        for (int row = c * 8 + wid; row < T; row += G * 8) {
            const float* src = row < TR ? p.in[0] + (size_t)row * DM : p.in[1] + (size_t)((row - TR) & 15) * DM;
            float ss = 0.f;
#pragma unroll
            for (int i = 0; i < 4; ++i) {
                const int col = (i * 64 + lane) * 4; const f32x4 v = *(const f32x4*)(src + col);
                u32x2 w; w.x = pk2(v[0], v[1]); w.y = pk2(v[2], v[3]); *(u32x2*)(hb + (size_t)row * DM + col) = w;
                ss += (v[0] * v[0] + v[1] * v[1]) + (v[2] * v[2] + v[3] * v[3]);
            }
#pragma unroll
            for (int o = 32; o >= 1; o >>= 1) ss += __shfl_xor(ss, o);
            if (lane < 16) rowpart[(size_t)row * 16 + lane] = lane == 0 ? ss : 0.f;
        }
    }

#ifdef DBG_AMP_P0
    if (c == 0) { const unsigned long long t1 = __builtin_amdgcn_s_memrealtime(); const unsigned long long dt = t1 - amp_k0; while (__builtin_amdgcn_s_memrealtime() - t1 < 4ull * dt) __builtin_amdgcn_s_sleep(8); __syncthreads(); }
#endif
    for (int step = 0; step < 24; ++step) {
        const int l = step / 12, s = step % 12;
#ifdef DBG_AMP_STEP
        const unsigned long long amp_t0 = __builtin_amdgcn_s_memrealtime();
#endif
        if (s == 0) {
            if (l == 1) continue;
            PH(0) {
                bf16_t* W = (bf16_t*)(ws + OFF_W);
                if (G > 64) {
                    if (c < 64) { const int g = c >> 1; s5_gen(lds, p, 0, g, W + W_S1 + (size_t)g * 256 * 256, W + W_S2 + (size_t)g * 256 * 512, (float*)(ws + OFF_LAM), c & 1); }
                    else { int rot = 0; for (int job = 0; job < 9; ++job) { const CvtJob j = make_job(p, 0, job); convert_wt(lds, j, G - 64, c - 64, rot); } }
                } else {
                    int rot = 0;
                    for (int job = 0; job < 9; ++job) { const CvtJob j = make_job(p, 0, job); convert_wt(lds, j, G, c, rot); }
                    for (int g = c; g < 32; g += G) s5_gen(lds, p, 0, g, W + W_S1 + (size_t)g * 256 * 256, W + W_S2 + (size_t)g * 256 * 512, (float*)(ws + OFF_LAM), 2);
                }
            }
        }
        int k0 = -1, k1 = -1;
#ifdef DBG_SKIP_LO
        if (s >= DBG_SKIP_LO && s <= DBG_SKIP_HI) { grid_barrier(bctx); continue; }
#endif
        switch (s) {
        case 1: k0 = GK_UP1; break;
        case 2: k0 = GK_DN1; break;
        case 3: k0 = GK_PROJ; break;
        case 4: k0 = GK_S5S; break;
        case 6: k0 = GK_S5Y; break;
        case 7: k0 = GK_GLU; k1 = GK_WO; break;
        case 8: k0 = GK_GATE; break;
        case 9: k0 = GK_OUTP; break;
        case 10: k0 = GK_UP2; break;
        case 11: k0 = GK_DN2; break;
        default: break;
        }
#ifdef DBG_NO_GLA
        if (k1 == GK_WO) k1 = -1;
#endif
#ifdef DBG_NO_S5
        if (k0 == GK_S5S || k0 == GK_S5Y) k0 = -1;
        if (k0 == GK_GLU) { k0 = k1; k1 = -1; }
#endif
#ifdef DBG_DUP_UP
        if (s == 1 || s == 10) k1 = k0;
#endif
#ifdef DBG_DUP_ALLGEMM
        PH(1) { if (k0 >= 0) { const pg8::Gemm g = make_gemm(k0, ws, l); const EpiSwitch E{k0 + 100, ws, out}; pg8::gemm_phase(lds, g, E, G, c); }
                if (k1 >= 0) { const pg8::Gemm g = make_gemm(k1, ws, l); const EpiSwitch E{k1 + 100, ws, out}; pg8::gemm_phase(lds, g, E, G, c); } }
#endif
        PH(1) {
            for (int sub = 0; sub < 2; ++sub) {
                const int kk = sub ? k1 : k0;
                if (kk >= 0) { const pg8::Gemm g = make_gemm(kk % 100, ws, l); const EpiSwitch E{kk, ws, out}; pg8::gemm_phase(lds, g, E, G, sub ? (c + 8) % G : c); }
            }
        }
#ifdef DBG_DUP_GLA
        if (s == 4) { gla_g1(lds, p, l, (const bf16_t*)(ws + OFF_K), (const bf16_t*)(ws + OFF_V), (const float*)(ws + OFF_Z), (bf16_t*)(ws + OFF_GS), (float*)(ws + OFF_DEC), G, (c + 32) % G); }
        if (s == 6) { gla_g3(lds, p, l, (const bf16_t*)(ws + OFF_Q), (const bf16_t*)(ws + OFF_K), (const bf16_t*)(ws + OFF_V), (const bf16_t*)(ws + OFF_R), (const float*)(ws + OFF_Z),
                             (const bf16_t*)(ws + OFF_GS), (bf16_t*)(ws + OFF_O), G, (c + 32) % G); }
#endif
#ifdef DBG_DUP_MISC
        if (s == 0) { int rot = 0; for (int job = 0; job < 9; ++job) { const CvtJob j = make_job(p, l, job); convert_wt(lds, j, G, c, rot); } }
        if (s == 5) { s5_scan(lds, (const float*)(ws + OFF_S5S), (bf16_t*)(ws + OFF_UBUF), (const float*)(ws + OFF_LAM), G, c); }
        grid_barrier(bctx);
#endif
        if (s == 3 && l == 0 && G >= 256 && c >= 128) {
            __syncthreads();
            int rot = 0; for (int job = 0; job < 4; ++job) { const CvtJob j = make_job(p, 1, job); convert_wt(lds, j, 128, c - 128, rot); }
        }
        if (s == 4) { PH(5) gla_g1(lds, p, l, (const bf16_t*)(ws + OFF_K), (const bf16_t*)(ws + OFF_V), (const float*)(ws + OFF_Z), (bf16_t*)(ws + OFF_GS), (float*)(ws + OFF_DEC), G, (c + 32) % G); }
        if (s == 5) {
            PH(6) s5_scan(lds, (const float*)(ws + OFF_S5S), (bf16_t*)(ws + OFF_UBUF), (const float*)(ws + OFF_LAM + (size_t)l * LAM_BYTES), G, c);
            PH(7) gla_g2(lds, (bf16_t*)(ws + OFF_GS), (const float*)(ws + OFF_DEC), G, c);
            if (l == 0) {
                bf16_t* W1 = (bf16_t*)(ws + OFF_W + W_BYTES); float* lam1 = (float*)(ws + OFF_LAM + LAM_BYTES);
                __syncthreads();
                if (G >= 256) {
                    if (c >= 128 && c < 192) { const int g = (c - 128) >> 1; s5_gen(lds, p, 1, g, W1 + W_S1 + (size_t)g * 256 * 256, W1 + W_S2 + (size_t)g * 256 * 512, lam1, c & 1); }
                    if (c < 128 || c >= 192) { const int cc = c < 128 ? c : c - 64; int rot = 0; for (int job = 4; job < 9; ++job) { const CvtJob j = make_job(p, 1, job); convert_wt(lds, j, 192, cc, rot); } }
                } else {
                    int rot = 0;
                    for (int job = 0; job < 9; ++job) { const CvtJob j = make_job(p, 1, job); convert_wt(lds, j, G, c, rot); }
                    for (int g = c; g < 32; g += G) s5_gen(lds, p, 1, g, W1 + W_S1 + (size_t)g * 256 * 256, W1 + W_S2 + (size_t)g * 256 * 512, lam1, 2);
                }
            }
        }
        if (s == 6) { PH(9) gla_g3(lds, p, l, (const bf16_t*)(ws + OFF_Q), (const bf16_t*)(ws + OFF_K), (const bf16_t*)(ws + OFF_V), (const bf16_t*)(ws + OFF_R), (const float*)(ws + OFF_Z),
                                   (const bf16_t*)(ws + OFF_GS), (bf16_t*)(ws + OFF_O), G, (c + 32) % G); }
        grid_barrier(bctx);
#ifdef DBG_AMP_STEP
        if (c == 0 && s == DBG_AMP_STEP) {
            const unsigned long long t1 = __builtin_amdgcn_s_memrealtime(); const unsigned long long dt = t1 - amp_t0;
            while (__builtin_amdgcn_s_memrealtime() - t1 < 4ull * dt) __builtin_amdgcn_s_sleep(8);
            __syncthreads();
        }
#endif
    }
#ifdef DBG_AMP_FINAL
    amp_k0 = __builtin_amdgcn_s_memrealtime();
#endif
    {
        const int tid_ = opaque_tid(); const int wid = tid_ >> 6, lane = tid_ & 63;
        const float* gf = p.in[31]; const float* rowpart = (const float*)(ws + OFF_ROWPART); const bf16_t* hbf = (const bf16_t*)(ws + OFF_HB);
        for (int row = c * 8 + wid; row < TR; row += G * 8) {
            float s = lane < 16 ? rowpart[(size_t)row * 16 + lane] : 0.f;
#pragma unroll
            for (int o = 8; o >= 1; o >>= 1) s += __shfl_xor(s, o);
            s = __shfl(s, 0);
            const float rs = rsqrtf(s * (1.f / 1024.f) + 1e-6f);
#pragma unroll
            for (int i = 0; i < 4; ++i) { const int col = (i * 64 + lane) * 4; const u32x2 hv = *(const u32x2*)(hbf + (size_t)row * DM + col); const f32x4 gv = *(const f32x4*)(gf + col);
                f32x4 v; v[0] = lo16(hv.x) * rs * gv[0]; v[1] = hi16(hv.x) * rs * gv[1]; v[2] = lo16(hv.y) * rs * gv[2]; v[3] = hi16(hv.y) * rs * gv[3]; *(f32x4*)(out + (size_t)row * DM + col) = v; }
        }
    }
#ifdef DBG_AMP_FINAL
    { const unsigned long long t1 = __builtin_amdgcn_s_memrealtime(); const unsigned long long dt = t1 - amp_k0; while (__builtin_amdgcn_s_memrealtime() - t1 < 4ull * dt) __builtin_amdgcn_s_sleep(8); }
#endif
}

extern "C" void kernel_launch(void* const* d_in, const int* in_sizes, int n_in, void* d_out, int out_size, void* d_ws, size_t ws_size, hipStream_t stream) {
    static int grid_blocks = 0;
    if (grid_blocks == 0) {
        if (n_in != 32 || ws_size < WS_END || out_size != TR * DM) { fprintf(stderr, "kernel_launch: unexpected shapes / workspace (%d inputs, ws %zu < %zu)\n", n_in, ws_size, (size_t)WS_END); grid_blocks = -1; return; }
        int dev = 0, cus = 0, per_cu = 0;
        hipGetDevice(&dev); hipDeviceGetAttribute(&cus, hipDeviceAttributeMultiprocessorCount, dev);
        hipFuncSetAttribute((const void*)fwd_mega, hipFuncAttributeMaxDynamicSharedMemorySize, LDS_BYTES);
        hipOccupancyMaxActiveBlocksPerMultiprocessor(&per_cu, (const void*)fwd_mega, NTHR, LDS_BYTES);
        if (per_cu < 1) per_cu = 1;
        if (per_cu > 1) per_cu = 1;
        grid_blocks = cus * per_cu;
    }
    if (grid_blocks < 0) return;
    if (hipMemsetAsync((char*)d_ws + OFF_BAR, 0, 4096, stream) != hipSuccess) { fprintf(stderr, "memset failed\n"); return; }
    Params p{};
    for (int i = 0; i < 32; ++i) p.in[i] = (const float*)d_in[i];
    p.out = (float*)d_out; p.ws = (unsigned char*)d_ws;
    void* args[] = {&p};
    hipError_t e = hipLaunchCooperativeKernel((const void*)fwd_mega, dim3(grid_blocks), dim3(NTHR), args, LDS_BYTES, stream);
    if (e != hipSuccess) fprintf(stderr, "cooperative launch failed: %s (grid %d)\n", hipGetErrorString(e), grid_blocks);
}
```
